# Optimizing an MI355X kernel written in HIP

```python
import math
import jax, jax.numpy as jnp
from jax import lax
import numpy as np

D_MODEL = 4096
BATCH = 1
SEQ = 8192
DEPTH = 2

N_EVEN = (DEPTH + 1) // 2
N_ODD = DEPTH // 2

S5_WIDTH = D_MODEL // 2
S5_GROUP = 16
S5_GROUPS = S5_WIDTH // S5_GROUP
S5_STATE = 64
S5_DT_MIN = 0.001
S5_DT_MAX = 0.1

RET_HEADS = 8
RET_HEAD_DIM = (D_MODEL // 2) // RET_HEADS
RET_WIDTH = RET_HEADS * RET_HEAD_DIM
RET_CHUNK = 128
ROPE_BASE = 10000.0

EVEN_IN_WIDTH = S5_WIDTH + 4 * RET_WIDTH

DIFF_HEADS = 16
DIFF_HEAD_DIM = D_MODEL // (2 * DIFF_HEADS)
DIFF_V_DIM = 2 * DIFF_HEAD_DIM
ODD_IN_WIDTH = 3 * D_MODEL
Q_BLOCK = 128

REL_BUCKETS = 32
REL_MAX_DIST = 128

PEER_HEADS = 8
PEER_N_KEYS = 128
PEER_N_EXPERTS = PEER_N_KEYS * PEER_N_KEYS
PEER_KEY_DIM = 128
PEER_TOPK = 16
PEER_TOKEN_BLOCK = 128

EPS = 1e-6
F32 = jnp.float32

kernel_name = "hybrid_s5_retnet_diffattn_peer"


def rmsnorm(x, g):
    x32 = x.astype(F32)
    y = x32 * lax.rsqrt(jnp.mean(x32 * x32, axis=-1, keepdims=True) + EPS)
    return (y * g.astype(F32)).astype(x.dtype)


def rotary(x, pos):
    half = x.shape[-1] // 2
    freqs = ROPE_BASE ** (-jnp.arange(half, dtype=F32) / half)
    ang = pos[:, None] * freqs[None, :]
    cos = jnp.cos(ang)[None, :, None, :]
    sin = jnp.sin(ang)[None, :, None, :]
    x32 = x.astype(F32)
    x1, x2 = x32[..., :half], x32[..., half:]
    return jnp.concatenate([x1 * cos - x2 * sin, x1 * sin + x2 * cos], axis=-1)


def s5_mixer(u, log_step, a_re, a_im, b_re, b_im, c_re, c_im, d_skip, glu_w, glu_b):
    bsz, t, _ = u.shape
    dt = u.dtype
    u32 = u.astype(F32)
    ug = u32.reshape(bsz, t, S5_GROUPS, S5_GROUP)
    step = jnp.exp(log_step.astype(F32))[:, None]
    lr, li = a_re.astype(F32), a_im.astype(F32)
    mag = jnp.exp(lr * step)
    abar_re = mag * jnp.cos(li * step)
    abar_im = mag * jnp.sin(li * step)
    den = lr * lr + li * li
    num_re = abar_re - 1.0
    f_re = (num_re * lr + abar_im * li) / den
    f_im = (abar_im * lr - num_re * li) / den
    br, bi = b_re.astype(F32), b_im.astype(F32)
    bbar_re = f_re[..., None] * br - f_im[..., None] * bi
    bbar_im = f_re[..., None] * bi + f_im[..., None] * br
    xr = jnp.einsum('btgc,gpc->btgp', ug, bbar_re)
    xi = jnp.einsum('btgc,gpc->btgp', ug, bbar_im)
    ar = jnp.broadcast_to(abar_re, xr.shape)
    ai = jnp.broadcast_to(abar_im, xi.shape)

    def combine(e1, e2):
        a1r, a1i, b1r, b1i = e1
        a2r, a2i, b2r, b2i = e2
        return (a2r * a1r - a2i * a1i,
                a2r * a1i + a2i * a1r,
                a2r * b1r - a2i * b1i + b2r,
                a2r * b1i + a2i * b1r + b2i)

    _, _, sr, si = lax.associative_scan(combine, (ar, ai, xr, xi), axis=1)
    y = (jnp.einsum('btgp,gcp->btgc', sr, c_re.astype(F32))
         - jnp.einsum('btgp,gcp->btgc', si, c_im.astype(F32)))
    y = y.reshape(bsz, t, S5_WIDTH) + d_skip.astype(F32) * u32
    y = jax.nn.gelu(y).astype(dt)
    return y * jax.nn.sigmoid(y @ glu_w + glu_b)


def retention_mixer(q, k, v, gate, gn_g, gn_b, pos):
    bsz, t, _ = q.shape
    dt = q.dtype
    shp = (bsz, t, RET_HEADS, RET_HEAD_DIM)
    q = rotary(q.reshape(shp), pos)
    k = rotary(k.reshape(shp), pos) * (RET_HEAD_DIM ** -0.5)
    v = v.reshape(shp).astype(F32)
    gamma = 1.0 - 2.0 ** (-5.0 - jnp.arange(RET_HEADS, dtype=F32))
    log_g = jnp.log(gamma)
    idx = jnp.arange(RET_CHUNK, dtype=F32)
    rel = idx[:, None] - idx[None, :]
    intra = jnp.where(rel >= 0, jnp.exp(log_g[:, None, None] * jnp.maximum(rel, 0.0)), 0.0)
    q_decay = jnp.exp(log_g[:, None] * (idx + 1.0))[..., None]
    k_decay = jnp.exp(log_g[:, None] * (RET_CHUNK - 1.0 - idx))[..., None]
    chunk_decay = jnp.exp(log_g * RET_CHUNK)[:, None, None]
    n_chunks = t // RET_CHUNK

    def to_chunks(z):
        return z.reshape(bsz, n_chunks, RET_CHUNK, RET_HEADS, RET_HEAD_DIM).transpose(1, 0, 3, 2, 4)

    qc, kc, vc = to_chunks(q), to_chunks(k), to_chunks(v)

    def step(state, inp):
        qi, ki, vi = inp
        scores = jnp.einsum('bhid,bhjd->bhij', qi, ki) * intra
        inner = jnp.einsum('bhij,bhjd->bhid', scores, vi)
        cross = jnp.einsum('bhid,bhde->bhie', qi * q_decay, state)
        new_state = chunk_decay * state + jnp.einsum('bhjd,bhje->bhde', ki * k_decay, vi)
        return new_state, inner + cross

    state0 = jnp.zeros((bsz, RET_HEADS, RET_HEAD_DIM, RET_HEAD_DIM), F32)
    _, out = lax.scan(step, state0, (qc, kc, vc))
    out = out.transpose(1, 0, 3, 2, 4).reshape(shp)
    mu = jnp.mean(out, axis=-1, keepdims=True)
    var = jnp.mean((out - mu) ** 2, axis=-1, keepdims=True)
    out = ((out - mu) * lax.rsqrt(var + EPS)).reshape(bsz, t, RET_WIDTH)
    out = out * gn_g.astype(F32) + gn_b.astype(F32)
    return (jax.nn.silu(gate.astype(F32)) * out).astype(dt)


def even_mixer(h, w_in, log_step, a_re, a_im, b_re, b_im, c_re, c_im, d_skip,
               glu_w, glu_b, gn_g, gn_b, w_out):
    t = h.shape[1]
    pos = jnp.arange(t, dtype=F32)
    z = h @ w_in
    u, q, k, v, g = jnp.split(z, [S5_WIDTH, S5_WIDTH + RET_WIDTH, S5_WIDTH + 2 * RET_WIDTH,
                                  S5_WIDTH + 3 * RET_WIDTH], axis=-1)
    ya = s5_mixer(u, log_step, a_re, a_im, b_re, b_im, c_re, c_im, d_skip, glu_w, glu_b)
    yb = retention_mixer(q, k, v, g, gn_g, gn_b, pos)
    return jnp.concatenate([ya, yb], axis=-1) @ w_out


def t5_bucket(rel):
    n = jnp.maximum(rel, 0)
    max_exact = REL_BUCKETS // 2
    nf = jnp.maximum(n, 1).astype(F32)
    large = max_exact + (jnp.log(nf / max_exact) / math.log(REL_MAX_DIST / max_exact)
                         * (REL_BUCKETS - max_exact)).astype(jnp.int32)
    large = jnp.minimum(large, REL_BUCKETS - 1)
    return jnp.where(n < max_exact, n, large)


def odd_mixer(h, w_in, q_norm_g, k_norm_g, lq1, lk1, lq2, lk2, sub_norm_g, w_out,
              rel_bias, lambda_init):
    bsz, t, _ = h.shape
    dt = h.dtype
    q, k, v = jnp.split(h @ w_in, 3, axis=-1)
    q = q.reshape(bsz, t, DIFF_HEADS, 2, DIFF_HEAD_DIM)
    k = k.reshape(bsz, t, DIFF_HEADS, 2, DIFF_HEAD_DIM)
    v = v.reshape(bsz, t, DIFF_HEADS, DIFF_V_DIM)
    q = rmsnorm(q, q_norm_g) * (DIFF_HEAD_DIM ** -0.5)
    k = rmsnorm(k, k_norm_g)
    lam = (jnp.exp(jnp.sum(lq1.astype(F32) * lk1.astype(F32)))
           - jnp.exp(jnp.sum(lq2.astype(F32) * lk2.astype(F32))) + lambda_init)
    kh = k.transpose(0, 2, 3, 1, 4)
    vh = v.transpose(0, 2, 1, 3)
    n_blocks = t // Q_BLOCK
    qb = q.transpose(0, 2, 3, 1, 4).reshape(bsz, DIFF_HEADS, 2, n_blocks, Q_BLOCK, DIFF_HEAD_DIM)
    qb = qb.transpose(3, 0, 1, 2, 4, 5)
    k_pos = jnp.arange(t, dtype=jnp.int32)

    def block(args):
        qi, bi = args
        q_pos = bi * Q_BLOCK + jnp.arange(Q_BLOCK, dtype=jnp.int32)
        rel = q_pos[:, None] - k_pos[None, :]
        bias = rel_bias[t5_bucket(rel)].transpose(2, 0, 1).astype(F32)
        logits = jnp.einsum('bhmqd,bhmkd->bhmqk', qi, kh).astype(F32) + bias[None, :, None]
        logits = jnp.where(rel >= 0, logits, -jnp.inf)
        p = jax.nn.softmax(logits, axis=-1)
        attn = p[:, :, 0] - lam * p[:, :, 1]
        return jnp.einsum('bhqk,bhkd->bhqd', attn.astype(dt), vh)

    out = lax.map(block, (qb, jnp.arange(n_blocks, dtype=jnp.int32)))
    out = out.transpose(1, 0, 3, 2, 4).reshape(bsz, t, DIFF_HEADS, DIFF_V_DIM)
    out = rmsnorm(out, sub_norm_g) * (1.0 - lambda_init)
    return out.reshape(bsz, t, D_MODEL) @ w_out


def peer(h, w_q, sub_keys, u_tab, v_tab):
    bsz, t, d = h.shape
    dt = h.dtype
    n_tok = bsz * t
    x = h.reshape(n_tok, d)
    q = (x @ w_q).reshape(n_tok, PEER_HEADS, 2, PEER_KEY_DIM)
    s = jnp.einsum('nhpk,hpek->nhpe', q, sub_keys).astype(F32)
    s1, i1 = lax.top_k(s[:, :, 0], PEER_TOPK)
    s2, i2 = lax.top_k(s[:, :, 1], PEER_TOPK)
    cand = (s1[..., :, None] + s2[..., None, :]).reshape(n_tok, PEER_HEADS, PEER_TOPK * PEER_TOPK)
    cand_idx = (i1[..., :, None] * PEER_N_KEYS + i2[..., None, :]).reshape(n_tok, PEER_HEADS, PEER_TOPK * PEER_TOPK)
    best, sel = lax.top_k(cand, PEER_TOPK)
    expert = jnp.take_along_axis(cand_idx, sel, axis=-1)
    gate = jax.nn.softmax(best, axis=-1)
    nb = n_tok // PEER_TOKEN_BLOCK

    def block(args):
        xb, eb, gb = args
        act = jax.nn.gelu(jnp.einsum('ted,td->te', u_tab[eb], xb).astype(F32))
        w = (gb * act).astype(dt)
        return jnp.einsum('te,ted->td', w, v_tab[eb])

    out = lax.map(block, (x.reshape(nb, PEER_TOKEN_BLOCK, d),
                          expert.reshape(nb, PEER_TOKEN_BLOCK, PEER_HEADS * PEER_TOPK),
                          gate.reshape(nb, PEER_TOKEN_BLOCK, PEER_HEADS * PEER_TOPK)))
    return out.reshape(bsz, t, d)


def setup_inputs(seed: int = 0) -> dict:
    key = jax.random.key(seed)
    ks = iter(jax.random.split(key, 40))
    nrm = lambda shape, scale: jax.random.normal(next(ks), shape, F32) * scale
    D = D_MODEL
    inp = {}
    inp["x"] = nrm((BATCH, SEQ, D), 1.0)
    inp["ev_norm_g"] = 1.0 + nrm((N_EVEN, D), 0.02)
    inp["ev_w_in"] = nrm((N_EVEN, D, EVEN_IN_WIDTH), D ** -0.5)
    inp["s5_log_step"] = jax.random.uniform(next(ks), (N_EVEN, S5_GROUPS), F32,
                                            math.log(S5_DT_MIN), math.log(S5_DT_MAX))
    inp["s5_a_re"] = -0.5 + nrm((N_EVEN, S5_GROUPS, S5_STATE), 0.01)
    inp["s5_a_im"] = (math.pi * jnp.arange(S5_STATE, dtype=F32))[None, None, :] + nrm((N_EVEN, S5_GROUPS, S5_STATE), 0.01)
    inp["s5_b_re"] = nrm((N_EVEN, S5_GROUPS, S5_STATE, S5_GROUP), (2 * S5_GROUP) ** -0.5)
    inp["s5_b_im"] = nrm((N_EVEN, S5_GROUPS, S5_STATE, S5_GROUP), (2 * S5_GROUP) ** -0.5)
    inp["s5_c_re"] = nrm((N_EVEN, S5_GROUPS, S5_GROUP, S5_STATE), (2 * S5_STATE) ** -0.5)
    inp["s5_c_im"] = nrm((N_EVEN, S5_GROUPS, S5_GROUP, S5_STATE), (2 * S5_STATE) ** -0.5)
    inp["s5_d"] = nrm((N_EVEN, S5_WIDTH), 1.0)
    inp["s5_glu_w"] = nrm((N_EVEN, S5_WIDTH, S5_WIDTH), S5_WIDTH ** -0.5)
    inp["s5_glu_b"] = nrm((N_EVEN, S5_WIDTH), 0.01)
    inp["ret_gn_g"] = 1.0 + nrm((N_EVEN, RET_WIDTH), 0.02)
    inp["ret_gn_b"] = nrm((N_EVEN, RET_WIDTH), 0.01)
    inp["ev_w_out"] = nrm((N_EVEN, D, D), D ** -0.5)
    inp["od_norm_g"] = 1.0 + nrm((N_ODD, D), 0.02)
    inp["od_w_in"] = nrm((N_ODD, D, ODD_IN_WIDTH), D ** -0.5)
    inp["diff_q_norm_g"] = 1.0 + nrm((N_ODD, DIFF_HEAD_DIM), 0.02)
    inp["diff_k_norm_g"] = 1.0 + nrm((N_ODD, DIFF_HEAD_DIM), 0.02)
    inp["diff_lq1"] = nrm((N_ODD, DIFF_HEAD_DIM), 0.1)
    inp["diff_lk1"] = nrm((N_ODD, DIFF_HEAD_DIM), 0.1)
    inp["diff_lq2"] = nrm((N_ODD, DIFF_HEAD_DIM), 0.1)
    inp["diff_lk2"] = nrm((N_ODD, DIFF_HEAD_DIM), 0.1)
    inp["diff_sub_norm_g"] = 1.0 + nrm((N_ODD, DIFF_V_DIM), 0.02)
    inp["od_w_out"] = nrm((N_ODD, D, D), D ** -0.5)
    inp["rel_bias"] = nrm((REL_BUCKETS, DIFF_HEADS), 0.5)
    inp["ffn_norm_g"] = 1.0 + nrm((DEPTH, D), 0.02)
    inp["peer_w_q"] = nrm((DEPTH, D, PEER_HEADS * 2 * PEER_KEY_DIM), D ** -0.5)
    inp["peer_sub_keys"] = nrm((DEPTH, PEER_HEADS, 2, PEER_N_KEYS, PEER_KEY_DIM), PEER_KEY_DIM ** -0.5)
    inp["peer_u"] = nrm((DEPTH, PEER_N_EXPERTS, D), D ** -0.5)
    inp["peer_v"] = nrm((DEPTH, PEER_N_EXPERTS, D), PEER_HEADS ** -0.5)
    return inp


def reference(x, ev_norm_g, ev_w_in, s5_log_step, s5_a_re, s5_a_im, s5_b_re, s5_b_im,
              s5_c_re, s5_c_im, s5_d, s5_glu_w, s5_glu_b, ret_gn_g, ret_gn_b, ev_w_out,
              od_norm_g, od_w_in, diff_q_norm_g, diff_k_norm_g, diff_lq1, diff_lk1,
              diff_lq2, diff_lk2, diff_sub_norm_g, od_w_out, rel_bias,
              ffn_norm_g, peer_w_q, peer_sub_keys, peer_u, peer_v):
    for layer in range(DEPTH):
        i = layer // 2
        if layer % 2 == 0:
            x = x + even_mixer(rmsnorm(x, ev_norm_g[i]), ev_w_in[i], s5_log_step[i],
                               s5_a_re[i], s5_a_im[i], s5_b_re[i], s5_b_im[i],
                               s5_c_re[i], s5_c_im[i], s5_d[i], s5_glu_w[i], s5_glu_b[i],
                               ret_gn_g[i], ret_gn_b[i], ev_w_out[i])
        else:
            lambda_init = 0.8 - 0.6 * math.exp(-0.3 * layer)
            x = x + odd_mixer(rmsnorm(x, od_norm_g[i]), od_w_in[i], diff_q_norm_g[i],
                              diff_k_norm_g[i], diff_lq1[i], diff_lk1[i], diff_lq2[i],
                              diff_lk2[i], diff_sub_norm_g[i], od_w_out[i], rel_bias,
                              lambda_init)
        x = x + peer(rmsnorm(x, ffn_norm_g[layer]), peer_w_q[layer], peer_sub_keys[layer],
                     peer_u[layer], peer_v[layer])
    return x
```

```cpp
#include <hip/hip_runtime.h>
#include <cstdio>
#include <cstdint>

#define GAS __attribute__((address_space(1)))
#define LAS __attribute__((address_space(3)))
typedef unsigned short bf16;
typedef short bf16x8 __attribute__((ext_vector_type(8)));
typedef short s16x4 __attribute__((ext_vector_type(4)));
typedef float f32x2 __attribute__((ext_vector_type(2)));
typedef float f32x4 __attribute__((ext_vector_type(4)));
typedef float f32x16 __attribute__((ext_vector_type(16)));
typedef unsigned u32x2 __attribute__((ext_vector_type(2)));
typedef unsigned u32x4 __attribute__((ext_vector_type(4)));
typedef __bf16 bf16x2_t __attribute__((ext_vector_type(2)));
#define DI __device__ __forceinline__

DI unsigned pk2(float lo, float hi) { f32x2 v = {lo, hi}; bf16x2_t b = __builtin_convertvector(v, bf16x2_t); return __builtin_bit_cast(unsigned, b); }
DI float bflo(unsigned u) { return __builtin_bit_cast(float, u << 16); }
DI float bfhi(unsigned u) { return __builtin_bit_cast(float, u & 0xffff0000u); }
DI float bf2f(bf16 b) { return __builtin_bit_cast(float, (unsigned)b << 16); }
DI float wave_sum(float v) {
#pragma unroll
    for (int o = 1; o < 64; o <<= 1) v += __shfl_xor(v, o);
    return v;
}
DI float sigmoidf_(float x) { return 1.f / (1.f + __expf(-x)); }
DI float gelu_tanh(float v) { const float z = 0.7978845608028654f * (v + 0.044715f * v * v * v); return v / (1.f + __expf(-2.f * z)); }
DI int crow(int r, int hi) { return (r & 3) + 8 * (r >> 2) + 4 * hi; }
DI unsigned pk4_fp8(float a, float b, float c, float d) { int p = 0; p = __builtin_amdgcn_cvt_pk_fp8_f32(a, b, p, false); p = __builtin_amdgcn_cvt_pk_fp8_f32(c, d, p, true); return (unsigned)p; }
DI void swap32(const float x, float& lo, float& hi) { unsigned a_ = __builtin_bit_cast(unsigned, x), b_ = a_; asm volatile("s_nop 1\n\tv_permlane32_swap_b32 %0, %1" : "+v"(a_), "+v"(b_)); lo = __builtin_bit_cast(float, a_); hi = __builtin_bit_cast(float, b_); }
DI int lane_id() { return (int)__builtin_amdgcn_mbcnt_hi(~0u, __builtin_amdgcn_mbcnt_lo(~0u, 0u)); }

#ifndef FP8_WIN
#define FP8_WIN 0
#endif
#ifndef FP8_EWO
#define FP8_EWO 1
#endif
#ifndef FP8_WPART
#define FP8_WPART 1
#endif
#ifndef FP8_OWO
#define FP8_OWO 1
#endif
constexpr int T = 8192, D = 4096;
constexpr int S5W = 2048, S5G = 128, S5P = 64, S5L = 32, S5NC = T / S5L;
constexpr int UCLD = 640;
constexpr int RH = 8, RHD = 256, RW = 2048;
constexpr int ZW = 8192;
constexpr int AH = 16, AHD = 128, AVD = 256, QKVW = 12288;
constexpr int PH = 8, PNK = 128, PKD = 128, PTOPK = 16, PQW = 2048, NEXP = 16384;
constexpr float EPS = 1e-6f;
constexpr float LAMBDA_INIT = 0.35550906759096926f;
constexpr float LOG2E = 1.4426950408889634f;

constexpr size_t MiB = 1u << 20;
constexpr size_t WS_CTL = 0, CTL_ZERO_BYTES = 1 * MiB;
constexpr size_t WS_WIN = 2 * MiB;
constexpr size_t WS_GLU = 82 * MiB;
constexpr size_t WS_EWO = 90 * MiB;
constexpr size_t WS_OWI = 122 * MiB;
constexpr size_t WS_OWO = 218 * MiB;
constexpr size_t WS_WST = 250 * MiB;
constexpr size_t WS_PKEY = 282 * MiB;
constexpr size_t WS_BT13 = 298 * MiB;
constexpr size_t WS_BTE = 378 * MiB;
constexpr size_t WS_PW32 = 410 * MiB;
constexpr size_t WS_MISC = 411 * MiB;
constexpr size_t WS_SU = WS_MISC + 65536;
constexpr size_t WS_SV = WS_MISC + 262144;
constexpr size_t WS_TU = 412 * MiB;
constexpr size_t WS_TV = 668 * MiB;
constexpr size_t WS_H = 924 * MiB;
constexpr size_t WS_R0 = 988 * MiB;
constexpr size_t WS_Z = WS_R0;
constexpr size_t WS_UC = WS_R0 + 128 * MiB;
constexpr size_t WS_E = WS_R0 + 168 * MiB;
constexpr size_t WS_YPRE = WS_R0 + 184 * MiB;
constexpr size_t WS_YCAT = WS_R0 + 216 * MiB;
constexpr size_t WS_QR = WS_R0 + 280 * MiB;
constexpr size_t WS_KR = WS_R0 + 312 * MiB;
constexpr size_t WS_VT = WS_R0 + 344 * MiB;
constexpr size_t WS_H8L0 = WS_R0 + 448 * MiB;
constexpr size_t WS_WIN8 = WS_R0 + 480 * MiB;
constexpr size_t WS_PART = WS_R0;
constexpr size_t WS_PW = WS_R0 + 32 * MiB;
constexpr size_t WS_QKV = WS_R0;
constexpr size_t WS_VT1 = WS_R0 + 192 * MiB;
constexpr size_t WS_O1 = WS_R0 + 256 * MiB;
constexpr size_t WS_AO = WS_R0 + 384 * MiB;
constexpr size_t WS_WQB = 1500 * MiB;
constexpr size_t WS_PS = 1532 * MiB;
constexpr size_t WS_EIDX = 1596 * MiB;
constexpr size_t WS_GATE = 1600 * MiB;
constexpr size_t WS_SQ = 1604 * MiB;
constexpr size_t WS_VS = 1668 * MiB;
constexpr size_t WS_KVT = 1732 * MiB;
constexpr size_t WS_KDT = 1796 * MiB;
constexpr size_t WS_END = 1828 * MiB;

constexpr int LDS_BYTES = 147456;
constexpr int LDS_MISC = 131072 + 8192;

#define XB_TMO      128
#define XB_XCNT(j)  (256  + 64 * (j))
#define XB_XSUB(j)  (1280 + 64 * (j))
#define XB_XGEN(j)  (2304 + 64 * (j))
#define XB_TOP      3328
#define XB_TOPGEN   3392
#define XCD_BAR_WORDS 3456
#define XB_SPIN_CAP (1u << 21)
DI unsigned xb_ld(unsigned* p)              { return __hip_atomic_load(p, __ATOMIC_RELAXED, __HIP_MEMORY_SCOPE_AGENT); }
DI unsigned xb_add(unsigned* p, unsigned v) { return __hip_atomic_fetch_add(p, v, __ATOMIC_RELAXED, __HIP_MEMORY_SCOPE_AGENT); }
DI unsigned xb_xcc_id() { return (unsigned)__builtin_amdgcn_s_getreg((3 << 11) | 20) & 0xFu; }
#define XB_SPIN(cond, bar) do { unsigned _sp = 0; while (cond) { __builtin_amdgcn_s_sleep(1); \
    if ((++_sp & 255u) == 0u) { if (xb_ld(&(bar)[XB_TMO])) break; if (_sp > XB_SPIN_CAP) { atomicAdd(&(bar)[XB_TMO], 1u); break; } } } } while (0)
struct XcdBarrier { unsigned* bar; unsigned x; volatile LAS unsigned* st; int wv; };
DI XcdBarrier xcd_barrier_post(unsigned* bar, volatile LAS unsigned* st, int wv) {
    XcdBarrier b; b.bar = bar; b.x = xb_xcc_id(); b.st = st; b.wv = wv;
    if (wv == 0 && lane_id() == 0) (void)xb_add(&bar[XB_XCNT(b.x)], 1u);
    return b;
}
DI void xcd_barrier_complete(unsigned* bar, unsigned x, unsigned& nloc, unsigned& nx) {
    const unsigned G = gridDim.x * gridDim.y * gridDim.z;
    unsigned sum, cnt, mine, sp = 0u;
    for (;;) {
        sum = 0u; cnt = 0u; mine = 0u;
#pragma unroll
        for (unsigned j = 0; j < 16; ++j) { const unsigned c = xb_ld(&bar[XB_XCNT(j)]); sum += c; cnt += (c > 0u) ? 1u : 0u; mine = (j == x) ? c : mine; }
        if (sum == G) break;
        __builtin_amdgcn_s_sleep(1);
        if ((++sp & 255u) == 0u) { if (xb_ld(&bar[XB_TMO])) break; if (sp > XB_SPIN_CAP) { atomicAdd(&bar[XB_TMO], 1u); break; } }
    }
    nloc = mine > 0u ? mine : 1u; nx = cnt > 0u ? cnt : 1u;
}
DI void xcd_barrier(const XcdBarrier& b) {
    asm volatile("s_waitcnt vmcnt(0)" ::: "memory");
    __syncthreads();
    if (b.wv == 0 && lane_id() == 0) {
        unsigned* bar = b.bar;
        __builtin_amdgcn_s_waitcnt(0);
        unsigned nloc = b.st[0], nx = b.st[1];
        if (nloc == 0u) { xcd_barrier_complete(bar, b.x, nloc, nx); b.st[0] = nloc; b.st[1] = nx; }
        const unsigned old = xb_add(&bar[XB_XSUB(b.x)], 1u);
        const unsigned gen = old / nloc;
        if (old + 1u == (gen + 1u) * nloc) {
            __builtin_amdgcn_fence(__ATOMIC_RELEASE, "agent");
            asm volatile("s_waitcnt vmcnt(0)" ::: "memory");
            const unsigned og = xb_add(&bar[XB_TOP], 1u);
            const unsigned tg = og / nx;
            if (og + 1u == (tg + 1u) * nx) xb_add(&bar[XB_TOPGEN], 1u);
            else XB_SPIN(xb_ld(&bar[XB_TOPGEN]) == tg, bar);
            __builtin_amdgcn_fence(__ATOMIC_ACQUIRE, "agent");
            xb_add(&bar[XB_XGEN(b.x)], 1u);
            asm volatile("s_waitcnt vmcnt(0)" ::: "memory");
        } else {
            XB_SPIN(xb_ld(&bar[XB_XGEN(b.x)]) == gen, bar);
            __builtin_amdgcn_fence(__ATOMIC_ACQUIRE, "agent");
            asm volatile("s_waitcnt vmcnt(0)" ::: "memory");
        }
    }
    __syncthreads();
}

DI void peer_topk_process(float a0, float a1, float b0, float b1, int* EIDX, float* GATE, LAS float* scr, int item, int lane);
namespace pg8 {
#define PG8_LAS __attribute__((address_space(3)))
constexpr int BM = 256, BK = 64, HALF = 128, HTB = HALF * BK * 2, STAGE_BYTES = 8 * HTB, NXCD = 8, WGM = 8;
__host__ __device__ __forceinline__ int lds_byte(int r, int c) { const int st = (r >> 4) * 2 + (c >> 5), rr = r & 15, cc = c & 31, ob = rr * 64 + cc * 2; return st * 1024 + (ob ^ (((ob >> 9) & 1) << 5)); }
__host__ __device__ __forceinline__ void stage_rc(int b, int& R, int& C) { const int st = b / 1024, sb = b % 1024, swz = sb ^ (((sb >> 9) & 1) << 5); R = (st >> 1) * 16 + swz / 64; C = (st & 1) * 32 + (swz % 64) / 2; }
__host__ __device__ __forceinline__ int perm32(int rho) { const int n = rho >> 4, i = rho & 15; return 8 * (i >> 2) + 4 * n + (i & 3); }

struct Unit { const char* a; const char* b; int pm, pn, bz; };

struct Sched {
    const bf16* A; const bf16* B; size_t sA, sB; int lda, ldb, nM, nN, nB, G, c;
    DI bool next(int i, Unit& u) const {
        const long L = (long)i * G + c; const int per = nM * nN; if (L >= (long)per * nB) return false;
        const int bz = (int)(L / per); int wgid = (int)(L % per);
        { const int q = per / NXCD, r = per % NXCD, xcd = wgid % NXCD, off = wgid / NXCD; wgid = (xcd < r ? xcd * (q + 1) : r * (q + 1) + (xcd - r) * q) + off; }
        const int nig = WGM * nN, gid = wgid / nig, fm = gid * WGM, gsz = (nM - fm) < WGM ? (nM - fm) : WGM;
        u.pm = fm + ((wgid % nig) % gsz); u.pn = (wgid % nig) / gsz; u.bz = bz;
        u.a = (const char*)(A + (size_t)bz * sA + (size_t)u.pm * BM * lda); u.b = (const char*)(B + (size_t)bz * sB + (size_t)u.pn * BM * ldb);
        return true;
    }
};

struct SchedFold {
    const bf16* A; const bf16* B; int G, c;
    DI bool next(int i, Unit& u) const {
        const int L = i * G + c; if (L >= 256) return false;
        const int l = L >> 7, pm = (L >> 4) & 7, pn = L & 15; u.pm = pm; u.pn = pn; u.bz = l;
        u.a = (const char*)(A + (size_t)l * 2048 * 2048 + (size_t)pm * 256 * 2048 + pm * 256); u.b = (const char*)(B + (size_t)l * 4096 * 2048 + (size_t)pn * 256 * 2048 + pm * 256);
        return true;
    }
};
struct SchedRet {
    const bf16* A; const bf16* B; int mode, G, c;
    DI bool next(int i, Unit& u) const {
        const int L = i * G + c; if (L >= 256) return false;
        const int h = L >> 5, ch = L & 31; u.pm = 0; u.pn = 0; u.bz = L;
        if (mode == 0) { const size_t o = (size_t)ch * 256 * RW + h * RHD; u.a = (const char*)(A + o); u.b = (const char*)(B + o); }
        else if (mode == 1) { u.a = (const char*)(A + (size_t)L * 256 * 512); u.b = (const char*)(B + (size_t)h * RHD * T + ch * 256); }
        else { u.a = (const char*)(A + (size_t)L * 256 * 512); u.b = (const char*)(B + (size_t)L * 256 * 512); }
        return true;
    }
};
typedef int i32x8 __attribute__((ext_vector_type(8)));
typedef short s16x16 __attribute__((ext_vector_type(16)));
template <class Epi, class SchedT, bool FP8 = false>
DI void gemm_phase(PG8_LAS unsigned char* lds, const int tid_, const int K_, const int lda, const int ldb, const SchedT& S, const Epi& E) {
    int K = K_; asm volatile("" : "+s"(K));
    int tid = tid_; asm volatile("" : "+v"(tid));
    const int wid = __builtin_amdgcn_readfirstlane(tid >> 6), lane = tid & 63, wr = wid >> 2, wc = wid & 3, fr = lane & 15, fq = lane >> 4;
    const int nt = K / BK;
    unsigned voffA[2], voffB[2];
#pragma unroll
    for (int i = 0; i < 2; ++i) { int R, C; stage_rc(tid * 16 + i * 8192, R, C); const int Rb = Epi::PERM ? ((R & ~31) + perm32(R & 31)) : R;
        voffA[i] = (unsigned)(R * lda + C) * 2u; voffB[i] = (unsigned)(Rb * ldb + C) * 2u; }
    const size_t kstep = (size_t)(BK * 2);
    const size_t hsA = (size_t)HALF * lda * 2, hsB = (size_t)HALF * ldb * 2;
    const unsigned ldsw = (unsigned)wid * 1024u;
    const int aoff = lds_byte(wr * 64 + fr, fq * 8), boff = lds_byte(wc * 32 + fr, fq * 8);
#define PG8_SA(b, h) (((b) * 2 + (h)) * HTB)
#define PG8_SB(b, h) ((4 + (b) * 2 + (h)) * HTB)
#define PG8_STAGE(bufoff, gbase, voff) do { _Pragma("unroll") for (int _i = 0; _i < 2; ++_i) \
        __builtin_amdgcn_global_load_lds((const unsigned*)((const char*)(gbase) + (voff)[_i]), (PG8_LAS unsigned*)(lds + (bufoff) + ldsw + _i * 8192), 16, 0, 0); } while (0)
#define PG8_LDA(dst, b, h) do { _Pragma("unroll") for (int m = 0; m < 4; ++m) { const u32x4 f0 = *(const PG8_LAS u32x4*)(lds + PG8_SA(b, h) + aoff + m * 2048), f1 = *(const PG8_LAS u32x4*)(lds + PG8_SA(b, h) + aoff + m * 2048 + 1024); \
        dst[m] = __builtin_bit_cast(i32x8, __builtin_shufflevector(f0, f1, 0, 1, 2, 3, 4, 5, 6, 7)); } } while (0)
#define PG8_LDB(dst, b, h) do { _Pragma("unroll") for (int n = 0; n < 2; ++n) { const u32x4 f0 = *(const PG8_LAS u32x4*)(lds + PG8_SB(b, h) + boff + n * 2048), f1 = *(const PG8_LAS u32x4*)(lds + PG8_SB(b, h) + boff + n * 2048 + 1024); \
        dst[n] = __builtin_bit_cast(i32x8, __builtin_shufflevector(f0, f1, 0, 1, 2, 3, 4, 5, 6, 7)); } } while (0)
#define PG8_MMA(ai, bj, At, Bt) do { __builtin_amdgcn_s_setprio(1); _Pragma("unroll") for (int m = 0; m < 4; ++m) _Pragma("unroll") for (int n = 0; n < 2; ++n) { \
        if constexpr (FP8) { asm volatile("v_mfma_scale_f32_16x16x128_f8f6f4 %0, %1, %2, %0, %3, %4 op_sel_hi:[0,0,0]" : "+v"(acc[ai][bj][m][n]) : "v"(Bt[n]), "v"(At[m]), "v"(scw), "v"(scx)); } \
        else { const bf16x8 w0 = __builtin_bit_cast(bf16x8, __builtin_shufflevector(Bt[n], Bt[n], 0, 1, 2, 3)), w1 = __builtin_bit_cast(bf16x8, __builtin_shufflevector(Bt[n], Bt[n], 4, 5, 6, 7)); \
            const bf16x8 x0 = __builtin_bit_cast(bf16x8, __builtin_shufflevector(At[m], At[m], 0, 1, 2, 3)), x1 = __builtin_bit_cast(bf16x8, __builtin_shufflevector(At[m], At[m], 4, 5, 6, 7)); \
            acc[ai][bj][m][n] = __builtin_amdgcn_mfma_f32_16x16x32_bf16(w0, x0, acc[ai][bj][m][n], 0, 0, 0); acc[ai][bj][m][n] = __builtin_amdgcn_mfma_f32_16x16x32_bf16(w1, x1, acc[ai][bj][m][n], 0, 0, 0); } } \
        __builtin_amdgcn_s_setprio(0); } while (0)
#define PG8_WAIT_V(n) asm volatile("s_waitcnt vmcnt(" #n ")" ::: "memory")
#define PG8_WAIT_L(n) asm volatile("s_waitcnt lgkmcnt(" #n ")" ::: "memory")
#define PG8_BAR __builtin_amdgcn_s_barrier()
#define PG8_SCHED __builtin_amdgcn_sched_barrier(0)
    Unit cur, nxt; int ui = 0;
    if (!S.next(0, cur)) return;
    f32x4 acc[2][2][4][2];
#pragma unroll
    for (int a = 0; a < 2; ++a)
#pragma unroll
        for (int b = 0; b < 2; ++b)
#pragma unroll
            for (int m = 0; m < 4; ++m)
#pragma unroll
                for (int n = 0; n < 2; ++n) acc[a][b][m][n] = (f32x4){0.f, 0.f, 0.f, 0.f};
    const int scw = 0x77777777, scx = 0x7f7f7f7f;
    i32x8 At[4], B0[2], B1[2];
    const char* cA = cur.a; const char* cB = cur.b;
    PG8_STAGE(PG8_SB(0, 0), cB, voffB); PG8_STAGE(PG8_SB(0, 1), cB + hsB, voffB); PG8_STAGE(PG8_SA(0, 0), cA, voffA); PG8_STAGE(PG8_SA(0, 1), cA + hsA, voffA);
    if (wr == 1) PG8_BAR;
    PG8_WAIT_V(2); PG8_BAR;
    PG8_STAGE(PG8_SB(1, 0), cB + kstep, voffB); PG8_STAGE(PG8_SA(1, 0), cA + kstep, voffA); PG8_STAGE(PG8_SB(1, 1), cB + hsB + kstep, voffB);
    PG8_WAIT_V(6); PG8_BAR;
    for (;;) {
        const bool has_next = S.next(ui + 1, nxt);
        const char* nA = has_next ? nxt.a : cA; const char* nB = has_next ? nxt.b : cB;
        for (int t = 0; t < nt; t += 2) {
            const bool last = (t == nt - 2);
            const char* a1 = cA + (size_t)(t + 1) * kstep;
            const char* a2 = last ? nA : cA + (size_t)(t + 2) * kstep; const char* b2 = last ? nB : cB + (size_t)(t + 2) * kstep;
            const char* a3 = a2 + kstep; const char* b3 = b2 + kstep;
            PG8_LDB(B0, 0, 0); PG8_LDB(B1, 0, 1); PG8_SCHED; PG8_LDA(At, 0, 0); PG8_STAGE(PG8_SA(1, 1), a1 + hsA, voffA);
            PG8_WAIT_V(8); PG8_WAIT_L(0); PG8_BAR; PG8_MMA(0, 0, At, B0); PG8_MMA(0, 1, At, B1); PG8_BAR; PG8_SCHED;
            PG8_LDA(At, 0, 1); PG8_STAGE(PG8_SB(0, 0), b2, voffB); PG8_STAGE(PG8_SB(0, 1), b2 + hsB, voffB); PG8_STAGE(PG8_SA(0, 0), a2, voffA);
            PG8_WAIT_V(8); PG8_WAIT_L(0); PG8_BAR; PG8_MMA(1, 0, At, B0); PG8_MMA(1, 1, At, B1); PG8_BAR; PG8_SCHED;
            PG8_LDB(B0, 1, 0); PG8_LDB(B1, 1, 1); PG8_SCHED; PG8_LDA(At, 1, 0); PG8_STAGE(PG8_SA(0, 1), a2 + hsA, voffA);
            PG8_WAIT_V(8); PG8_WAIT_L(0); PG8_BAR; PG8_MMA(0, 0, At, B0); PG8_MMA(0, 1, At, B1); PG8_BAR; PG8_SCHED;
            PG8_LDA(At, 1, 1); PG8_STAGE(PG8_SB(1, 0), b3, voffB); PG8_STAGE(PG8_SB(1, 1), b3 + hsB, voffB); PG8_STAGE(PG8_SA(1, 0), a3, voffA);
            PG8_WAIT_V(8); PG8_WAIT_L(0); PG8_BAR; PG8_MMA(1, 0, At, B0); PG8_MMA(1, 1, At, B1); PG8_BAR; PG8_SCHED;
        }
        if (wr == 0) PG8_BAR;
        if constexpr (FP8) asm volatile("s_nop 15\n\ts_nop 15" ::: "memory");
        { int frE = fr, fqE = fq; asm volatile("" : "+v"(frE), "+v"(fqE)); E(acc, cur, wr, wc, frE, fqE); }
        if (!has_next) break;
#pragma unroll
        for (int a = 0; a < 2; ++a)
#pragma unroll
            for (int b = 0; b < 2; ++b)
#pragma unroll
                for (int m = 0; m < 4; ++m)
#pragma unroll
                    for (int n = 0; n < 2; ++n) acc[a][b][m][n] = (f32x4){0.f, 0.f, 0.f, 0.f};
        cur = nxt; cA = nA; cB = nB; ++ui;
        if (wr == 1) PG8_BAR;
    }
    PG8_WAIT_V(0);
    PG8_BAR;
#undef PG8_SA
#undef PG8_SB
#undef PG8_STAGE
#undef PG8_LDA
#undef PG8_LDB
#undef PG8_MMA
#undef PG8_WAIT_V
#undef PG8_WAIT_L
#undef PG8_BAR
#undef PG8_SCHED
}

#define EPI_LOOP_PERM(...) \
    _Pragma("unroll") for (int ai = 0; ai < 2; ++ai) _Pragma("unroll") for (int m = 0; m < 4; ++m) _Pragma("unroll") for (int bj = 0; bj < 2; ++bj) { \
        const int trow = ai * HALF + wr * 64 + m * 16 + fr, tcol = bj * HALF + wc * 32 + 8 * fq; const f32x4 v0 = acc[ai][bj][m][0], v1 = acc[ai][bj][m][1]; __VA_ARGS__ }

struct EpiBf16 {
    static constexpr bool PERM = true;
    bf16* O; int ldc; size_t sO;
    DI void operator()(const f32x4 (&acc)[2][2][4][2], const Unit& u, int wr, int wc, int fr, int fq) const {
        EPI_LOOP_PERM({ u32x4 w; w.x = pk2(v0[0], v0[1]); w.y = pk2(v0[2], v0[3]); w.z = pk2(v1[0], v1[1]); w.w = pk2(v1[2], v1[3]);
            *(u32x4*)(O + (size_t)u.bz * sO + (size_t)(u.pm * BM + trow) * ldc + u.pn * BM + tcol) = w; })
    }
};
struct EpiZ {
    static constexpr bool PERM = true;
    bf16* UC; bf16* Z; int thr, add0, add1;
    DI void operator()(const f32x4 (&acc)[2][2][4][2], const Unit& u, int wr, int wc, int fr, int fq) const {
        const int pn = u.pn + (u.pn < thr ? add0 : add1);
        EPI_LOOP_PERM({ u32x4 w; w.x = pk2(v0[0], v0[1]); w.y = pk2(v0[2], v0[3]); w.z = pk2(v1[0], v1[1]); w.w = pk2(v1[2], v1[3]);
            const int row = u.pm * BM + trow, col = pn * BM + tcol;
            if (pn < 8) { const int g = col >> 4, c = col & 15; *(u32x4*)(UC + ((size_t)(g * S5NC + (row >> 5)) * UCLD + (row & 31) * 16 + c)) = w; }
            else *(u32x4*)(Z + (size_t)row * ZW + (col - S5W)) = w; })
    }
};
struct EpiS5Y {
    static constexpr bool PERM = true;
    const bf16* UC; const float* dskip; bf16* Y;
    DI void operator()(const f32x4 (&acc)[2][2][4][2], const Unit& u, int wr, int wc, int fr, int fq) const {
        EPI_LOOP_PERM({ const int g = u.bz, chunk = trow, col = u.pn * BM + tcol, t = col >> 4, c = col & 15, tok = chunk * S5L + t, ch = g * 16 + c;
            const u32x4 uu = *(const u32x4*)(UC + ((size_t)(g * S5NC + chunk) * UCLD + col));
            const f32x4 d0 = *(const f32x4*)(dskip + ch), d1 = *(const f32x4*)(dskip + ch + 4);
            float y[8];
            y[0] = v0[0] + d0[0] * bflo(uu.x); y[1] = v0[1] + d0[1] * bfhi(uu.x); y[2] = v0[2] + d0[2] * bflo(uu.y); y[3] = v0[3] + d0[3] * bfhi(uu.y);
            y[4] = v1[0] + d1[0] * bflo(uu.z); y[5] = v1[1] + d1[1] * bfhi(uu.z); y[6] = v1[2] + d1[2] * bflo(uu.w); y[7] = v1[3] + d1[3] * bfhi(uu.w);
            _Pragma("unroll") for (int e = 0; e < 8; ++e) y[e] = gelu_tanh(y[e]);
            u32x4 w; w.x = pk2(y[0], y[1]); w.y = pk2(y[2], y[3]); w.z = pk2(y[4], y[5]); w.w = pk2(y[6], y[7]);
            *(u32x4*)(Y + (size_t)tok * S5W + ch) = w; })
    }
};
struct EpiGlu {
    static constexpr bool PERM = true;
    const bf16* YP; const float* bias; bf16* O;
    DI void operator()(const f32x4 (&acc)[2][2][4][2], const Unit& u, int wr, int wc, int fr, int fq) const {
        EPI_LOOP_PERM({ const int row = u.pm * BM + trow, col = u.pn * BM + tcol;
            const u32x4 yy = *(const u32x4*)(YP + (size_t)row * S5W + col);
            const f32x4 b0 = *(const f32x4*)(bias + col), b1 = *(const f32x4*)(bias + col + 4);
            float y[8];
            y[0] = bflo(yy.x) * sigmoidf_(v0[0] + b0[0]); y[1] = bfhi(yy.x) * sigmoidf_(v0[1] + b0[1]); y[2] = bflo(yy.y) * sigmoidf_(v0[2] + b0[2]); y[3] = bfhi(yy.y) * sigmoidf_(v0[3] + b0[3]);
            y[4] = bflo(yy.z) * sigmoidf_(v1[0] + b1[0]); y[5] = bfhi(yy.z) * sigmoidf_(v1[1] + b1[1]); y[6] = bflo(yy.w) * sigmoidf_(v1[2] + b1[2]); y[7] = bfhi(yy.w) * sigmoidf_(v1[3] + b1[3]);
            if (FP8_EWO) { u32x2 w8; w8.x = pk4_fp8(y[0], y[1], y[2], y[3]); w8.y = pk4_fp8(y[4], y[5], y[6], y[7]); *(u32x2*)((unsigned char*)O + (size_t)row * D + col) = w8; }
            else { u32x4 w; w.x = pk2(y[0], y[1]); w.y = pk2(y[2], y[3]); w.z = pk2(y[4], y[5]); w.w = pk2(y[6], y[7]);
            *(u32x4*)(O + (size_t)row * D + col) = w; } })
    }
};
#define EPI_LOOP_NAT(...) \
    _Pragma("unroll") for (int ai = 0; ai < 2; ++ai) _Pragma("unroll") for (int m = 0; m < 4; ++m) _Pragma("unroll") for (int bj = 0; bj < 2; ++bj) _Pragma("unroll") for (int n = 0; n < 2; ++n) { \
        const int trow = ai * HALF + wr * 64 + m * 16 + fr, tcol = bj * HALF + wc * 32 + 16 * n + 4 * fq; const f32x4 v = acc[ai][bj][m][n]; __VA_ARGS__ }
struct EpiF32 {
    static constexpr bool PERM = false;
    float* C; const float* res; int ldc;
    DI void operator()(const f32x4 (&acc)[2][2][4][2], const Unit& u, int wr, int wc, int fr, int fq) const {
        EPI_LOOP_NAT({ const size_t o = (size_t)(u.pm * BM + trow) * ldc + u.pn * BM + tcol; f32x4 r = v; if (res) r = r + *(const f32x4*)(res + o); *(f32x4*)(C + o) = r; })
    }
};
struct EpiS5E {
    static constexpr bool PERM = false;
    float* Eo;
    DI void operator()(const f32x4 (&acc)[2][2][4][2], const Unit& u, int wr, int wc, int fr, int fq) const {
        EPI_LOOP_NAT({ if (bj == 0) *(f32x4*)(Eo + ((size_t)(u.bz * S5NC + trow) * 128 + tcol)) = v; })
    }
};
struct EpiRetS {
    static constexpr bool PERM = true;
    bf16* SQ;
    DI void operator()(const f32x4 (&acc)[2][2][4][2], const Unit& u, int wr, int wc, int fr, int fq) const {
        const float lg2 = log2f(1.f - exp2f(-5.f - (float)(u.bz >> 5)));
        EPI_LOOP_PERM({ const int d = trow - tcol; float y[8];
            _Pragma("unroll") for (int e = 0; e < 8; ++e) { const int dd = d - e; const float sc = __builtin_amdgcn_exp2f(lg2 * (float)dd); const float v = e < 4 ? v0[e & 3] : v1[e & 3];
                y[e] = __builtin_bit_cast(float, __builtin_bit_cast(int, v * sc) & ~(dd >> 31)); }
            u32x4 w; w.x = pk2(y[0], y[1]); w.y = pk2(y[2], y[3]); w.z = pk2(y[4], y[5]); w.w = pk2(y[6], y[7]);
            *(u32x4*)(SQ + ((size_t)u.bz * 256 + trow) * 512 + tcol) = w; })
    }
};
struct EpiRetKV {
    static constexpr bool PERM = false;
    float* KVT;
    DI void operator()(const f32x4 (&acc)[2][2][4][2], const Unit& u, int wr, int wc, int fr, int fq) const {
        EPI_LOOP_NAT({ *(f32x4*)(KVT + ((size_t)u.bz * 256 + trow) * 256 + tcol) = v; })
    }
};
struct EpiQK {
    static constexpr bool PERM = true;
    bf16* O; const float* qg; const float* kg; PG8_LAS float* red;
    DI void operator()(const f32x4 (&acc)[2][2][4][2], const Unit& u, int wr, int wc, int fr, int fq) const {
        const int which = u.pn >> 4;
        _Pragma("unroll") for (int ai = 0; ai < 2; ++ai) _Pragma("unroll") for (int m = 0; m < 4; ++m) _Pragma("unroll") for (int bj = 0; bj < 2; ++bj) {
            const f32x4 v0 = acc[ai][bj][m][0], v1 = acc[ai][bj][m][1];
            float s = ((v0[0] * v0[0] + v0[1] * v0[1]) + (v0[2] * v0[2] + v0[3] * v0[3])) + ((v1[0] * v1[0] + v1[1] * v1[1]) + (v1[2] * v1[2] + v1[3] * v1[3]));
            s += __shfl_xor(s, 16); s += __shfl_xor(s, 32);
            if (fq == 0) red[(bj * 256 + ai * HALF + wr * 64 + m * 16 + fr) * 4 + wc] = s; }
        asm volatile("s_waitcnt lgkmcnt(0)" ::: "memory"); __builtin_amdgcn_s_barrier(); asm volatile("" ::: "memory");
        const float* gp = (which ? kg : qg) + wc * 32 + 8 * fq; const f32x4 g0 = *(const f32x4*)gp, g1 = *(const f32x4*)(gp + 4);
        const float sc = which ? 1.f : 0.08838834764831845f * LOG2E;
        EPI_LOOP_PERM({ const f32x4 r4 = *(const PG8_LAS f32x4*)(red + (bj * 256 + trow) * 4);
            const float rs = (1.f / sqrtf(((r4[0] + r4[1]) + (r4[2] + r4[3])) * (1.f / AHD) + EPS)) * sc;
            u32x4 w; w.x = pk2(v0[0] * rs * g0[0], v0[1] * rs * g0[1]); w.y = pk2(v0[2] * rs * g0[2], v0[3] * rs * g0[3]); w.z = pk2(v1[0] * rs * g1[0], v1[1] * rs * g1[1]); w.w = pk2(v1[2] * rs * g1[2], v1[3] * rs * g1[3]);
            *(u32x4*)(O + (size_t)(u.pm * BM + trow) * QKVW + u.pn * BM + tcol) = w; })
    }
};
struct EpiRetOut {
    static constexpr bool PERM = true;
    const bf16* Z; const float* gng; const float* gnb; bf16* YCAT; PG8_LAS float* red;
    DI void operator()(const f32x4 (&acc)[2][2][4][2], const Unit& u, int wr, int wc, int fr, int fq) const {
        const int h = u.bz >> 5, t0 = (u.bz & 31) * 256;
        float mean[2][4], rstd[2][4];
        _Pragma("unroll") for (int ai = 0; ai < 2; ++ai) _Pragma("unroll") for (int m = 0; m < 4; ++m) { float s = 0.f;
            _Pragma("unroll") for (int bj = 0; bj < 2; ++bj) _Pragma("unroll") for (int n = 0; n < 2; ++n) { const f32x4 v = acc[ai][bj][m][n]; s += (v[0] + v[1]) + (v[2] + v[3]); }
            s += __shfl_xor(s, 16); s += __shfl_xor(s, 32);
            if (fq == 0) red[(ai * HALF + wr * 64 + m * 16 + fr) * 4 + wc] = s; }
        asm volatile("s_waitcnt lgkmcnt(0)" ::: "memory"); __builtin_amdgcn_s_barrier(); asm volatile("" ::: "memory");
        _Pragma("unroll") for (int ai = 0; ai < 2; ++ai) _Pragma("unroll") for (int m = 0; m < 4; ++m) { const f32x4 r4 = *(const PG8_LAS f32x4*)(red + (ai * HALF + wr * 64 + m * 16 + fr) * 4);
            mean[ai][m] = ((r4[0] + r4[1]) + (r4[2] + r4[3])) * (1.f / 256.f); }
        _Pragma("unroll") for (int ai = 0; ai < 2; ++ai) _Pragma("unroll") for (int m = 0; m < 4; ++m) { float s = 0.f;
            _Pragma("unroll") for (int bj = 0; bj < 2; ++bj) _Pragma("unroll") for (int n = 0; n < 2; ++n) { const f32x4 v = acc[ai][bj][m][n] - mean[ai][m]; s += (v[0] * v[0] + v[1] * v[1]) + (v[2] * v[2] + v[3] * v[3]); }
            s += __shfl_xor(s, 16); s += __shfl_xor(s, 32);
            if (fq == 0) red[1024 + (ai * HALF + wr * 64 + m * 16 + fr) * 4 + wc] = s; }
        asm volatile("s_waitcnt lgkmcnt(0)" ::: "memory"); __builtin_amdgcn_s_barrier(); asm volatile("" ::: "memory");
        _Pragma("unroll") for (int ai = 0; ai < 2; ++ai) _Pragma("unroll") for (int m = 0; m < 4; ++m) { const f32x4 r4 = *(const PG8_LAS f32x4*)(red + 1024 + (ai * HALF + wr * 64 + m * 16 + fr) * 4);
            rstd[ai][m] = 1.f / sqrtf(((r4[0] + r4[1]) + (r4[2] + r4[3])) * (1.f / 256.f) + EPS); }
        EPI_LOOP_PERM({ const int t = t0 + trow, ch = h * RHD + tcol;
            const f32x4 g0 = *(const f32x4*)(gng + ch), g1 = *(const f32x4*)(gng + ch + 4), b0 = *(const f32x4*)(gnb + ch), b1 = *(const f32x4*)(gnb + ch + 4);
            const u32x4 gz = *(const u32x4*)(Z + (size_t)t * ZW + 3 * RW + ch);
            float gt[8]; gt[0] = bflo(gz.x); gt[1] = bfhi(gz.x); gt[2] = bflo(gz.y); gt[3] = bfhi(gz.y); gt[4] = bflo(gz.z); gt[5] = bfhi(gz.z); gt[6] = bflo(gz.w); gt[7] = bfhi(gz.w);
            float y[8];
            _Pragma("unroll") for (int e = 0; e < 8; ++e) { const float v = e < 4 ? v0[e & 3] : v1[e & 3]; const float gg = e < 4 ? g0[e & 3] : g1[e & 3]; const float bb = e < 4 ? b0[e & 3] : b1[e & 3];
                y[e] = ((v - mean[ai][m]) * rstd[ai][m] * gg + bb) * (gt[e] * sigmoidf_(gt[e])); }
            if (FP8_EWO) { u32x2 w8; w8.x = pk4_fp8(y[0], y[1], y[2], y[3]); w8.y = pk4_fp8(y[4], y[5], y[6], y[7]); *(u32x2*)((unsigned char*)YCAT + (size_t)t * D + S5W + ch) = w8; }
            else { u32x4 w; w.x = pk2(y[0], y[1]); w.y = pk2(y[2], y[3]); w.z = pk2(y[4], y[5]); w.w = pk2(y[6], y[7]);
            *(u32x4*)(YCAT + (size_t)t * D + S5W + ch) = w; } })
    }
};
struct EpiTopk {
    static constexpr bool PERM = false;
    int* EIDX; float* GATE; PG8_LAS unsigned char* lds;
    DI void operator()(const f32x4 (&acc)[2][2][4][2], const Unit& u, int wr, int wc, int fr, int fq) const {
        const int lane = fq * 16 + fr, wave = wr * 4 + wc;
        PG8_LAS float* tile = (PG8_LAS float*)lds; PG8_LAS float* scr = (PG8_LAS float*)(lds + 131072 + wave * 1024);
        asm volatile("s_waitcnt vmcnt(0)" ::: "memory");
        _Pragma("unroll") for (int ai = 0; ai < 2; ++ai) {
            asm volatile("s_waitcnt lgkmcnt(0)" ::: "memory"); __builtin_amdgcn_s_barrier(); asm volatile("" ::: "memory");
            _Pragma("unroll") for (int m = 0; m < 4; ++m) _Pragma("unroll") for (int bj = 0; bj < 2; ++bj) _Pragma("unroll") for (int n = 0; n < 2; ++n) {
                const int row = wr * 64 + m * 16 + fr, c4 = (bj * HALF + wc * 32 + 16 * n + 4 * fq) >> 2;
                *(PG8_LAS f32x4*)(tile + row * 256 + ((c4 ^ (row & 15)) << 2)) = acc[ai][bj][m][n]; }
            asm volatile("s_waitcnt lgkmcnt(0)" ::: "memory"); __builtin_amdgcn_s_barrier(); asm volatile("" ::: "memory");
            _Pragma("unroll 1") for (int rr = 0; rr < 16; ++rr) { const int row = wave * 16 + rr; const PG8_LAS float* rp = tile + row * 256; const int sw = row & 15, l4 = lane >> 2, l0 = lane & 3;
                const float a0 = rp[((l4 ^ sw) << 2) + l0], a1 = rp[(((16 + l4) ^ sw) << 2) + l0], b0 = rp[(((32 + l4) ^ sw) << 2) + l0], b1 = rp[(((48 + l4) ^ sw) << 2) + l0];
                peer_topk_process(a0, a1, b0, b1, EIDX, GATE, scr, (u.pm * BM + ai * HALF + row) * 8 + u.pn, lane); }
        }
    }
};
}

struct Args { const float* in[32]; float* out; unsigned char* ws; int ph_lo, ph_hi; };
enum { I_X = 0, I_EVG, I_EWIN, I_S5LS, I_S5ARE, I_S5AIM, I_S5BRE, I_S5BIM, I_S5CRE, I_S5CIM, I_S5D, I_GLUW, I_GLUB, I_GNG, I_GNB, I_EWOUT,
       I_ODG, I_OWIN, I_QNG, I_KNG, I_LQ1, I_LK1, I_LQ2, I_LK2, I_SUBG, I_OWOUT, I_RELB, I_FFNG, I_PWQ, I_PKEYS, I_PU, I_PV };

struct PA { const Args& k; unsigned char* ws; float* out; };
DI const float* inp(const PA& a, int i) { asm volatile("" : "+s"(i)); return a.k.in[i]; }

DI void transpose_item(const float* W, int K, int N, bf16* WT, const float* gain, LAS float* scr, int item, int lane) {
    const int nblk = N / 32, kb = item / nblk, nb = item % nblk, k0 = 64 * kb, n0 = 32 * nb;
#pragma unroll 8
    for (int i = 0; i < 32; ++i) { const int kk = 2 * i + (lane >> 5); float v = W[(size_t)(k0 + kk) * N + n0 + (lane & 31)]; if (gain) v *= gain[k0 + kk]; scr[kk * 33 + (lane & 31)] = v; }
    asm volatile("s_waitcnt lgkmcnt(0)" ::: "memory");
    const int c = lane & 7;
#pragma unroll
    for (int j = 0; j < 4; ++j) { const int n = (lane >> 3) + 8 * j; const LAS float* s = scr + (8 * c) * 33 + n;
        u32x4 o; o.x = pk2(s[0 * 33], s[1 * 33]); o.y = pk2(s[2 * 33], s[3 * 33]); o.z = pk2(s[4 * 33], s[5 * 33]); o.w = pk2(s[6 * 33], s[7 * 33]);
        *(u32x4*)(WT + (size_t)(n0 + n) * K + k0 + 8 * c) = o; }
    asm volatile("s_waitcnt lgkmcnt(0)" ::: "memory");
}
DI void transpose_item8(const float* W, int K, int N, unsigned char* WT, LAS float* scr, int item, int lane, int roff = 0) {
    const int nblk = N / 32, kb = item / nblk, nb = item % nblk, k0 = 64 * kb, n0 = 32 * nb;
#pragma unroll 8
    for (int i = 0; i < 32; ++i) { const int kk = 2 * i + (lane >> 5); scr[kk * 33 + (lane & 31)] = W[(size_t)(k0 + kk) * N + n0 + (lane & 31)] * 256.f; }
    asm volatile("s_waitcnt lgkmcnt(0)" ::: "memory");
    const int c = lane & 7;
#pragma unroll
    for (int j = 0; j < 4; ++j) { const int n = (lane >> 3) + 8 * j; const LAS float* sp = scr + (8 * c) * 33 + n;
        u32x2 o; o.x = pk4_fp8(sp[0 * 33], sp[1 * 33], sp[2 * 33], sp[3 * 33]); o.y = pk4_fp8(sp[4 * 33], sp[5 * 33], sp[6 * 33], sp[7 * 33]);
        *(u32x2*)(WT + (size_t)(n0 + n + roff) * K + k0 + 8 * c) = o; }
    asm volatile("s_waitcnt lgkmcnt(0)" ::: "memory");
}
DI void rms_row8(const float* xrow, const float* g, unsigned char* orow, int lane) {
    const f32x4* xr = (const f32x4*)xrow + lane; const f32x4* gr = (const f32x4*)g + lane;
    f32x4 v[16]; float s = 0.f;
#pragma unroll
    for (int j = 0; j < 16; ++j) { v[j] = xr[64 * j]; s += (v[j].x * v[j].x + v[j].y * v[j].y) + (v[j].z * v[j].z + v[j].w * v[j].w); }
    const float rstd = 1.f / sqrtf(wave_sum(s) * (1.f / D) + EPS);
    unsigned* o4 = (unsigned*)orow + lane;
#pragma unroll
    for (int j = 0; j < 16; ++j) { const f32x4 gg = gr[64 * j]; o4[64 * j] = pk4_fp8(v[j].x * rstd * gg.x, v[j].y * rstd * gg.y, v[j].z * rstd * gg.z, v[j].w * rstd * gg.w); }
}
DI void rms_row(const float* xrow, const float* g, bf16* orow, int lane) {
    const f32x4* xr = (const f32x4*)xrow + lane; const f32x4* gr = (const f32x4*)g + lane;
    f32x4 v[16]; float s = 0.f;
#pragma unroll
    for (int j = 0; j < 16; ++j) { v[j] = xr[64 * j]; s += (v[j].x * v[j].x + v[j].y * v[j].y) + (v[j].z * v[j].z + v[j].w * v[j].w); }
    const float rstd = 1.f / sqrtf(wave_sum(s) * (1.f / D) + EPS);
    u32x2* o8 = (u32x2*)orow + lane;
#pragma unroll
    for (int j = 0; j < 16; ++j) { const f32x4 gg = gr[64 * j]; u32x2 w; w.x = pk2(v[j].x * rstd * gg.x, v[j].y * rstd * gg.y); w.y = pk2(v[j].z * rstd * gg.z, v[j].w * rstd * gg.w); o8[64 * j] = w; }
}
DI void rms_row_both(const float* xrow, const float* g, bf16* orow, unsigned char* o8row, int lane) {
    const f32x4* xr = (const f32x4*)xrow + lane; const f32x4* gr = (const f32x4*)g + lane;
    f32x4 v[16]; float s = 0.f;
#pragma unroll
    for (int j = 0; j < 16; ++j) { v[j] = xr[64 * j]; s += (v[j].x * v[j].x + v[j].y * v[j].y) + (v[j].z * v[j].z + v[j].w * v[j].w); }
    const float rstd = 1.f / sqrtf(wave_sum(s) * (1.f / D) + EPS);
    u32x2* o8 = (u32x2*)orow + lane; unsigned* o4 = (unsigned*)o8row + lane;
#pragma unroll
    for (int j = 0; j < 16; ++j) { const f32x4 gg = gr[64 * j]; const float y0 = v[j].x * rstd * gg.x, y1 = v[j].y * rstd * gg.y, y2 = v[j].z * rstd * gg.z, y3 = v[j].w * rstd * gg.w;
        u32x2 w; w.x = pk2(y0, y1); w.y = pk2(y2, y3); o8[64 * j] = w; o4[64 * j] = pk4_fp8(y0, y1, y2, y3); }
}
DI void rms_phase(const float* x, const float* g, bf16* H, int gw, int ngw, int lane) {
    for (int m = gw; m < T; m += ngw) rms_row(x + (size_t)m * D, g, H + (size_t)m * D, lane);
}

DI void s5_build(const PA& a, LAS unsigned char* lds, int g, int tid) {
    LAS float* lam = (LAS float*)lds;
    LAS float* ang = lam + 64;
    LAS float* fre = ang + 64; LAS float* fim = fre + 64;
    LAS float* bbr = fim + 64; LAS float* bbi = bbr + 1024;
    LAS float* ccr = bbi + 1024; LAS float* cci = ccr + 1024;
    LAS float* pwr = cci + 1024; LAS float* pwi = pwr + 33 * 64;
    LAS float* km = pwi + 33 * 64;
    bf16* BT13 = (bf16*)(a.ws + WS_BT13) + (size_t)g * 512 * UCLD; bf16* BTE = (bf16*)(a.ws + WS_BTE) + (size_t)g * 256 * 512;
    float* PW32 = (float*)(a.ws + WS_PW32) + (size_t)g * 128;
    __syncthreads();
    if (tid < 64) { const int p = tid; const float step = expf(inp(a, I_S5LS)[g]); const float lr = inp(a, I_S5ARE)[g * 64 + p], li = inp(a, I_S5AIM)[g * 64 + p];
        const float mag = expf(lr * step), ar = mag * cosf(li * step), ai = mag * sinf(li * step), den = lr * lr + li * li, nr = ar - 1.f;
        lam[p] = lr * step; ang[p] = li * step; fre[p] = (nr * lr + ai * li) / den; fim[p] = (ai * lr - nr * li) / den; }
    __syncthreads();
    for (int i = tid; i < 1024; i += 512) { const int p = i >> 4; const float br = inp(a, I_S5BRE)[(size_t)g * 1024 + i], bi = inp(a, I_S5BIM)[(size_t)g * 1024 + i];
        bbr[i] = fre[p] * br - fim[p] * bi; bbi[i] = fre[p] * bi + fim[p] * br;
        ccr[i] = inp(a, I_S5CRE)[(size_t)g * 1024 + i]; cci[i] = inp(a, I_S5CIM)[(size_t)g * 1024 + i]; }
    for (int i = tid; i < 33 * 64; i += 512) { const int tau = i >> 6, p = i & 63; const float m = expf(lam[p] * (float)tau), an = ang[p] * (float)tau; pwr[i] = m * cosf(an); pwi[i] = m * sinf(an); }
    __syncthreads();
    if (tid < 64) { PW32[tid] = pwr[32 * 64 + tid]; PW32[64 + tid] = pwi[32 * 64 + tid]; }
    for (int i = tid; i < 8192; i += 512) { const int tau = i >> 8, c2 = (i >> 4) & 15, c = i & 15; float s = 0.f;
        for (int p = 0; p < 64; ++p) { const float cr = ccr[c2 * 64 + p], ci = cci[c2 * 64 + p], pr = pwr[tau * 64 + p], pi = pwi[tau * 64 + p];
            const float wr_ = cr * pr - ci * pi, wi_ = cr * pi + ci * pr; s += wr_ * bbr[p * 16 + c] - wi_ * bbi[p * 16 + c]; }
        km[i] = s; }
    __syncthreads();
    for (int q = tid; q < 512 * 80; q += 512) { const int row = q / 80, col0 = (q % 80) * 8, t = row >> 4, c2 = row & 15; float v[8];
        if (col0 < 512) { const int j = col0 >> 4, c0 = col0 & 15, tau = t - j;
#pragma unroll
            for (int e = 0; e < 8; ++e) v[e] = tau >= 0 ? km[tau * 256 + c2 * 16 + c0 + e] : 0.f; }
        else {
#pragma unroll
            for (int e = 0; e < 8; ++e) { const int pp = col0 - 512 + e, p = pp & 63; const float cr = ccr[c2 * 64 + p], ci = cci[c2 * 64 + p], pr = pwr[(t + 1) * 64 + p], pi = pwi[(t + 1) * 64 + p];
                v[e] = pp < 64 ? (cr * pr - ci * pi) : -(cr * pi + ci * pr); } }
        u32x4 w; w.x = pk2(v[0], v[1]); w.y = pk2(v[2], v[3]); w.z = pk2(v[4], v[5]); w.w = pk2(v[6], v[7]);
        *(u32x4*)(BT13 + (size_t)row * UCLD + col0) = w; }
    for (int q = tid; q < 256 * 64; q += 512) { const int row = q >> 6, col0 = (q & 63) * 8, j = col0 >> 4, c0 = col0 & 15; float v[8];
        if (row < 128) { const int p = row & 63, ri = row >> 6; const float pr = pwr[(31 - j) * 64 + p], pi = pwi[(31 - j) * 64 + p];
#pragma unroll
            for (int e = 0; e < 8; ++e) { const float br = bbr[p * 16 + c0 + e], bi = bbi[p * 16 + c0 + e]; v[e] = ri == 0 ? (pr * br - pi * bi) : (pr * bi + pi * br); } }
        else {
#pragma unroll
            for (int e = 0; e < 8; ++e) v[e] = 0.f; }
        u32x4 w; w.x = pk2(v[0], v[1]); w.y = pk2(v[2], v[3]); w.z = pk2(v[4], v[5]); w.w = pk2(v[6], v[7]);
        *(u32x4*)(BTE + (size_t)row * 512 + col0) = w; }
    __syncthreads();
}

DI void s5_scan(const PA& a, LAS unsigned char* lds, int g, int tid) {
    const int p = tid & 63, seg = tid >> 6;
    const float* E = (const float*)(a.ws + WS_E) + ((size_t)(g * S5NC + seg * 32)) * 128 + p;
    const float* PW32 = (const float*)(a.ws + WS_PW32) + (size_t)g * 128;
    bf16* UC = (bf16*)(a.ws + WS_UC) + ((size_t)(g * S5NC + seg * 32)) * UCLD + 512 + p;
    LAS float* se = (LAS float*)lds;
    const float Ar = PW32[p], Ai = PW32[64 + p];
    float er[32], ei[32];
#pragma unroll
    for (int k = 0; k < 32; ++k) { er[k] = E[(size_t)k * 128]; ei[k] = E[(size_t)k * 128 + 64]; }
    float sr = 0.f, si = 0.f;
#pragma unroll
    for (int k = 0; k < 32; ++k) { const float nr = Ar * sr - Ai * si + er[k], ni = Ar * si + Ai * sr + ei[k]; sr = nr; si = ni; }
    __syncthreads();
    se[(seg * 64 + p) * 2] = sr; se[(seg * 64 + p) * 2 + 1] = si;
    float Pr = Ar, Pi = Ai;
#pragma unroll
    for (int k = 0; k < 5; ++k) { const float nr = Pr * Pr - Pi * Pi, ni = 2.f * Pr * Pi; Pr = nr; Pi = ni; }
    __syncthreads();
    float cr = 0.f, ci = 0.f;
    for (int s2 = 0; s2 < seg; ++s2) { const float xr = se[(s2 * 64 + p) * 2], xi = se[(s2 * 64 + p) * 2 + 1]; const float nr = Pr * cr - Pi * ci + xr, ni = Pr * ci + Pi * cr + xi; cr = nr; ci = ni; }
#pragma unroll
    for (int k = 0; k < 32; ++k) { UC[(size_t)k * UCLD] = (bf16)(pk2(cr, 0.f) & 0xffffu); UC[(size_t)k * UCLD + 64] = (bf16)(pk2(ci, 0.f) & 0xffffu);
        const float nr = Ar * cr - Ai * ci + er[k], ni = Ar * ci + Ai * cr + ei[k]; cr = nr; ci = ni; }
    __syncthreads();
}

DI void v_transpose_tile(const bf16* Vsrc, int ld, bf16* dst, int dpitch, int t0, int c0, LAS unsigned char* lds, int tid) {
    LAS bf16* tile = (LAS bf16*)lds;
    __syncthreads();
#pragma unroll
    for (int i = 0; i < 4; ++i) { const int q = tid + 512 * i, tt = q >> 5, d0 = (q & 31) * 8; const u32x4 v = *(const u32x4*)(Vsrc + (size_t)(t0 + tt) * ld + d0);
        tile[(d0 + 0) * 72 + tt] = (bf16)(v.x & 0xffffu); tile[(d0 + 1) * 72 + tt] = (bf16)(v.x >> 16); tile[(d0 + 2) * 72 + tt] = (bf16)(v.y & 0xffffu); tile[(d0 + 3) * 72 + tt] = (bf16)(v.y >> 16);
        tile[(d0 + 4) * 72 + tt] = (bf16)(v.z & 0xffffu); tile[(d0 + 5) * 72 + tt] = (bf16)(v.z >> 16); tile[(d0 + 6) * 72 + tt] = (bf16)(v.w & 0xffffu); tile[(d0 + 7) * 72 + tt] = (bf16)(v.w >> 16); }
    __syncthreads();
#pragma unroll
    for (int i = 0; i < 4; ++i) { const int q = tid + 512 * i, dv = q >> 3, cc = q & 7; const u32x4 v = *(const LAS u32x4*)(tile + dv * 72 + cc * 8);
        *(u32x4*)(dst + (size_t)dv * dpitch + c0 + cc * 8) = v; }
}

DI void ret_prep_item(const PA& a, LAS unsigned char* lds, int item, int tid) {
    const int h = item & 7, t0 = (item >> 3) * 64, ch = t0 >> 8, jl0 = t0 & 255, bz = h * 32 + ch;
    const bf16* Z = (const bf16*)(a.ws + WS_Z); bf16* QR = (bf16*)(a.ws + WS_QR); bf16* KR = (bf16*)(a.ws + WS_KR);
    bf16* SQ = (bf16*)(a.ws + WS_SQ) + (size_t)bz * 256 * 512; bf16* VS = (bf16*)(a.ws + WS_VS) + (size_t)bz * 256 * 512; bf16* KDT = (bf16*)(a.ws + WS_KDT) + (size_t)h * RHD * T;
    LAS bf16* tile = (LAS bf16*)lds;
    const float lg2 = log2f(1.f - exp2f(-5.f - (float)h));
    __syncthreads();
#pragma unroll
    for (int i = 0; i < 2; ++i) { const int q = tid + 512 * i, tt = q >> 4, i0 = (q & 15) * 8, t = t0 + tt, jl = jl0 + tt;
        const float qdec = __builtin_amdgcn_exp2f(lg2 * (float)(jl + 1)), kdec = __builtin_amdgcn_exp2f(lg2 * (float)(255 - jl));
        float cs[8], sn[8];
#pragma unroll
        for (int e = 0; e < 8; ++e) { const float fr_ = expf(-(float)(i0 + e) * (9.210340371976184f / 128.f));
            const float rev = __builtin_amdgcn_fractf((float)t * fr_ * 0.15915494309189535f); sn[e] = __builtin_amdgcn_sinf(rev); cs[e] = __builtin_amdgcn_cosf(rev); }
#pragma unroll
        for (int which = 0; which < 2; ++which) { const bf16* src = Z + (size_t)t * ZW + which * RW + h * RHD + i0; bf16* dst = (which ? KR : QR) + (size_t)t * RW + h * RHD + i0; const float sc = which ? 0.0625f : 1.f;
            const u32x4 x1 = *(const u32x4*)src, x2 = *(const u32x4*)(src + 128); float a1[8], a2[8];
            a1[0] = bflo(x1.x); a1[1] = bfhi(x1.x); a1[2] = bflo(x1.y); a1[3] = bfhi(x1.y); a1[4] = bflo(x1.z); a1[5] = bfhi(x1.z); a1[6] = bflo(x1.w); a1[7] = bfhi(x1.w);
            a2[0] = bflo(x2.x); a2[1] = bfhi(x2.x); a2[2] = bflo(x2.y); a2[3] = bfhi(x2.y); a2[4] = bflo(x2.z); a2[5] = bfhi(x2.z); a2[6] = bflo(x2.w); a2[7] = bfhi(x2.w);
            float o1[8], o2[8];
#pragma unroll
            for (int e = 0; e < 8; ++e) { o1[e] = (a1[e] * cs[e] - a2[e] * sn[e]) * sc; o2[e] = (a1[e] * sn[e] + a2[e] * cs[e]) * sc; }
            u32x4 w1, w2; w1.x = pk2(o1[0], o1[1]); w1.y = pk2(o1[2], o1[3]); w1.z = pk2(o1[4], o1[5]); w1.w = pk2(o1[6], o1[7]);
            w2.x = pk2(o2[0], o2[1]); w2.y = pk2(o2[2], o2[3]); w2.z = pk2(o2[4], o2[5]); w2.w = pk2(o2[6], o2[7]);
            *(u32x4*)dst = w1; *(u32x4*)(dst + 128) = w2;
            if (which == 0) { u32x4 d1, d2; d1.x = pk2(o1[0] * qdec, o1[1] * qdec); d1.y = pk2(o1[2] * qdec, o1[3] * qdec); d1.z = pk2(o1[4] * qdec, o1[5] * qdec); d1.w = pk2(o1[6] * qdec, o1[7] * qdec);
                d2.x = pk2(o2[0] * qdec, o2[1] * qdec); d2.y = pk2(o2[2] * qdec, o2[3] * qdec); d2.z = pk2(o2[4] * qdec, o2[5] * qdec); d2.w = pk2(o2[6] * qdec, o2[7] * qdec);
                bf16* sq = SQ + (size_t)jl * 512 + 256 + i0; *(u32x4*)sq = d1; *(u32x4*)(sq + 128) = d2; }
            else {
#pragma unroll
                for (int e = 0; e < 8; e += 2) { const unsigned p1 = pk2(o1[e] * kdec, o1[e + 1] * kdec), p2 = pk2(o2[e] * kdec, o2[e + 1] * kdec);
                    tile[(i0 + e) * 72 + tt] = (bf16)(p1 & 0xffffu); tile[(i0 + e + 1) * 72 + tt] = (bf16)(p1 >> 16); tile[(128 + i0 + e) * 72 + tt] = (bf16)(p2 & 0xffffu); tile[(128 + i0 + e + 1) * 72 + tt] = (bf16)(p2 >> 16); } } } }
    __syncthreads();
#pragma unroll
    for (int i = 0; i < 4; ++i) { const int q = tid + 512 * i, d = q >> 3, cc = q & 7; const u32x4 v = *(const LAS u32x4*)(tile + d * 72 + cc * 8);
        *(u32x4*)(KDT + (size_t)d * T + t0 + cc * 8) = v; }
    v_transpose_tile(Z + 2 * RW + h * RHD, ZW, VS, 512, t0, jl0, lds, tid);
}

DI void ret_prefix(const PA& a, int e4) {
    const int h = e4 >> 14, rem = e4 & 16383, dv = rem >> 6, dk4 = (rem & 63) * 4;
    const float* KVT = (const float*)(a.ws + WS_KVT) + ((size_t)(h * 32) * 256 + dv) * 256 + dk4;
    bf16* VS = (bf16*)(a.ws + WS_VS) + ((size_t)(h * 32) * 256 + dv) * 512 + 256 + dk4;
    const float g = 1.f - exp2f(-5.f - (float)h), g256 = exp2f(256.f * log2f(g));
    f32x4 st = {0.f, 0.f, 0.f, 0.f};
#pragma unroll 1
    for (int c0 = 0; c0 < 32; c0 += 8) { f32x4 kv[8];
#pragma unroll
        for (int c = 0; c < 8; ++c) kv[c] = *(const f32x4*)(KVT + (size_t)(c0 + c) * 65536);
#pragma unroll
        for (int c = 0; c < 8; ++c) { u32x2 w; w.x = pk2(st[0], st[1]); w.y = pk2(st[2], st[3]); *(u32x2*)(VS + (size_t)(c0 + c) * 131072) = w; st = st * g256 + kv[c]; } }
}

DI void attn_prep_item(const PA& a, LAS unsigned char* lds, int item, int tid) {
    const int h = item & 15, t0 = (item >> 4) * 64, lane = tid & 63, wave = tid >> 6;
    bf16* QKV = (bf16*)(a.ws + WS_QKV); bf16* VT1 = (bf16*)(a.ws + WS_VT1);
    const int l16 = lane & 15, sub = lane >> 4;
    const f32x4 qg0 = *(const f32x4*)(inp(a, I_QNG) + l16 * 8), qg1 = *(const f32x4*)(inp(a, I_QNG) + l16 * 8 + 4), kg0 = *(const f32x4*)(inp(a, I_KNG) + l16 * 8), kg1 = *(const f32x4*)(inp(a, I_KNG) + l16 * 8 + 4);
    for (int it = 0; it < 8; ++it) { const int rr = it * 32 + wave * 4 + sub;
        const int tt = rr >> 2, which = (rr >> 1) & 1, mm = rr & 1;
        bf16* p = QKV + (size_t)(t0 + tt) * QKVW + which * D + (h * 2 + mm) * AHD + l16 * 8;
        const u32x4 x = *(const u32x4*)p; float v[8];
        v[0] = bflo(x.x); v[1] = bfhi(x.x); v[2] = bflo(x.y); v[3] = bfhi(x.y); v[4] = bflo(x.z); v[5] = bfhi(x.z); v[6] = bflo(x.w); v[7] = bfhi(x.w);
        float s = 0.f;
#pragma unroll
        for (int e = 0; e < 8; ++e) s += v[e] * v[e];
        s += __shfl_xor(s, 1); s += __shfl_xor(s, 2); s += __shfl_xor(s, 4); s += __shfl_xor(s, 8);
        const float rs = (1.f / sqrtf(s * (1.f / AHD) + EPS)) * (which ? 1.f : 0.08838834764831845f * LOG2E);
        const f32x4 g0 = which ? kg0 : qg0, g1 = which ? kg1 : qg1;
        u32x4 w; w.x = pk2(v[0] * rs * g0[0], v[1] * rs * g0[1]); w.y = pk2(v[2] * rs * g0[2], v[3] * rs * g0[3]); w.z = pk2(v[4] * rs * g1[0], v[5] * rs * g1[1]); w.w = pk2(v[6] * rs * g1[2], v[7] * rs * g1[3]);
        *(u32x4*)p = w; }
    v_transpose_tile(QKV + 2 * D + h * AVD, QKVW, VT1 + (size_t)h * AVD * T, T, t0, t0, lds, tid);
}

template <int DQK, int MODE, int NDT, bool PF>
DI void flash_pass(LAS unsigned char* lds, const bf16* Qu, const int ldq, const bf16* Ku, const int ldk, const bf16* VTh, const int dvoff, const int qw0, const int qwl, const int nkt,
                   const float lg2, const LAS float* btab, f32x16 (&O)[NDT], float& l_out) {
    constexpr int KPB = (DQK + 8) * 2, VT_OFF = 64 * KPB, VPB = 136, CPR = DQK / 8, NKI = (64 * CPR) / 512;
    int tid = threadIdx.x; asm volatile("" : "+v"(tid));
    const int lane = tid & 63, r = lane & 31, h = lane >> 5;
    bf16x8 qf[DQK / 16];
    { const unsigned qoff = (unsigned)(r * ldq + 8 * h) * 2u;
#pragma unroll
      for (int s = 0; s < DQK / 16; ++s) qf[s] = *(const bf16x8*)((const char*)Qu + qoff + 32 * s); }
#pragma unroll
    for (int dt = 0; dt < NDT; ++dt)
#pragma unroll
        for (int i = 0; i < 16; ++i) O[dt][i] = 0.f;
    float m_run = -1e30f, l_run = 0.f;
    const int qi = qwl + r;
    const unsigned kgo = (unsigned)((tid / CPR) * ldk + (tid % CPR) * 8) * 2u, klo = (unsigned)((tid / CPR) * KPB + (tid % CPR) * 16);
    const unsigned vgo = (unsigned)((tid >> 3) * T + (tid & 7) * 8) * 2u, vlo = (unsigned)(VT_OFF + (tid >> 3) * VPB + (tid & 7) * 16);
    const unsigned ka = (unsigned)(r * KPB + 16 * h), va_ = (unsigned)(VT_OFF + (dvoff + r) * VPB + 8 * h);
    const __amdgpu_buffer_rsrc_t krs = __builtin_amdgcn_make_buffer_rsrc((void*)Ku, 0, 0x7ffffff0, 0x00020000);
    const __amdgpu_buffer_rsrc_t vrs = __builtin_amdgcn_make_buffer_rsrc((void*)VTh, 0, 0x7ffffff0, 0x00020000);
    u32x4 kreg[NKI], vreg[4];
    if (PF) {
#pragma unroll
        for (int i = 0; i < NKI; ++i) kreg[i] = __builtin_amdgcn_raw_buffer_load_b128(krs, kgo, (i * (512 / CPR)) * ldk * 2, 0);
#pragma unroll
        for (int i = 0; i < 4; ++i) vreg[i] = __builtin_amdgcn_raw_buffer_load_b128(vrs, vgo, i * 64 * T * 2, 0);
    }
    for (int kt = 0; kt < nkt; ++kt) {
        const int k0 = kt * 64;
        __syncthreads();
        if (!PF) {
#pragma unroll
            for (int i = 0; i < NKI; ++i) { const u32x4 v = __builtin_amdgcn_raw_buffer_load_b128(krs, kgo, (k0 + i * (512 / CPR)) * ldk * 2, 0); *(LAS u32x4*)(lds + klo + i * (512 / CPR) * KPB) = v; }
#pragma unroll
            for (int i = 0; i < 4; ++i) { const u32x4 v = __builtin_amdgcn_raw_buffer_load_b128(vrs, vgo, k0 * 2 + i * 64 * T * 2, 0); LAS u32x2* d = (LAS u32x2*)(lds + vlo + i * 64 * VPB);
                u32x2 lo; lo.x = v.x; lo.y = v.y; u32x2 hi; hi.x = v.z; hi.y = v.w; d[0] = lo; d[1] = hi; }
        } else {
#pragma unroll
            for (int i = 0; i < NKI; ++i) *(LAS u32x4*)(lds + klo + i * (512 / CPR) * KPB) = kreg[i];
#pragma unroll
            for (int i = 0; i < 4; ++i) { LAS u32x2* d = (LAS u32x2*)(lds + vlo + i * 64 * VPB);
                u32x2 lo; lo.x = vreg[i].x; lo.y = vreg[i].y; u32x2 hi; hi.x = vreg[i].z; hi.y = vreg[i].w; d[0] = lo; d[1] = hi; }
        }
        __syncthreads();
        if (PF && kt + 1 < nkt) {
#pragma unroll
            for (int i = 0; i < NKI; ++i) kreg[i] = __builtin_amdgcn_raw_buffer_load_b128(krs, kgo, (k0 + 64 + i * (512 / CPR)) * ldk * 2, 0);
#pragma unroll
            for (int i = 0; i < 4; ++i) vreg[i] = __builtin_amdgcn_raw_buffer_load_b128(vrs, vgo, (k0 + 64) * 2 + i * 64 * T * 2, 0);
        }
        if (k0 <= qw0 + 31) {
            f32x16 st0, st1;
#pragma unroll
            for (int i = 0; i < 16; ++i) { st0[i] = 0.f; st1[i] = 0.f; }
#pragma unroll
            for (int s = 0; s < DQK / 16; ++s) {
                const bf16x8 a0 = *(const LAS bf16x8*)(lds + ka + 32 * s);
                const bf16x8 a1 = *(const LAS bf16x8*)(lds + ka + 32 * KPB + 32 * s);
                st0 = __builtin_amdgcn_mfma_f32_32x32x16_bf16(a0, qf[s], st0, 0, 0, 0);
                st1 = __builtin_amdgcn_mfma_f32_32x32x16_bf16(a1, qf[s], st1, 0, 0, 0);
                if ((s & 3) == 3) __builtin_amdgcn_sched_barrier(0);
            }
            const int dbase = qi - k0 - 4 * h;
            if (MODE == 0) {
#pragma unroll
                for (int i = 0; i < 16; ++i) { const int d0 = dbase - ((i & 3) + 8 * (i >> 2)), d1 = d0 - 32;
                    const float e0 = __builtin_amdgcn_exp2f(lg2 * (float)d0), e1 = __builtin_amdgcn_exp2f(lg2 * (float)d1);
                    st0[i] = d0 >= 0 ? st0[i] * e0 : 0.f; st1[i] = d1 >= 0 ? st1[i] * e1 : 0.f; }
            } else {
                if (k0 + 63 + 127 <= qw0) { const float c = btab[96 + 127];
#pragma unroll
                    for (int i = 0; i < 16; ++i) { st0[i] += c; st1[i] += c; } }
                else {
#pragma unroll
                    for (int i = 0; i < 16; ++i) { const int d0 = dbase - ((i & 3) + 8 * (i >> 2)) + 96, d1 = d0 - 32;
                        const float b0 = btab[d0 > 223 ? 223 : d0], b1 = btab[d1 > 223 ? 223 : d1];
                        st0[i] += b0; st1[i] += b1; } }
                float mx = fmaxf(st0[0], st1[0]);
#pragma unroll
                for (int i = 1; i < 16; ++i) mx = fmaxf(mx, fmaxf(st0[i], st1[i]));
                mx = fmaxf(mx, __shfl_xor(mx, 32));
                const float m_new = fmaxf(m_run, mx), alpha = __builtin_amdgcn_exp2f(m_run - m_new); m_run = m_new;
                float ps = 0.f;
#pragma unroll
                for (int i = 0; i < 16; ++i) { st0[i] = __builtin_amdgcn_exp2f(st0[i] - m_new); st1[i] = __builtin_amdgcn_exp2f(st1[i] - m_new); ps += st0[i] + st1[i]; }
                ps += __shfl_xor(ps, 32);
                l_run = l_run * alpha + ps;
#pragma unroll
                for (int dt = 0; dt < NDT; ++dt)
#pragma unroll
                    for (int i = 0; i < 16; ++i) O[dt][i] *= alpha;
            }
            __builtin_amdgcn_sched_barrier(0);
#pragma unroll
            for (int mt = 0; mt < 2; ++mt)
#pragma unroll
                for (int s2 = 0; s2 < 2; ++s2) {
                    u32x4 pw;
                    if (mt == 0) { pw.x = pk2(st0[8 * s2 + 0], st0[8 * s2 + 1]); pw.y = pk2(st0[8 * s2 + 2], st0[8 * s2 + 3]); pw.z = pk2(st0[8 * s2 + 4], st0[8 * s2 + 5]); pw.w = pk2(st0[8 * s2 + 6], st0[8 * s2 + 7]); }
                    else         { pw.x = pk2(st1[8 * s2 + 0], st1[8 * s2 + 1]); pw.y = pk2(st1[8 * s2 + 2], st1[8 * s2 + 3]); pw.z = pk2(st1[8 * s2 + 4], st1[8 * s2 + 5]); pw.w = pk2(st1[8 * s2 + 6], st1[8 * s2 + 7]); }
                    const bf16x8 pb = __builtin_bit_cast(bf16x8, pw);
#pragma unroll
                    for (int dt = 0; dt < NDT; ++dt) {
                        const LAS unsigned char* vp = lds + va_ + (32 * dt) * VPB + (32 * mt + 16 * s2) * 2;
                        const s16x4 lo = *(const LAS s16x4*)vp, hi = *(const LAS s16x4*)(vp + 16);
                        const bf16x8 va = __builtin_shufflevector(lo, hi, 0, 1, 2, 3, 4, 5, 6, 7);
                        O[dt] = __builtin_amdgcn_mfma_f32_32x32x16_bf16(va, pb, O[dt], 0, 0, 0);
                        if ((dt & 3) == 3) __builtin_amdgcn_sched_barrier(0);
                    }
                }
        }
    }
    l_out = l_run;
}
constexpr int FL_SCR_OFF = 64 * (256 + 8) * 2 + 256 * 136;

namespace dfa {
constexpr int KB0 = 0, VB0 = 16384, KB1 = 49152, VB1 = 65536, BT_OFF = 98304, XM_OFF = 99328, XP_OFF = 101376;
DI void dma16(const __amdgpu_buffer_rsrc_t rs, const unsigned voff, const unsigned soff, LAS unsigned char* ldst) { __builtin_amdgcn_raw_ptr_buffer_load_lds(rs, (LAS void*)ldst, 16, (int)voff, (int)soff, 0, 0); }
DI void stage_k(LAS unsigned char* lds, const int KB, const __amdgpu_buffer_rsrc_t rs, const unsigned soff, const unsigned (&ko)[2], int wave) {
#pragma unroll
    for (int i = 0; i < 2; ++i) dma16(rs, ko[i], soff, lds + KB + (2 * wave + i) * 1024);
}
DI void stage_v(LAS unsigned char* lds, const int VB, const __amdgpu_buffer_rsrc_t rs, const unsigned soff, const unsigned (&vo)[4], int wave) {
#pragma unroll
    for (int i = 0; i < 4; ++i) dma16(rs, vo[i], soff, lds + VB + (4 * wave + i) * 1024);
}
#define DFA_BAR() do { asm volatile("s_waitcnt lgkmcnt(0)" ::: "memory"); __builtin_amdgcn_s_barrier(); asm volatile("" ::: "memory"); } while (0)
template <bool WANT_MAX>
DI float s_tile(LAS unsigned char* lds, const unsigned kb, const bf16x8 (&qf)[8], f32x16& st, const unsigned A0, const int duni, const bool far_, const int lane) {
    const LAS float* btab = (const LAS float*)(lds + BT_OFF);
#pragma unroll
    for (int i = 0; i < 16; ++i) st[i] = 0.f;
    bf16x8 ka[8];
    unsigned a0 = A0; asm volatile("" : "+v"(a0));
#pragma unroll
    for (int s = 0; s < 8; ++s) ka[s] = *(const LAS bf16x8*)(lds + kb + (a0 ^ (32u * s)));
    __builtin_amdgcn_sched_barrier(0);
#pragma unroll
    for (int s = 0; s < 8; ++s) st = __builtin_amdgcn_mfma_f32_32x32x16_bf16(ka[s], qf[s], st, 0, 0, 0);
    __builtin_amdgcn_sched_barrier(0);
    if (!far_) { int ln = lane; asm volatile("" : "+v"(ln));
        const int db = (ln & 31) - 8 * (ln >> 5) + duni;
#pragma unroll
        for (int i = 0; i < 16; ++i) { const int d0 = db - ((i & 3) + 4 * ((i >> 2) & 1) + 16 * (i >> 3)); st[i] += btab[d0 > 223 ? 223 : d0]; } }
    if (!WANT_MAX) return 0.f;
    float mx = st[0];
#pragma unroll
    for (int i = 1; i < 16; ++i) mx = fmaxf(mx, st[i]);
    { float lo, hi; swap32(mx, lo, hi); mx = fmaxf(lo, hi); }
    return mx;
}
DI float p_tile(LAS unsigned char* lds, const unsigned xpn, f32x16& st, const float m, u32x4& pn0, u32x4& pn1, const int wave, const int lane) {
    float ps = 0.f;
#pragma unroll
    for (int i = 0; i < 16; ++i) { st[i] = __builtin_amdgcn_exp2f(st[i] - m); ps += st[i]; }
    { float lo, hi; swap32(ps, lo, hi); ps = lo + hi; }
    pn0.x = pk2(st[0], st[1]); pn0.y = pk2(st[2], st[3]); pn0.z = pk2(st[4], st[5]); pn0.w = pk2(st[6], st[7]);
    pn1.x = pk2(st[8], st[9]); pn1.y = pk2(st[10], st[11]); pn1.z = pk2(st[12], st[13]); pn1.w = pk2(st[14], st[15]);
    *(LAS u32x4*)(lds + xpn + ((wave * 2 + 0) * 64 + lane) * 16) = pn0;
    *(LAS u32x4*)(lds + xpn + ((wave * 2 + 1) * 64 + lane) * 16) = pn1;
    return ps;
}
DI void first(LAS unsigned char* lds, const bf16x8 (&qf)[8], float& m_run, float& l_run, float& mx, u32x4& pw0, u32x4& pw1, const unsigned A0, const int duni, const bool far_, const int wave, const int lane) {
    const int r = lane & 31, role = wave & 1;
    f32x16 st;
    mx = s_tile<true>(lds, (unsigned)(KB0 + 8192 * role), qf, st, A0, duni, far_, lane);
    *(LAS float*)(lds + XM_OFF + (wave * 32 + r) * 4) = mx;
    DFA_BAR();
    m_run = fmaxf(mx, *(const LAS float*)(lds + XM_OFF + ((wave ^ 1) * 32 + r) * 4));
    l_run = p_tile(lds, (unsigned)XP_OFF, st, m_run, pw0, pw1, wave, lane);
}
DI void iter(LAS unsigned char* lds, const int KBn, const int VB, const int par, const bf16x8 (&qf)[8], f32x16 (&O)[4], float& m_run, float& l_run, float& mx, u32x4& pw0, u32x4& pw1,
             const unsigned A0, const unsigned B0, const int duni_n, const bool far_n, const bool act, const bool act_n, const int wave, const int lane,
             const __amdgpu_buffer_rsrc_t krs, const unsigned ksoff, const int kdst, const unsigned (&ko)[2]) {
    const int r = lane & 31, role = wave & 1;
    if (!act) { stage_k(lds, kdst, krs, ksoff, ko, wave); return; }
    const unsigned xpo = (unsigned)(XP_OFF + par * 16384), xpn = (unsigned)(XP_OFF + 16384 - par * 16384), xmo = (unsigned)(XM_OFF + par * 1024), xmn = (unsigned)(XM_OFF + 1024 - par * 1024);
    const float m_new = fmaxf(m_run, fmaxf(mx, *(const LAS float*)(lds + xmo + ((wave ^ 1) * 32 + r) * 4)));
    const unsigned vbase = (unsigned)(VB + 16384 * role);
    const unsigned mtA = 64u * role, mtB = 64u - mtA;
    float ps = 0.f;
    {
        f32x16 st; bf16x8 ka[8];
        if (act_n) { unsigned a0 = A0; asm volatile("" : "+v"(a0)); const unsigned kb = (unsigned)(KBn + 8192 * role);
#pragma unroll
            for (int s = 0; s < 8; ++s) ka[s] = *(const LAS bf16x8*)(lds + kb + (a0 ^ (32u * s))); }
        bf16x8 va[8], vb[8];
#pragma unroll
        for (int j = 0; j < 4; ++j) va[j] = *(const LAS bf16x8*)(lds + 4096 * (j & 3) + vbase + (B0 ^ (mtA + 32u * (j >> 2))));
        __builtin_amdgcn_sched_barrier(0);
        if (act_n) {
#pragma unroll
            for (int i = 0; i < 16; ++i) st[i] = 0.f;
#pragma unroll
            for (int s = 0; s < 8; ++s) st = __builtin_amdgcn_mfma_f32_32x32x16_bf16(ka[s], qf[s], st, 0, 0, 0);
            __builtin_amdgcn_sched_barrier(0);
            if (!far_n) { int ln = lane; asm volatile("" : "+v"(ln)); const int db = (ln & 31) - 8 * (ln >> 5) + duni_n; const LAS float* btab = (const LAS float*)(lds + BT_OFF);
#pragma unroll
                for (int i = 0; i < 16; ++i) { const int d0 = db - ((i & 3) + 4 * ((i >> 2) & 1) + 16 * (i >> 3)); st[i] += btab[d0 > 223 ? 223 : d0]; } }
        } else asm volatile("" : "=v"(st));
        stage_k(lds, kdst, krs, ksoff, ko, wave);
        __builtin_amdgcn_sched_barrier(0);
#pragma unroll
        for (int j = 4; j < 8; ++j) va[j] = *(const LAS bf16x8*)(lds + 4096 * (j & 3) + vbase + (B0 ^ (mtA + 32u * (j >> 2))));
        const u32x4 qw0_ = *(const LAS u32x4*)(lds + xpo + (((wave ^ 1) * 2 + 0) * 64 + lane) * 16);
        const u32x4 qw1_ = *(const LAS u32x4*)(lds + xpo + (((wave ^ 1) * 2 + 1) * 64 + lane) * 16);
        __builtin_amdgcn_sched_barrier(0);
        u32x4 pn0, pn1; float pe[16]; float mxn = -3.0e38f;
#pragma unroll
        for (int j = 0; j < 8; ++j) {
            O[j & 3] = __builtin_amdgcn_mfma_f32_32x32x16_bf16(va[j], __builtin_bit_cast(bf16x8, (j >> 2) ? pw1 : pw0), O[j & 3], 0, 0, 0);
            vb[j] = *(const LAS bf16x8*)(lds + 4096 * (j & 3) + vbase + (B0 ^ (mtB + 32u * (j >> 2))));
            pe[j] = __builtin_amdgcn_exp2f(st[j] - m_new); ps += pe[j];
            if (j & 1) pn0[j >> 1] = pk2(pe[j - 1], pe[j]);
            __builtin_amdgcn_sched_barrier(0);
        }
#pragma unroll
        for (int j = 0; j < 8; ++j) {
            O[j & 3] = __builtin_amdgcn_mfma_f32_32x32x16_bf16(vb[j], __builtin_bit_cast(bf16x8, (j >> 2) ? qw1_ : qw0_), O[j & 3], 0, 0, 0);
            asm("v_max3_f32 %0, %1, %2, %3" : "=v"(mxn) : "v"(mxn), "v"(st[2 * j]), "v"(st[2 * j + 1]));
            pe[8 + j] = __builtin_amdgcn_exp2f(st[8 + j] - m_new); ps += pe[8 + j];
            if (j & 1) pn1[j >> 1] = pk2(pe[8 + j - 1], pe[8 + j]);
            if (j == 0) *(LAS u32x4*)(lds + xpn + ((wave * 2 + 0) * 64 + lane) * 16) = pn0;
            __builtin_amdgcn_sched_barrier(0);
        }
        *(LAS u32x4*)(lds + xpn + ((wave * 2 + 1) * 64 + lane) * 16) = pn1;
        { float lo, hi; swap32(mxn, lo, hi); mxn = fmaxf(lo, hi); }
        mxn = act_n ? mxn : -1e30f;
        *(LAS float*)(lds + xmn + (wave * 32 + r) * 4) = mxn;
        mx = mxn;
        { float lo, hi; swap32(ps, lo, hi); ps = lo + hi; }
        pw0 = pn0; pw1 = pn1;
        ps = act_n ? ps : 0.f;
    }
    if (__builtin_amdgcn_ballot_w64(m_new > m_run) != 0ull) {
        const float alpha = __builtin_amdgcn_exp2f(m_run - m_new); l_run *= alpha;
#pragma unroll
        for (int dt = 0; dt < 4; ++dt)
#pragma unroll
            for (int i = 0; i < 16; ++i) O[dt][i] *= alpha;
        m_run = m_new;
    }
    l_run += ps;
}
}

DI void diff_unit(const PA& a, LAS unsigned char* lds, int h, int qb, const float lam, const int wave_) {
    int wave = wave_; asm volatile("" : "+s"(wave));
    int lane; asm volatile("v_mbcnt_lo_u32_b32 %0, -1, 0\n\tv_mbcnt_hi_u32_b32 %0, -1, %0" : "=v"(lane));
    const int tid = wave * 64 + lane;
    const int r = lane & 31, h2 = lane >> 5, pair = wave >> 1, role = wave & 1, q0 = qb * 128, qw0 = q0 + 32 * pair, nkt = (q0 + 128) / 64;
    const bf16* QKV = (const bf16*)(a.ws + WS_QKV); const bf16* VT1 = (const bf16*)(a.ws + WS_VT1);
    LAS float* btab = (LAS float*)(lds + dfa::BT_OFF);
    LAS float* xm = (LAS float*)(lds + dfa::XM_OFF);
    __syncthreads();
    if (tid < 224) { float v = -1e30f;
        if (tid >= 96) { const int n = tid - 96; int bk = n;
            if (n >= 16) { bk = 16 + (n >= 19) + (n >= 21) + (n >= 24) + (n >= 27) + (n >= 31) + (n >= 35) + (n >= 40) + (n >= 46) + (n >= 52) + (n >= 59) + (n >= 67) + (n >= 77) + (n >= 87) + (n >= 99) + (n >= 113); }
            v = (inp(a, I_RELB)[bk * AH + h] - inp(a, I_RELB)[31 * AH + h]) * LOG2E; }
        btab[tid] = v; }
    const int pr = (r & 0x13) | ((r & 4) << 1) | ((r & 8) >> 1);
    const unsigned A0 = (unsigned)(pr * 256) | (unsigned)((h2 ^ (pr & 15)) << 4);
    const unsigned B0 = (unsigned)(r * 128) | (unsigned)((h2 ^ ((r >> 1) & 7)) << 4);
    unsigned ko[2], vo[4];
#pragma unroll
    for (int i = 0; i < 2; ++i) { const int row = 4 * (2 * wave + i) + (lane >> 4), u = (lane & 15) ^ (row & 15); ko[i] = (unsigned)(row * QKVW + u * 8) * 2u; }
#pragma unroll
    for (int i = 0; i < 4; ++i) { const int row = 8 * (4 * wave + i) + (lane >> 3), u = (lane & 7) ^ ((row >> 1) & 7); vo[i] = (unsigned)(row * T + u * 8) * 2u; }
    const int chb = h * AVD + role * 128;
    const __amdgpu_buffer_rsrc_t vrs = __builtin_amdgcn_make_buffer_rsrc((void*)(VT1 + (size_t)h * AVD * T), 0, 0x7fffffff, 0x00020000);
    const int qi = qw0 + r;
    for (int mp = 0; mp < 2; ++mp) {
        const __amdgpu_buffer_rsrc_t krs = __builtin_amdgcn_make_buffer_rsrc((void*)(QKV + D + (h * 2 + mp) * AHD), 0, 0x7fffffff, 0x00020000);
        bf16x8 qf[8];
        { const __amdgpu_buffer_rsrc_t qrs = __builtin_amdgcn_make_buffer_rsrc((void*)(QKV + (h * 2 + mp) * AHD), 0, 0x7fffffff, 0x00020000);
          const int qoff = (r * QKVW + 8 * h2) * 2, qso = qw0 * QKVW * 2;
#pragma unroll
          for (int s = 0; s < 8; ++s) qf[s] = __builtin_bit_cast(bf16x8, __builtin_amdgcn_raw_buffer_load_b128(qrs, qoff + 32 * s, qso, 0)); }
        f32x16 O[4];
#pragma unroll
        for (int dt = 0; dt < 4; ++dt)
#pragma unroll
            for (int i = 0; i < 16; ++i) O[dt][i] = 0.f;
        float m_run = -1e30f, l_run = 0.f;
        asm volatile("s_waitcnt vmcnt(0)" ::: "memory");
        dfa::stage_k(lds, dfa::KB0, krs, 0u, ko, wave); dfa::stage_v(lds, dfa::VB0, vrs, 0u, vo, wave); dfa::stage_k(lds, dfa::KB1, krs, 64u * QKVW * 2u, ko, wave);
        asm volatile("s_waitcnt vmcnt(6)" ::: "memory");
        __builtin_amdgcn_s_barrier(); asm volatile("" ::: "memory");
        float mx; u32x4 pw0, pw1;
        dfa::first(lds, qf, m_run, l_run, mx, pw0, pw1, A0, qw0 - 32 * role + 96, 63 + 127 <= qw0, wave, lane);
#pragma unroll 1
        for (int kt = 0; kt < nkt; ++kt) {
            const int k0 = kt * 64, odd = kt & 1;
            asm volatile("s_waitcnt vmcnt(0)" ::: "memory");
            DFA_BAR();
            if (kt + 1 < nkt) dfa::stage_v(lds, odd ? dfa::VB0 : dfa::VB1, vrs, (unsigned)(k0 + 64) * 2u, vo, wave);
            dfa::iter(lds, odd ? dfa::KB0 : dfa::KB1, odd ? dfa::VB1 : dfa::VB0, odd, qf, O, m_run, l_run, mx, pw0, pw1, A0, B0, qw0 - (k0 + 64) - 32 * role + 96, k0 + 64 + 63 + 127 <= qw0,
                      k0 <= qw0 + 31, (kt + 1 < nkt) && (k0 + 64 <= qw0 + 31), wave, lane, krs, (unsigned)(kt + 2 < nkt ? k0 + 128 : k0) * (QKVW * 2u), odd ? dfa::KB1 : dfa::KB0, ko);
        }
        int l2_ = lane; asm volatile("" : "+v"(l2_));
        const int r2_ = l2_ & 31, h22_ = l2_ >> 5, oo = (r2_ * D + 4 * h22_) * 4, ao = (r2_ * D + 4 * h22_) * 2, so = (4 * h22_) * 4;
        const __amdgpu_buffer_rsrc_t o1_rs = __builtin_amdgcn_make_buffer_rsrc((void*)((float*)(a.ws + WS_O1) + (size_t)qw0 * D + chb), 0, 32 * D * 4, 0x00020000);
        const __amdgpu_buffer_rsrc_t ao_rs = FP8_OWO ? __builtin_amdgcn_make_buffer_rsrc((void*)(a.ws + WS_AO + (size_t)qw0 * D + chb), 0, 32 * D, 0x00020000)
                                                       : __builtin_amdgcn_make_buffer_rsrc((void*)((bf16*)(a.ws + WS_AO) + (size_t)qw0 * D + chb), 0, 32 * D * 2, 0x00020000);
        const __amdgpu_buffer_rsrc_t sg_rs = __builtin_amdgcn_make_buffer_rsrc((void*)(inp(a, I_SUBG) + role * 128), 0, 128 * 4, 0x00020000);
        xm[wave * 32 + r2_] = l_run;
        DFA_BAR();
        const float inv = 1.f / (l_run + xm[(wave ^ 1) * 32 + r2_]);
        if (mp == 0) {
#pragma unroll
            for (int dt = 0; dt < 4; ++dt)
#pragma unroll
                for (int g4 = 0; g4 < 4; ++g4) { const int dvl = 32 * dt + 8 * g4;
                    f32x4 v; v[0] = O[dt][4 * g4] * inv; v[1] = O[dt][4 * g4 + 1] * inv; v[2] = O[dt][4 * g4 + 2] * inv; v[3] = O[dt][4 * g4 + 3] * inv;
                    __builtin_amdgcn_raw_buffer_store_b128(__builtin_bit_cast(u32x4, v), o1_rs, oo + dvl * 4, 0, 0); if (g4 == 3) __builtin_amdgcn_sched_barrier(0); }
            DFA_BAR();
        } else {
            float lam_s = lam; asm volatile("" : "+s"(lam_s));
            const float c2 = lam_s * inv; float ss = 0.f;
#pragma unroll
            for (int dt = 0; dt < 4; ++dt)
#pragma unroll
                for (int g4 = 0; g4 < 4; ++g4) { const int dvl = 32 * dt + 8 * g4; const f32x4 o1 = __builtin_bit_cast(f32x4, __builtin_amdgcn_raw_buffer_load_b128(o1_rs, oo + dvl * 4, 0, 0));
#pragma unroll
                    for (int e = 0; e < 4; ++e) { const float d = o1[e] - c2 * O[dt][4 * g4 + e]; ss += d * d; } __builtin_amdgcn_sched_barrier(0); }
            { float lo, hi; swap32(ss, lo, hi); ss = lo + hi; }
            DFA_BAR();
            xm[wave * 32 + r2_] = ss;
            DFA_BAR();
            ss += xm[(wave ^ 1) * 32 + r2_];
            const float rs = (1.f / sqrtf(ss * (1.f / AVD) + EPS)) * (1.f - LAMBDA_INIT);
#pragma unroll
            for (int dt = 0; dt < 4; ++dt)
#pragma unroll
                for (int g4 = 0; g4 < 4; ++g4) { const int dvl = 32 * dt + 8 * g4; const f32x4 sg = __builtin_bit_cast(f32x4, __builtin_amdgcn_raw_buffer_load_b128(sg_rs, so + dvl * 4, 0, 0));
                    const f32x4 o1 = __builtin_bit_cast(f32x4, __builtin_amdgcn_raw_buffer_load_b128(o1_rs, oo + dvl * 4, 0, 0));
                    const float y0 = (o1[0] - c2 * O[dt][4 * g4]) * rs * sg[0], y1 = (o1[1] - c2 * O[dt][4 * g4 + 1]) * rs * sg[1], y2 = (o1[2] - c2 * O[dt][4 * g4 + 2]) * rs * sg[2], y3 = (o1[3] - c2 * O[dt][4 * g4 + 3]) * rs * sg[3];
                    if (FP8_OWO) __builtin_amdgcn_raw_buffer_store_b32(pk4_fp8(y0, y1, y2, y3), ao_rs, (ao >> 1) + dvl, 0, 0);
                    else { u32x2 w; w.x = pk2(y0, y1); w.y = pk2(y2, y3); __builtin_amdgcn_raw_buffer_store_b64(w, ao_rs, ao + dvl * 2, 0, 0); }
                    __builtin_amdgcn_sched_barrier(0); }
        }
    }
    __syncthreads();
}

DI void peer_topk_process(float a0, float a1, float b0, float b1, int* EIDX, float* GATE, LAS float* scr, int item, int lane) {
    const int tok = item >> 3, hd = item & 7;
    LAS float* sc = scr; LAS float* sv = scr + 64; volatile LAS int* si = (volatile LAS int*)(scr + 96); LAS float* cv = scr + 128; LAS float* fv = scr + 192; volatile LAS int* fi = (volatile LAS int*)(scr + 208);
    typedef unsigned long long u64;
    LAS u64* ck = (LAS u64*)sc;
    const unsigned ua0 = __builtin_bit_cast(unsigned, a0), ua1 = __builtin_bit_cast(unsigned, a1), ub0 = __builtin_bit_cast(unsigned, b0), ub1 = __builtin_bit_cast(unsigned, b1);
    const unsigned ka0 = (ua0 & 0x80000000u) ? ~ua0 : (ua0 | 0x80000000u), ka1 = (ua1 & 0x80000000u) ? ~ua1 : (ua1 | 0x80000000u);
    const unsigned kb0 = (ub0 & 0x80000000u) ? ~ub0 : (ub0 | 0x80000000u), kb1 = (ub1 & 0x80000000u) ? ~ub1 : (ub1 | 0x80000000u);
    unsigned pa = 0u, pb = 0u; bool da = false, db = false;
#pragma unroll 1
    for (int bit = 31; bit >= 0; --bit) {
        const unsigned m = 1u << bit;
        if (!da) { const unsigned t = pa | m; const int c = __builtin_popcountll(__builtin_amdgcn_ballot_w64(ka0 >= t)) + __builtin_popcountll(__builtin_amdgcn_ballot_w64(ka1 >= t)); pa = c >= 16 ? t : pa; da = c == 16; }
        if (!db) { const unsigned t = pb | m; const int c = __builtin_popcountll(__builtin_amdgcn_ballot_w64(kb0 >= t)) + __builtin_popcountll(__builtin_amdgcn_ballot_w64(kb1 >= t)); pb = c >= 16 ? t : pb; db = c == 16; }
        if (da && db) break;
    }
#pragma unroll
    for (int hf = 0; hf < 2; ++hf) {
        const unsigned k0 = hf ? kb0 : ka0, k1 = hf ? kb1 : ka1, p = hf ? pb : pa;
        const bool g0 = k0 > p, g1 = k1 > p, e0 = k0 == p, e1 = k1 == p;
        const u64 E0 = __builtin_amdgcn_ballot_w64(e0), E1 = __builtin_amdgcn_ballot_w64(e1);
        const int need = 16 - __builtin_popcountll(__builtin_amdgcn_ballot_w64(g0)) - __builtin_popcountll(__builtin_amdgcn_ballot_w64(g1));
        const int ne0 = (int)__builtin_amdgcn_mbcnt_hi((unsigned)(E0 >> 32), __builtin_amdgcn_mbcnt_lo((unsigned)E0, 0u));
        const int ne1 = __builtin_popcountll(E0) + (int)__builtin_amdgcn_mbcnt_hi((unsigned)(E1 >> 32), __builtin_amdgcn_mbcnt_lo((unsigned)E1, 0u));
        const bool s0 = g0 || (e0 && ne0 < need), s1 = g1 || (e1 && ne1 < need);
        const u64 S0 = __builtin_amdgcn_ballot_w64(s0), S1 = __builtin_amdgcn_ballot_w64(s1);
        const int p0 = (int)__builtin_amdgcn_mbcnt_hi((unsigned)(S0 >> 32), __builtin_amdgcn_mbcnt_lo((unsigned)S0, 0u));
        const int p1 = __builtin_popcountll(S0) + (int)__builtin_amdgcn_mbcnt_hi((unsigned)(S1 >> 32), __builtin_amdgcn_mbcnt_lo((unsigned)S1, 0u));
        if (s0) ck[hf * 16 + (p0 & 15)] = ((u64)k0 << 32) | (unsigned)(127 - lane);
        if (s1) ck[hf * 16 + (p1 & 15)] = ((u64)k1 << 32) | (unsigned)(63 - lane);
    }
    if (lane < 32) { const int hf = lane >> 4; const u64 mine = ck[lane]; int rk = 0;
#pragma unroll
        for (int j = 0; j < 16; ++j) rk += ck[hf * 16 + j] > mine ? 1 : 0;
        const unsigned k = (unsigned)(mine >> 32), u = (k & 0x80000000u) ? (k & 0x7fffffffu) : ~k;
        sv[hf * 16 + rk] = __builtin_bit_cast(float, u); si[hf * 16 + rk] = 127 - (int)(unsigned)mine; }
    int ca = 0;
    ca = lane >= 16 ? 1 : ca; ca = lane >= 24 ? 2 : ca; ca = lane >= 29 ? 3 : ca; ca = lane >= 33 ? 4 : ca; ca = lane >= 36 ? 5 : ca; ca = lane >= 38 ? 6 : ca; ca = lane >= 40 ? 7 : ca;
    ca = lane >= 42 ? lane - 34 : ca; ca = ca > 15 ? 15 : ca;
    int base = 0;
    base = ca == 1 ? 16 : base; base = ca == 2 ? 24 : base; base = ca == 3 ? 29 : base; base = ca == 4 ? 33 : base; base = ca == 5 ? 36 : base; base = ca == 6 ? 38 : base; base = ca == 7 ? 40 : base;
    base = ca >= 8 ? 34 + ca : base;
    int cb = lane - base; cb = cb > 15 ? 15 : cb;
    const bool valid = lane < 50;
    const float myv = valid ? sv[ca] + sv[16 + cb] : -3.0e38f;
    cv[lane] = myv;
    int rk = 0;
#pragma unroll
    for (int j = 0; j < 52; j += 4) { const f32x4 v = *(const LAS f32x4*)(cv + j);
#pragma unroll
        for (int e = 0; e < 4; ++e) rk += v[e] > myv ? 1 : 0; }
    if (valid && rk < 16) { fv[rk] = myv; fi[rk] = lane; }
    const bool bad = valid && rk < 16 && fi[rk] != lane;
    if (__builtin_amdgcn_ballot_w64(bad) != 0ull) {
        rk = 0;
#pragma unroll 1
        for (int j = 0; j < 50; ++j) { const float v = cv[j]; rk += (v > myv || (v == myv && j < lane)) ? 1 : 0; }
        if (valid && rk < 16) { fv[rk] = myv; fi[rk] = lane; }
    }
    if (valid && rk < 16) fi[rk] = si[ca] * PNK + si[16 + cb];
    if (lane < 16) { const float mx = fv[0]; const float e = __expf(fv[lane] - mx); float s = e; s += __shfl_xor(s, 1); s += __shfl_xor(s, 2); s += __shfl_xor(s, 4); s += __shfl_xor(s, 8);
        EIDX[(size_t)tok * 128 + hd * 16 + lane] = fi[lane] & (NEXP - 1); GATE[(size_t)tok * 128 + hd * 16 + lane] = e / s; }
}
DI void peer_topk_phase(const float* PS, int* EIDX, float* GATE, LAS float* scr, int gw, int ngw, int lane) {
    constexpr int NIT = T * PH;
    int it = gw; if (it >= NIT) return;
    const float* src = PS + (size_t)it * 256 + lane;
    float n0 = src[0], n1 = src[64], n2 = src[128], n3 = src[192];
    for (; it < NIT; it += ngw) {
        const float a0 = n0, a1 = n1, b0 = n2, b1 = n3;
        if (it + ngw < NIT) { const float* nx = PS + (size_t)(it + ngw) * 256 + lane; n0 = nx[0]; n1 = nx[64]; n2 = nx[128]; n3 = nx[192]; }
        peer_topk_process(a0, a1, b0, b1, EIDX, GATE, scr, it, lane);
    }
}

DI void unpack8(const u32x4 v, float* o) { o[0] = bflo(v.x); o[1] = bfhi(v.x); o[2] = bflo(v.y); o[3] = bfhi(v.y); o[4] = bflo(v.z); o[5] = bfhi(v.z); o[6] = bflo(v.w); o[7] = bfhi(v.w); }
DI void unpack_fp8x16(const u32x4 q, float* o) {
#pragma unroll
    for (int d = 0; d < 4; ++d) { const f32x2 lo = __builtin_amdgcn_cvt_pk_f32_fp8((int)q[d], false), hi = __builtin_amdgcn_cvt_pk_f32_fp8((int)q[d], true);
        o[4 * d] = lo.x; o[4 * d + 1] = lo.y; o[4 * d + 2] = hi.x; o[4 * d + 3] = hi.y; }
}
DI void fp8_row(const float* src, unsigned char* tab, int e, float* scale_out, int lane) {
    f32x4 v[16]; float mx = 0.f;
#pragma unroll
    for (int j = 0; j < 4; ++j)
#pragma unroll
        for (int q = 0; q < 4; ++q) { v[4 * j + q] = *(const f32x4*)(src + j * 1024 + lane * 16 + q * 4);
            mx = fmaxf(mx, fmaxf(fmaxf(fabsf(v[4 * j + q].x), fabsf(v[4 * j + q].y)), fmaxf(fabsf(v[4 * j + q].z), fabsf(v[4 * j + q].w)))); }
#pragma unroll
    for (int o = 1; o < 64; o <<= 1) mx = fmaxf(mx, __shfl_xor(mx, o));
    const float inv = mx > 0.f ? 416.f / mx : 0.f;
    if (lane == 0) *scale_out = mx * (1.f / 416.f);
#pragma unroll
    for (int j = 0; j < 4; ++j) { u32x4 w;
#pragma unroll
        for (int q = 0; q < 4; ++q) { int p = 0; p = __builtin_amdgcn_cvt_pk_fp8_f32(v[4 * j + q].x * inv, v[4 * j + q].y * inv, p, false); p = __builtin_amdgcn_cvt_pk_fp8_f32(v[4 * j + q].z * inv, v[4 * j + q].w * inv, p, true); w[q] = (unsigned)p; }
        *(u32x4*)(tab + ((size_t)(8 * j + (lane >> 3)) * NEXP + e) * 128 + (lane & 7) * 16) = w; }
}
typedef int i32x4 __attribute__((ext_vector_type(4)));
constexpr int PGP = 132;
DI float red8(float v) {
    v += __builtin_bit_cast(float, __builtin_amdgcn_update_dpp(0, __builtin_bit_cast(int, v), 0xB1, 0xF, 0xF, false));
    v += __builtin_bit_cast(float, __builtin_amdgcn_update_dpp(0, __builtin_bit_cast(int, v), 0x4E, 0xF, 0xF, false));
    v += __builtin_bit_cast(float, __builtin_amdgcn_update_dpp(0, __builtin_bit_cast(int, v), 0x141, 0xF, 0xF, false));
    return v;
}
DI void ld_e8(const int* p, int (&e)[8]) {
#pragma unroll
    for (int m = 0; m < 2; ++m) { const i32x4 v = *(const i32x4*)(p + 4 * m); e[4 * m] = v[0]; e[4 * m + 1] = v[1]; e[4 * m + 2] = v[2]; e[4 * m + 3] = v[3]; }
}
DI void ld_q8(const __amdgpu_buffer_rsrc_t tab, const int lo, const int (&e)[8], u32x4 (&q)[8]) {
#pragma unroll
    for (int i = 0; i < 8; ++i) q[i] = __builtin_amdgcn_raw_buffer_load_b128(tab, lo + e[i] * 128, 0, 0);
}
DI void g1_chunk(const u32x4 (&q)[8], const float (&hv)[16], LAS float* prow, int j) {
    float r0 = 0.f;
    f32x2 h2[8];
#pragma unroll
    for (int k = 0; k < 8; ++k) { h2[k].x = hv[2 * k]; h2[k].y = hv[2 * k + 1]; }
    float sd[8];
#pragma unroll
    for (int ii = 0; ii < 8; ++ii) {
        f32x2 s2 = __builtin_amdgcn_cvt_pk_f32_fp8((int)q[ii][0], false) * h2[0];
        s2 = __builtin_elementwise_fma(__builtin_amdgcn_cvt_pk_f32_fp8((int)q[ii][0], true), h2[1], s2);
#pragma unroll
        for (int d = 1; d < 4; ++d) { s2 = __builtin_elementwise_fma(__builtin_amdgcn_cvt_pk_f32_fp8((int)q[ii][d], false), h2[2 * d], s2);
            s2 = __builtin_elementwise_fma(__builtin_amdgcn_cvt_pk_f32_fp8((int)q[ii][d], true), h2[2 * d + 1], s2); }
        sd[ii] = s2.x + s2.y; }
#pragma unroll
    for (int ii = 0; ii < 8; ++ii) sd[ii] += __builtin_bit_cast(float, __builtin_amdgcn_update_dpp(0, __builtin_bit_cast(int, sd[ii]), 0xB1, 0xF, 0xF, false));
#pragma unroll
    for (int ii = 0; ii < 8; ++ii) sd[ii] += __builtin_bit_cast(float, __builtin_amdgcn_update_dpp(0, __builtin_bit_cast(int, sd[ii]), 0x4E, 0xF, 0xF, false));
#pragma unroll
    for (int ii = 0; ii < 8; ++ii) sd[ii] += __builtin_bit_cast(float, __builtin_amdgcn_update_dpp(0, __builtin_bit_cast(int, sd[ii]), 0x141, 0xF, 0xF, false));
#pragma unroll
    for (int ii = 0; ii < 8; ++ii) r0 = (j == ii) ? sd[ii] : r0;
    prow[j] += r0;
}
DI void peer_g1_unit(const bf16* H, const unsigned char* TU, const int* EIDX, float* PART, LAS unsigned char* lds, int unit, int tid) {
    const int x = unit & 7, r = unit >> 3, lane = tid & 63, wave = __builtin_amdgcn_readfirstlane(tid >> 6), j = lane & 7, g = lane >> 3;
    LAS float* part = (LAS float*)lds;
    const __amdgpu_buffer_rsrc_t tab = __builtin_amdgcn_make_buffer_rsrc((void*)TU, 0, NEXP * D, 0x00020000);
    __syncthreads();
    for (int i = tid; i < 256 * PGP; i += 512) part[i] = 0.f;
    __syncthreads();
    for (int sl = 0; sl < 4; ++sl) { const int sidx = 4 * x + sl;
        const int lo = sidx * NEXP * 128 + j * 16;
        for (int tb = wave * 32; tb < wave * 32 + 32; tb += 8) { const int tl = tb + g, tok = 256 * r + tl;
            const bf16* hp = H + (size_t)tok * D + sidx * 128 + 16 * j; float hv[16]; unpack8(*(const u32x4*)hp, hv); unpack8(*(const u32x4*)(hp + 8), hv + 8);
            const int* ep = EIDX + (size_t)tok * 128; LAS float* prow = part + tl * PGP;
            int eA[8], eB[8]; u32x4 qA[8], qB[8];
            ld_e8(ep, eA); ld_e8(ep + 8, eB); ld_q8(tab, lo, eA, qA);
#pragma unroll 1
            for (int c = 0; c < 16; c += 2) {
                ld_q8(tab, lo, eB, qB);
                if (c + 2 < 16) ld_e8(ep + 8 * (c + 2), eA);
                g1_chunk(qA, hv, prow + 8 * c, j);
                if (c + 2 < 16) ld_q8(tab, lo, eA, qA);
                if (c + 3 < 16) ld_e8(ep + 8 * (c + 3), eB);
                g1_chunk(qB, hv, prow + 8 * (c + 1), j);
            }
        }
    }
    __syncthreads();
    float* dst = PART + ((size_t)x * T + 256 * r) * 128;
    for (int i = tid; i < 256 * 32; i += 512) *(f32x4*)(dst + i * 4) = *(const LAS f32x4*)(part + (i >> 5) * PGP + (i & 31) * 4);
}
DI void peer_g2(const float* PART, const int* EIDX, const float* GATE, const float* SU, const float* SV, float* W, int i4) {
    f32x4 s = {0.f, 0.f, 0.f, 0.f};
#pragma unroll
    for (int x = 0; x < 8; ++x) s += *(const f32x4*)(PART + (size_t)x * T * 128 + 4 * (size_t)i4);
    const i32x4 e = *(const i32x4*)(EIDX + 4 * (size_t)i4); const f32x4 g = *(const f32x4*)(GATE + 4 * (size_t)i4);
    float su[4], sv[4];
#pragma unroll
    for (int k = 0; k < 4; ++k) { su[k] = SU[e[k]]; sv[k] = SV[e[k]]; }
    f32x4 w;
#pragma unroll
    for (int k = 0; k < 4; ++k) w[k] = g[k] * gelu_tanh(s[k] * su[k]) * sv[k];
    *(f32x4*)(W + 4 * (size_t)i4) = w;
}
DI void g3_chunk(const u32x4 (&q)[8], const LAS float* wrow, float (&acc)[16]) {
#pragma unroll
    for (int m = 0; m < 2; ++m) { const f32x4 w4 = *(const LAS f32x4*)(wrow + 4 * m);
#pragma unroll
        for (int i2 = 0; i2 < 4; ++i2) { float f[16]; unpack_fp8x16(q[4 * m + i2], f);
#pragma unroll
            for (int k = 0; k < 16; ++k) acc[k] += w4[i2] * f[k]; } }
}
DI void ld_e8b(const __amdgpu_buffer_rsrc_t ers, const int voff, int (&e)[8]) {
#pragma unroll
    for (int m = 0; m < 2; ++m) { const u32x4 v = __builtin_amdgcn_raw_buffer_load_b128(ers, voff + 16 * m, 0, 0); e[4 * m] = (int)v[0]; e[4 * m + 1] = (int)v[1]; e[4 * m + 2] = (int)v[2]; e[4 * m + 3] = (int)v[3]; }
}
struct GChunk { int eoff, lo, tl, c, sidx; };
DI GChunk gchunk(int cc, int wave, int r, int x, int g, int j) {
    GChunk q; const int b = cc >> 4; q.c = cc & 15; q.sidx = 4 * x + (b >> 2); q.tl = wave * 32 + (b & 3) * 8 + g;
    q.eoff = ((256 * r + q.tl) * 128 + 8 * q.c) * 4; q.lo = q.sidx * NEXP * 128 + j * 16; return q;
}
DI void peer_g3_unit(const float* W, const unsigned char* TV, const int* EIDX, float* out, LAS unsigned char* lds, int unit, int tid) {
    const int x = unit & 7, r = unit >> 3, lane = tid & 63, wave = __builtin_amdgcn_readfirstlane(tid >> 6), j = lane & 7, g = lane >> 3;
    LAS float* wl = (LAS float*)lds;
    const __amdgpu_buffer_rsrc_t tab = __builtin_amdgcn_make_buffer_rsrc((void*)TV, 0, NEXP * D, 0x00020000);
    const __amdgpu_buffer_rsrc_t ers = __builtin_amdgcn_make_buffer_rsrc((void*)EIDX, 0, T * 128 * 4, 0x00020000);
    __syncthreads();
    { const float* src = W + (size_t)(256 * r) * 128;
      for (int i = tid; i < 256 * 32; i += 512) *(LAS f32x4*)(wl + (i >> 5) * PGP + (i & 31) * 4) = *(const f32x4*)(src + i * 4); }
    __syncthreads();
    int eA[8], eB[8]; u32x4 qA[8], qB[8]; f32x4 ov[4]; float acc[16];
    { const GChunk c0 = gchunk(0, wave, r, x, g, j), c1 = gchunk(1, wave, r, x, g, j); ld_e8b(ers, c0.eoff, eA); ld_e8b(ers, c1.eoff, eB); ld_q8(tab, c0.lo, eA, qA); }
#pragma unroll 1
    for (int cc = 0; cc < 256; cc += 2) {
        const GChunk ca = gchunk(cc, wave, r, x, g, j), cb = gchunk(cc + 1, wave, r, x, g, j);
        float* op = out + (size_t)(256 * r + ca.tl) * D + ca.sidx * 128 + 16 * j;
        ld_q8(tab, cb.lo, eB, qB);
        if (cc + 2 < 256) ld_e8b(ers, gchunk(cc + 2, wave, r, x, g, j).eoff, eA);
        if (ca.c == 0) {
#pragma unroll
            for (int k = 0; k < 4; ++k) ov[k] = *(const f32x4*)(op + 4 * k);
#pragma unroll
            for (int k = 0; k < 16; ++k) acc[k] = 0.f; }
        g3_chunk(qA, wl + ca.tl * PGP + 8 * ca.c, acc);
        if (cc + 2 < 256) ld_q8(tab, gchunk(cc + 2, wave, r, x, g, j).lo, eA, qA);
        if (cc + 3 < 256) ld_e8b(ers, gchunk(cc + 3, wave, r, x, g, j).eoff, eB);
        g3_chunk(qB, wl + cb.tl * PGP + 8 * cb.c, acc);
        if (cb.c == 15) {
#pragma unroll
            for (int k = 0; k < 4; ++k) { f32x4 o = ov[k]; o[0] += acc[4 * k]; o[1] += acc[4 * k + 1]; o[2] += acc[4 * k + 2]; o[3] += acc[4 * k + 3]; *(f32x4*)(op + 4 * k) = o; } }
    }
}

constexpr int NPH = 24;
__global__ void __launch_bounds__(512, 2) fwd_kernel(Args a_) {
    extern __shared__ __attribute__((aligned(16))) unsigned char lds_raw[];
    LAS unsigned char* lds = (LAS unsigned char*)lds_raw;
    const int wave = __builtin_amdgcn_readfirstlane(threadIdx.x >> 6);
    const int G = gridDim.x, bid = blockIdx.x, gw = bid * 8 + wave, ngw = G * 8;
    volatile LAS unsigned* MISC = (volatile LAS unsigned*)(lds + LDS_MISC);
    if (wave == 0) MISC[lane_id()] = 0u;
    __syncthreads();
    unsigned* ctl = (unsigned*)(a_.ws + WS_CTL);
    XcdBarrier bar = xcd_barrier_post(ctl + 4096, MISC + 8, wave);
    const int lo = a_.ph_lo, hi = a_.ph_hi;
#ifndef PHASE_MASK
#define PHASE_MASK 0xffffffffu
#endif
#define IN(k) ((((PHASE_MASK) >> (k)) & 1u) && lo <= (k) && (k) < hi)
#ifndef DUP
#define DUP -1
#endif
#define REP(k) for (int rep_ = 0; rep_ < ((DUP) == (k) ? 2 : 1); ++rep_)
#define SEAM(k) do { if (IN(k) && IN((k) + 1)) xcd_barrier(bar); } while (0)
#define PH_BASES unsigned char* ws = a_.ws; float* out_ = a_.out; asm volatile("" : "+s"(ws), "+s"(out_)); const PA a{a_, ws, out_}; bf16* Hb = (bf16*)(ws + WS_H); (void)Hb; const int lane = lane_id(), tid = wave * 64 + lane; (void)tid;

    if (IN(0)) REP(0) { PH_BASES
        if (bid < S5G) s5_build(a, lds, bid, tid);
        for (int g = bid + G; g < S5G; g += G) s5_build(a, lds, g, tid);
        __syncthreads();
        LAS float* scr = (LAS float*)(lds + wave * 16384);
        constexpr int I_WIN = 64 * 320, I_GLU = 32 * 64, I_EWO = 64 * 128, I_OWI = 64 * 384, I_OWO = 64 * 128;
        constexpr int NIT = I_WIN + I_GLU + I_EWO + I_OWI + I_OWO;
        for (int it = gw; it < NIT; it += ngw) { int r = it;
            if (r < I_WIN) { const int nb_ = r % 320;
                if (FP8_WPART && !FP8_WIN && (nb_ < 64 || nb_ >= 256)) { transpose_item8(inp(a, I_EWIN), D, 10240, ws + WS_WIN8, scr, r, lane, nb_ < 64 ? 0 : -6144); continue; }
                if (FP8_WIN) transpose_item8(inp(a, I_EWIN), D, 10240, ws + WS_WIN, scr, r, lane); else transpose_item(inp(a, I_EWIN), D, 10240, (bf16*)(ws + WS_WIN), nullptr, scr, r, lane); continue; } r -= I_WIN;
            if (r < I_GLU) { transpose_item(inp(a, I_GLUW), S5W, S5W, (bf16*)(ws + WS_GLU), nullptr, scr, r, lane); continue; } r -= I_GLU;
            if (r < I_EWO) { if (FP8_EWO) transpose_item8(inp(a, I_EWOUT), D, D, ws + WS_EWO, scr, r, lane); else transpose_item(inp(a, I_EWOUT), D, D, (bf16*)(ws + WS_EWO), nullptr, scr, r, lane); continue; } r -= I_EWO;
            if (r < I_OWI) { transpose_item8(inp(a, I_OWIN), D, QKVW, ws + WS_OWI, scr, r, lane); continue; } r -= I_OWI;
            if (FP8_OWO) transpose_item8(inp(a, I_OWOUT), D, D, ws + WS_OWO, scr, r, lane); else transpose_item(inp(a, I_OWOUT), D, D, (bf16*)(ws + WS_OWO), nullptr, scr, r, lane);
        }
        {
            const int gt = bid * 512 + tid, ngt = G * 512;
            for (int q = gt; q < 2 * 2048 * 256; q += ngt) { const int l = q >> 19, rem = q & 524287, n = rem >> 8, col0 = (rem & 255) * 8, blk = n >> 7;
                u32x4 w = {0u, 0u, 0u, 0u};
                if ((col0 >> 7) == blk) { const float* kp = inp(a, I_PKEYS) + (((size_t)(l * 16 + blk) * PNK + (n & 127)) * PKD + (col0 & 127));
                    const f32x4 k0 = *(const f32x4*)kp, k1 = *(const f32x4*)(kp + 4); w.x = pk2(k0[0], k0[1]); w.y = pk2(k0[2], k0[3]); w.z = pk2(k1[0], k1[1]); w.w = pk2(k1[2], k1[3]); }
                *(u32x4*)((bf16*)(ws + WS_PKEY) + (size_t)q * 8) = w; }
            for (int q = gt; q < 2 * D * PQW / 8; q += ngt) { const float* sp = inp(a, I_PWQ) + (size_t)q * 8; const f32x4 v0 = *(const f32x4*)sp, v1 = *(const f32x4*)(sp + 4);
                u32x4 w; w.x = pk2(v0[0], v0[1]); w.y = pk2(v0[2], v0[3]); w.z = pk2(v1[0], v1[1]); w.w = pk2(v1[2], v1[3]); *(u32x4*)((bf16*)(ws + WS_WQB) + (size_t)q * 8) = w; }
        }
        const bool bal = (G == 256);
        const int nrounds = bal ? (bid >= 128 ? 34 : 30) : (4 * NEXP - gw + ngw - 1) / ngw;
#pragma unroll 1
        for (int k = 0; k < nrounds; ++k) { const int rr = (bal && k >= 30) ? 30 * ngw + (gw - 1024) + (k - 30) * 1024 : gw + k * ngw;
            const int tb = rr >> 15, idx = rr & 32767, l = idx >> 14, e = idx & 16383;
            fp8_row(inp(a, tb ? I_PV : I_PU) + (size_t)idx * D, ws + (tb ? WS_TV : WS_TU) + (size_t)l * NEXP * D, e, (float*)(ws + (tb ? WS_SV : WS_SU)) + idx, lane); }
        if (FP8_WIN) { for (int m = gw; m < T; m += ngw) rms_row8(inp(a, I_X) + (size_t)m * D, inp(a, I_EVG), ws + WS_H + (size_t)m * D, lane); }
        else if (FP8_WPART) { for (int m = gw; m < T; m += ngw) rms_row_both(inp(a, I_X) + (size_t)m * D, inp(a, I_EVG), Hb + (size_t)m * D, ws + WS_H8L0 + (size_t)m * D, lane); }
        else rms_phase(inp(a, I_X), inp(a, I_EVG), Hb, gw, ngw, lane);
    }
    SEAM(0);
    if (IN(1)) { PH_BASES
        if (FP8_WPART && !FP8_WIN) {
            { pg8::Sched S{Hb, (const bf16*)(ws + WS_WIN) + (size_t)2048 * D, 0, 0, D, D, T / 256, 24, 1, G, bid};
              pg8::EpiZ E{(bf16*)(ws + WS_UC), (bf16*)(ws + WS_Z), 0, 0, 8}; pg8::gemm_phase<pg8::EpiZ, pg8::Sched, false>(lds, tid, D, D, D, S, E); }
            { pg8::Sched S{(const bf16*)(ws + WS_H8L0), (const bf16*)(ws + WS_WIN8), 0, 0, D / 2, D / 2, T / 256, 16, 1, G, bid};
              pg8::EpiZ E{(bf16*)(ws + WS_UC), (bf16*)(ws + WS_Z), 8, 0, 24}; pg8::gemm_phase<pg8::EpiZ, pg8::Sched, true>(lds, tid, D / 2, D / 2, D / 2, S, E); }
        } else { constexpr int KW = FP8_WIN ? D / 2 : D; pg8::Sched S{Hb, (const bf16*)(ws + WS_WIN), 0, 0, KW, KW, T / 256, 10240 / 256, 1, G, bid};
        pg8::EpiZ E{(bf16*)(ws + WS_UC), (bf16*)(ws + WS_Z), 0, 0, 0}; pg8::gemm_phase<pg8::EpiZ, pg8::Sched, FP8_WIN != 0>(lds, tid, KW, KW, KW, S, E); }
        pg8::SchedFold SF{(const bf16*)(ws + WS_PKEY), (const bf16*)(ws + WS_WQB), G, bid};
        pg8::EpiBf16 EF{(bf16*)(ws + WS_WST), D, (size_t)PQW * D}; pg8::gemm_phase(lds, tid, 256, PQW, PQW, SF, EF); }
    SEAM(1);
    if (IN(2)) { PH_BASES pg8::Sched S{(const bf16*)(ws + WS_UC), (const bf16*)(ws + WS_BTE), (size_t)S5NC * UCLD, (size_t)256 * 512, UCLD, 512, 1, 1, S5G, G, bid};
        pg8::EpiS5E E{(float*)(ws + WS_E)}; pg8::gemm_phase(lds, tid, 512, UCLD, 512, S, E);
        for (int it = bid; it < (T / 64) * RH; it += G) ret_prep_item(a, lds, it, tid);
    }
    SEAM(2);
    if (IN(3)) { PH_BASES
        { pg8::SchedRet S{(const bf16*)(ws + WS_QR), (const bf16*)(ws + WS_KR), 0, G, bid}; pg8::EpiRetS E{(bf16*)(ws + WS_SQ)}; pg8::gemm_phase(lds, tid, 256, RW, RW, S, E); }
        { pg8::SchedRet S{(const bf16*)(ws + WS_VS), (const bf16*)(ws + WS_KDT), 1, G, bid}; pg8::EpiRetKV E{(float*)(ws + WS_KVT)}; pg8::gemm_phase(lds, tid, 256, 512, T, S, E); }
        for (int g = bid; g < S5G; g += G) s5_scan(a, lds, g, tid); }
    SEAM(3);
    if (IN(4)) REP(4) { PH_BASES pg8::Sched S{(const bf16*)(ws + WS_UC), (const bf16*)(ws + WS_BT13), (size_t)S5NC * UCLD, (size_t)512 * UCLD, UCLD, UCLD, 1, 2, S5G, G, bid};
        pg8::EpiS5Y E{(const bf16*)(ws + WS_UC), inp(a, I_S5D), (bf16*)(ws + WS_YPRE)}; pg8::gemm_phase(lds, tid, UCLD, UCLD, UCLD, S, E);
        for (int e4 = bid * 512 + tid; e4 < RH * 256 * 64; e4 += G * 512) ret_prefix(a, e4);
    }
    SEAM(4);
    if (IN(5)) { PH_BASES
        { pg8::Sched S{(const bf16*)(ws + WS_YPRE), (const bf16*)(ws + WS_GLU), 0, 0, S5W, S5W, T / 256, S5W / 256, 1, G, bid};
          pg8::EpiGlu E{(const bf16*)(ws + WS_YPRE), inp(a, I_GLUB), (bf16*)(ws + WS_YCAT)}; pg8::gemm_phase(lds, tid, S5W, S5W, S5W, S, E); }
        { pg8::SchedRet S{(const bf16*)(ws + WS_SQ), (const bf16*)(ws + WS_VS), 2, G, bid};
          pg8::EpiRetOut E{(const bf16*)(ws + WS_Z), inp(a, I_GNG), inp(a, I_GNB), (bf16*)(ws + WS_YCAT), (LAS float*)(lds + 131072)}; pg8::gemm_phase(lds, tid, 512, 512, 512, S, E); } }
    SEAM(5);
    if (IN(6)) { PH_BASES constexpr int KW = FP8_EWO ? D / 2 : D; pg8::Sched S{(const bf16*)(ws + WS_YCAT), (const bf16*)(ws + WS_EWO), 0, 0, KW, KW, T / 256, D / 256, 1, G, bid};
        pg8::EpiF32 E{a.out, inp(a, I_X), D}; pg8::gemm_phase<pg8::EpiF32, pg8::Sched, FP8_EWO != 0>(lds, tid, KW, KW, KW, S, E); }
    SEAM(6);
#define PEER_BLOCK(P, LAYER) \
    if (IN(P)) { PH_BASES rms_phase(a.out, inp(a, I_FFNG) + (LAYER) * D, Hb, gw, ngw, lane); } \
    SEAM(P); \
    if (IN((P) + 1)) { PH_BASES pg8::Sched S{Hb, (const bf16*)(ws + WS_WST) + (size_t)(LAYER) * PQW * D, 0, 0, D, D, T / 256, PQW / 256, 1, G, bid}; \
        if (G == 256) { pg8::EpiTopk E{(int*)(ws + WS_EIDX), (float*)(ws + WS_GATE), lds}; pg8::gemm_phase(lds, tid, D, D, D, S, E); }        \
        else { pg8::EpiF32 E{(float*)(ws + WS_PS), nullptr, PQW}; pg8::gemm_phase(lds, tid, D, D, D, S, E); } } \
    if (G != 256) SEAM((P) + 1); \
    if (IN((P) + 2) && G != 256) REP((P) + 2) { PH_BASES peer_topk_phase((const float*)(ws + WS_PS), (int*)(ws + WS_EIDX), (float*)(ws + WS_GATE), (LAS float*)(lds + wave * 2048), gw, ngw, lane); } \
    SEAM((P) + 2); \
    if (IN((P) + 3)) REP((P) + 3) { PH_BASES for (int u = bid; u < 256; u += G) \
        peer_g1_unit(Hb, ws + WS_TU + (size_t)(LAYER) * NEXP * D, (const int*)(ws + WS_EIDX), (float*)(ws + WS_PART), lds, u, tid); } \
    SEAM((P) + 3); \
    if (IN((P) + 4)) { PH_BASES for (int i = bid * 512 + tid; i < T * 32; i += G * 512) \
        peer_g2((const float*)(ws + WS_PART), (const int*)(ws + WS_EIDX), (const float*)(ws + WS_GATE), (const float*)(ws + WS_SU) + (LAYER) * NEXP, (const float*)(ws + WS_SV) + (LAYER) * NEXP, (float*)(ws + WS_PW), i); } \
    SEAM((P) + 4); \
    if (IN((P) + 5)) { PH_BASES for (int u = bid; u < 256; u += G) \
        peer_g3_unit((const float*)(ws + WS_PW), ws + WS_TV + (size_t)(LAYER) * NEXP * D, (const int*)(ws + WS_EIDX), a.out, lds, u, tid); } \
    SEAM((P) + 5);
    PEER_BLOCK(7, 0)
    if (IN(13)) { PH_BASES for (int m = gw; m < T; m += ngw) rms_row8(a.out + (size_t)m * D, inp(a, I_ODG), ws + WS_H + (size_t)m * D, lane); }
    SEAM(13);
    if (IN(14)) REP(14) { PH_BASES
        { pg8::Sched S{Hb, (const bf16*)(ws + WS_OWI), 0, 0, D / 2, D / 2, T / 256, 2 * D / 256, 1, G, bid};
          pg8::EpiQK E{(bf16*)(ws + WS_QKV), inp(a, I_QNG), inp(a, I_KNG), (PG8_LAS float*)(lds + 131072)}; pg8::gemm_phase<pg8::EpiQK, pg8::Sched, true>(lds, tid, D / 2, D / 2, D / 2, S, E); }
        { pg8::Sched S{(const bf16*)(ws + WS_OWI) + (size_t)2 * D * (D / 2), Hb, 0, 0, D / 2, D / 2, AH * AVD / 256, T / 256, 1, G, bid};
          pg8::EpiBf16 E{(bf16*)(ws + WS_VT1), T, 0}; pg8::gemm_phase<pg8::EpiBf16, pg8::Sched, true>(lds, tid, D / 2, D / 2, D / 2, S, E); }
        if (bid == 0 && wave == 0) { const float s1 = wave_sum(inp(a, I_LQ1)[lane] * inp(a, I_LK1)[lane] + inp(a, I_LQ1)[lane + 64] * inp(a, I_LK1)[lane + 64]);
            const float s2 = wave_sum(inp(a, I_LQ2)[lane] * inp(a, I_LK2)[lane] + inp(a, I_LQ2)[lane + 64] * inp(a, I_LK2)[lane + 64]);
            if (lane == 0) *(float*)(ws + WS_MISC) = expf(s1) - expf(s2) + LAMBDA_INIT; }
    }
    SEAM(14);
    if (IN(16)) REP(16) { PH_BASES if (wave >= 4) __builtin_amdgcn_s_setprio(1);
        const float lam = __builtin_bit_cast(float, __builtin_amdgcn_readfirstlane(*(const int*)(ws + WS_MISC)));
        for (int c = bid; c < 256; c += G) { const int hA = 2 * (c & 7) + ((c >> 3) & 1), j = c >> 4;
#pragma unroll 1
            for (int u = 0; u < 4; ++u) { const int qb = (u == 0) ? 63 - j : (u == 1) ? 32 + j : (u == 2) ? 31 - j : j; diff_unit(a, lds, hA, qb, lam, wave); } }
        __builtin_amdgcn_s_setprio(0); }
    SEAM(16);
    if (IN(17)) { PH_BASES constexpr int KW = FP8_OWO ? D / 2 : D; pg8::Sched S{(const bf16*)(ws + WS_AO), (const bf16*)(ws + WS_OWO), 0, 0, KW, KW, T / 256, D / 256, 1, G, bid};
        pg8::EpiF32 E{a.out, a.out, D}; pg8::gemm_phase<pg8::EpiF32, pg8::Sched, FP8_OWO != 0>(lds, tid, KW, KW, KW, S, E); }
    SEAM(17);
    PEER_BLOCK(18, 1)
#undef IN
#undef SEAM
}

#ifndef N_LAUNCH_SPLIT
#define N_LAUNCH_SPLIT 0
#endif
extern "C" void kernel_launch(void* const* d_in, const int* in_sizes, int n_in, void* d_out, int out_size, void* d_ws, size_t ws_size, hipStream_t stream) {
    static int grid = 0;
    if (grid == 0) {
        if (n_in != 32 || out_size != T * D || ws_size < WS_END) { fprintf(stderr, "kernel_launch: unexpected shapes (n_in %d, out %d, ws %zu < %zu)\n", n_in, out_size, ws_size, (size_t)WS_END); grid = -1; return; }
        int dev = 0, cus = 0, per_cu = 0;
        if (hipGetDevice(&dev) != hipSuccess || hipDeviceGetAttribute(&cus, hipDeviceAttributeMultiprocessorCount, dev) != hipSuccess) { grid = -1; return; }
        if (hipFuncSetAttribute((const void*)fwd_kernel, hipFuncAttributeMaxDynamicSharedMemorySize, LDS_BYTES) != hipSuccess) { fprintf(stderr, "kernel_launch: hipFuncSetAttribute failed\n"); grid = -1; return; }
        if (hipOccupancyMaxActiveBlocksPerMultiprocessor(&per_cu, (const void*)fwd_kernel, 512, LDS_BYTES) != hipSuccess || per_cu < 1) fprintf(stderr, "kernel_launch: occupancy query reports %d\n", per_cu);
        (void)hipGetLastError();
        grid = cus;
    }
    if (grid < 0) return;
    (void)hipMemsetAsync((char*)d_ws + WS_CTL, 0, CTL_ZERO_BYTES, stream);
    Args a{};
    for (int i = 0; i < 32; ++i) a.in[i] = (const float*)d_in[i];
    a.out = (float*)d_out; a.ws = (unsigned char*)d_ws;
#if N_LAUNCH_SPLIT
    for (int p = 0; p < NPH; ++p) { a.ph_lo = p; a.ph_hi = p + 1; hipLaunchKernelGGL(fwd_kernel, dim3(grid), dim3(512), LDS_BYTES, stream, a); }
#else
    a.ph_lo = 0; a.ph_hi = NPH; hipLaunchKernelGGL(fwd_kernel, dim3(grid), dim3(512), LDS_BYTES, stream, a);
#endif
}
```

```cpp
#include <hip/hip_runtime.h>
#include <cstdio>
#include <cstdint>

#define GAS __attribute__((address_space(1)))
#define LAS __attribute__((address_space(3)))
typedef unsigned short bf16;
typedef short bf16x8 __attribute__((ext_vector_type(8)));
typedef short s16x4 __attribute__((ext_vector_type(4)));
typedef float f32x2 __attribute__((ext_vector_type(2)));
typedef float f32x4 __attribute__((ext_vector_type(4)));
typedef float f32x16 __attribute__((ext_vector_type(16)));
typedef unsigned u32x2 __attribute__((ext_vector_type(2)));
typedef unsigned u32x4 __attribute__((ext_vector_type(4)));
typedef __bf16 bf16x2_t __attribute__((ext_vector_type(2)));
#define DI __device__ __forceinline__

DI unsigned pk2(float lo, float hi) { f32x2 v = {lo, hi}; bf16x2_t b = __builtin_convertvector(v, bf16x2_t); return __builtin_bit_cast(unsigned, b); }
DI float bflo(unsigned u) { return __builtin_bit_cast(float, u << 16); }
DI float bfhi(unsigned u) { return __builtin_bit_cast(float, u & 0xffff0000u); }
DI float bf2f(bf16 b) { return __builtin_bit_cast(float, (unsigned)b << 16); }
DI float wave_sum(float v) {
#pragma unroll
    for (int o = 1; o < 64; o <<= 1) v += __shfl_xor(v, o);
    return v;
}
DI float sigmoidf_(float x) { return 1.f / (1.f + __expf(-x)); }
DI float gelu_tanh(float v) { const float z = 0.7978845608028654f * (v + 0.044715f * v * v * v); return v / (1.f + __expf(-2.f * z)); }
DI int crow(int r, int hi) { return (r & 3) + 8 * (r >> 2) + 4 * hi; }
DI unsigned pk4_fp8(float a, float b, float c, float d) { int p = 0; p = __builtin_amdgcn_cvt_pk_fp8_f32(a, b, p, false); p = __builtin_amdgcn_cvt_pk_fp8_f32(c, d, p, true); return (unsigned)p; }
DI void swap32(const float x, float& lo, float& hi) { unsigned a_ = __builtin_bit_cast(unsigned, x), b_ = a_; asm volatile("s_nop 1\n\tv_permlane32_swap_b32 %0, %1" : "+v"(a_), "+v"(b_)); lo = __builtin_bit_cast(float, a_); hi = __builtin_bit_cast(float, b_); }
DI int lane_id() { return (int)__builtin_amdgcn_mbcnt_hi(~0u, __builtin_amdgcn_mbcnt_lo(~0u, 0u)); }

#ifndef FP8_WIN
#define FP8_WIN 0
#endif
#ifndef FP8_EWO
#define FP8_EWO 1
#endif
#ifndef FP8_WPART
#define FP8_WPART 1
#endif
#ifndef FP8_OWO
#define FP8_OWO 1
#endif
constexpr int T = 8192, D = 4096;
constexpr int S5W = 2048, S5G = 128, S5P = 64, S5L = 32, S5NC = T / S5L;
constexpr int UCLD = 640;
constexpr int RH = 8, RHD = 256, RW = 2048;
constexpr int ZW = 8192;
constexpr int AH = 16, AHD = 128, AVD = 256, QKVW = 12288;
constexpr int PH = 8, PNK = 128, PKD = 128, PTOPK = 16, PQW = 2048, NEXP = 16384;
constexpr float EPS = 1e-6f;
constexpr float LAMBDA_INIT = 0.35550906759096926f;
constexpr float LOG2E = 1.4426950408889634f;

constexpr size_t MiB = 1u << 20;
constexpr size_t WS_CTL = 0, CTL_ZERO_BYTES = 1 * MiB;
constexpr size_t WS_WIN = 2 * MiB;
constexpr size_t WS_GLU = 82 * MiB;
constexpr size_t WS_EWO = 90 * MiB;
constexpr size_t WS_OWI = 122 * MiB;
constexpr size_t WS_OWO = 218 * MiB;
constexpr size_t WS_WST = 250 * MiB;
constexpr size_t WS_PKEY = 282 * MiB;
constexpr size_t WS_BT13 = 298 * MiB;
constexpr size_t WS_BTE = 378 * MiB;
constexpr size_t WS_PW32 = 410 * MiB;
constexpr size_t WS_MISC = 411 * MiB;
constexpr size_t WS_SU = WS_MISC + 65536;
constexpr size_t WS_SV = WS_MISC + 262144;
constexpr size_t WS_TU = 412 * MiB;
constexpr size_t WS_TV = 668 * MiB;
constexpr size_t WS_H = 924 * MiB;
constexpr size_t WS_R0 = 988 * MiB;
constexpr size_t WS_Z = WS_R0;
constexpr size_t WS_UC = WS_R0 + 128 * MiB;
constexpr size_t WS_E = WS_R0 + 168 * MiB;
constexpr size_t WS_YPRE = WS_R0 + 184 * MiB;
constexpr size_t WS_YCAT = WS_R0 + 216 * MiB;
constexpr size_t WS_QR = WS_R0 + 280 * MiB;
constexpr size_t WS_KR = WS_R0 + 312 * MiB;
constexpr size_t WS_VT = WS_R0 + 344 * MiB;
constexpr size_t WS_H8L0 = WS_R0 + 448 * MiB;
constexpr size_t WS_WIN8 = WS_R0 + 480 * MiB;
constexpr size_t WS_PART = WS_R0;
constexpr size_t WS_PW = WS_R0 + 32 * MiB;
constexpr size_t WS_QKV = WS_R0;
constexpr size_t WS_VT1 = WS_R0 + 192 * MiB;
constexpr size_t WS_O1 = WS_R0 + 256 * MiB;
constexpr size_t WS_AO = WS_R0 + 384 * MiB;
constexpr size_t WS_WQB = 1500 * MiB;
constexpr size_t WS_PS = 1532 * MiB;
constexpr size_t WS_EIDX = 1596 * MiB;
constexpr size_t WS_GATE = 1600 * MiB;
constexpr size_t WS_SQ = 1604 * MiB;
constexpr size_t WS_VS = 1668 * MiB;
constexpr size_t WS_KVT = 1732 * MiB;
constexpr size_t WS_KDT = 1796 * MiB;
constexpr size_t WS_END = 1828 * MiB;

constexpr int LDS_BYTES = 147456;
constexpr int LDS_MISC = 131072 + 8192;

#define XB_TMO      128
#define XB_XCNT(j)  (256  + 64 * (j))
#define XB_XSUB(j)  (1280 + 64 * (j))
#define XB_XGEN(j)  (2304 + 64 * (j))
#define XB_TOP      3328
#define XB_TOPGEN   3392
#define XCD_BAR_WORDS 3456
#define XB_SPIN_CAP (1u << 21)
DI unsigned xb_ld(unsigned* p)              { return __hip_atomic_load(p, __ATOMIC_RELAXED, __HIP_MEMORY_SCOPE_AGENT); }
DI unsigned xb_add(unsigned* p, unsigned v) { return __hip_atomic_fetch_add(p, v, __ATOMIC_RELAXED, __HIP_MEMORY_SCOPE_AGENT); }
DI unsigned xb_xcc_id() { return (unsigned)__builtin_amdgcn_s_getreg((3 << 11) | 20) & 0xFu; }
#define XB_SPIN(cond, bar) do { unsigned _sp = 0; while (cond) { __builtin_amdgcn_s_sleep(1); \
    if ((++_sp & 255u) == 0u) { if (xb_ld(&(bar)[XB_TMO])) break; if (_sp > XB_SPIN_CAP) { atomicAdd(&(bar)[XB_TMO], 1u); break; } } } } while (0)
struct XcdBarrier { unsigned* bar; unsigned x; volatile LAS unsigned* st; int wv; };
DI XcdBarrier xcd_barrier_post(unsigned* bar, volatile LAS unsigned* st, int wv) {
    XcdBarrier b; b.bar = bar; b.x = xb_xcc_id(); b.st = st; b.wv = wv;
    if (wv == 0 && lane_id() == 0) (void)xb_add(&bar[XB_XCNT(b.x)], 1u);
    return b;
}
DI void xcd_barrier_complete(unsigned* bar, unsigned x, unsigned& nloc, unsigned& nx) {
    const unsigned G = gridDim.x * gridDim.y * gridDim.z;
    unsigned sum, cnt, mine, sp = 0u;
    for (;;) {
        sum = 0u; cnt = 0u; mine = 0u;
#pragma unroll
        for (unsigned j = 0; j < 16; ++j) { const unsigned c = xb_ld(&bar[XB_XCNT(j)]); sum += c; cnt += (c > 0u) ? 1u : 0u; mine = (j == x) ? c : mine; }
        if (sum == G) break;
        __builtin_amdgcn_s_sleep(1);
        if ((++sp & 255u) == 0u) { if (xb_ld(&bar[XB_TMO])) break; if (sp > XB_SPIN_CAP) { atomicAdd(&bar[XB_TMO], 1u); break; } }
    }
    nloc = mine > 0u ? mine : 1u; nx = cnt > 0u ? cnt : 1u;
}
DI void xcd_barrier(const XcdBarrier& b) {
    asm volatile("s_waitcnt vmcnt(0)" ::: "memory");
    __syncthreads();
    if (b.wv == 0 && lane_id() == 0) {
        unsigned* bar = b.bar;
        __builtin_amdgcn_s_waitcnt(0);
        unsigned nloc = b.st[0], nx = b.st[1];
        if (nloc == 0u) { xcd_barrier_complete(bar, b.x, nloc, nx); b.st[0] = nloc; b.st[1] = nx; }
        const unsigned old = xb_add(&bar[XB_XSUB(b.x)], 1u);
        const unsigned gen = old / nloc;
        if (old + 1u == (gen + 1u) * nloc) {
            __builtin_amdgcn_fence(__ATOMIC_RELEASE, "agent");
            asm volatile("s_waitcnt vmcnt(0)" ::: "memory");
            const unsigned og = xb_add(&bar[XB_TOP], 1u);
            const unsigned tg = og / nx;
            if (og + 1u == (tg + 1u) * nx) xb_add(&bar[XB_TOPGEN], 1u);
            else XB_SPIN(xb_ld(&bar[XB_TOPGEN]) == tg, bar);
            __builtin_amdgcn_fence(__ATOMIC_ACQUIRE, "agent");
            xb_add(&bar[XB_XGEN(b.x)], 1u);
            asm volatile("s_waitcnt vmcnt(0)" ::: "memory");
        } else {
            XB_SPIN(xb_ld(&bar[XB_XGEN(b.x)]) == gen, bar);
            __builtin_amdgcn_fence(__ATOMIC_ACQUIRE, "agent");
            asm volatile("s_waitcnt vmcnt(0)" ::: "memory");
        }
    }
    __syncthreads();
}

DI void peer_topk_process(float a0, float a1, float b0, float b1, int* EIDX, float* GATE, LAS float* scr, int item, int lane);
namespace pg8 {
#define PG8_LAS __attribute__((address_space(3)))
constexpr int BM = 256, BK = 64, HALF = 128, HTB = HALF * BK * 2, STAGE_BYTES = 8 * HTB, NXCD = 8, WGM = 8;
__host__ __device__ __forceinline__ int lds_byte(int r, int c) { const int st = (r >> 4) * 2 + (c >> 5), rr = r & 15, cc = c & 31, ob = rr * 64 + cc * 2; return st * 1024 + (ob ^ (((ob >> 9) & 1) << 5)); }
__host__ __device__ __forceinline__ void stage_rc(int b, int& R, int& C) { const int st = b / 1024, sb = b % 1024, swz = sb ^ (((sb >> 9) & 1) << 5); R = (st >> 1) * 16 + swz / 64; C = (st & 1) * 32 + (swz % 64) / 2; }
__host__ __device__ __forceinline__ int perm32(int rho) { const int n = rho >> 4, i = rho & 15; return 8 * (i >> 2) + 4 * n + (i & 3); }

struct Unit { const char* a; const char* b; int pm, pn, bz; };

struct Sched {
    const bf16* A; const bf16* B; size_t sA, sB; int lda, ldb, nM, nN, nB, G, c;
    DI bool next(int i, Unit& u) const {
        const long L = (long)i * G + c; const int per = nM * nN; if (L >= (long)per * nB) return false;
        const int bz = (int)(L / per); int wgid = (int)(L % per);
        { const int q = per / NXCD, r = per % NXCD, xcd = wgid % NXCD, off = wgid / NXCD; wgid = (xcd < r ? xcd * (q + 1) : r * (q + 1) + (xcd - r) * q) + off; }
        const int nig = WGM * nN, gid = wgid / nig, fm = gid * WGM, gsz = (nM - fm) < WGM ? (nM - fm) : WGM;
        u.pm = fm + ((wgid % nig) % gsz); u.pn = (wgid % nig) / gsz; u.bz = bz;
        u.a = (const char*)(A + (size_t)bz * sA + (size_t)u.pm * BM * lda); u.b = (const char*)(B + (size_t)bz * sB + (size_t)u.pn * BM * ldb);
        return true;
    }
};

struct SchedFold {
    const bf16* A; const bf16* B; int G, c;
    DI bool next(int i, Unit& u) const {
        const int L = i * G + c; if (L >= 256) return false;
        const int l = L >> 7, pm = (L >> 4) & 7, pn = L & 15; u.pm = pm; u.pn = pn; u.bz = l;
        u.a = (const char*)(A + (size_t)l * 2048 * 2048 + (size_t)pm * 256 * 2048 + pm * 256); u.b = (const char*)(B + (size_t)l * 4096 * 2048 + (size_t)pn * 256 * 2048 + pm * 256);
        return true;
    }
};
struct SchedRet {
    const bf16* A; const bf16* B; int mode, G, c;
    DI bool next(int i, Unit& u) const {
        const int L = i * G + c; if (L >= 256) return false;
        const int h = L >> 5, ch = L & 31; u.pm = 0; u.pn = 0; u.bz = L;
        if (mode == 0) { const size_t o = (size_t)ch * 256 * RW + h * RHD; u.a = (const char*)(A + o); u.b = (const char*)(B + o); }
        else if (mode == 1) { u.a = (const char*)(A + (size_t)L * 256 * 512); u.b = (const char*)(B + (size_t)h * RHD * T + ch * 256); }
        else { u.a = (const char*)(A + (size_t)L * 256 * 512); u.b = (const char*)(B + (size_t)L * 256 * 512); }
        return true;
    }
};
typedef int i32x8 __attribute__((ext_vector_type(8)));
typedef short s16x16 __attribute__((ext_vector_type(16)));
template <class Epi, class SchedT, bool FP8 = false>
DI void gemm_phase(PG8_LAS unsigned char* lds, const int tid_, const int K_, const int lda, const int ldb, const SchedT& S, const Epi& E) {
    int K = K_; asm volatile("" : "+s"(K));
    int tid = tid_; asm volatile("" : "+v"(tid));
    const int wid = __builtin_amdgcn_readfirstlane(tid >> 6), lane = tid & 63, wr = wid >> 2, wc = wid & 3, fr = lane & 15, fq = lane >> 4;
    const int nt = K / BK;
    unsigned voffA[2], voffB[2];
#pragma unroll
    for (int i = 0; i < 2; ++i) { int R, C; stage_rc(tid * 16 + i * 8192, R, C); const int Rb = Epi::PERM ? ((R & ~31) + perm32(R & 31)) : R;
        voffA[i] = (unsigned)(R * lda + C) * 2u; voffB[i] = (unsigned)(Rb * ldb + C) * 2u; }
    const size_t kstep = (size_t)(BK * 2);
    const size_t hsA = (size_t)HALF * lda * 2, hsB = (size_t)HALF * ldb * 2;
    const unsigned ldsw = (unsigned)wid * 1024u;
    const int aoff = lds_byte(wr * 64 + fr, fq * 8), boff = lds_byte(wc * 32 + fr, fq * 8);
#define PG8_SA(b, h) (((b) * 2 + (h)) * HTB)
#define PG8_SB(b, h) ((4 + (b) * 2 + (h)) * HTB)
#define PG8_STAGE(bufoff, gbase, voff) do { _Pragma("unroll") for (int _i = 0; _i < 2; ++_i) \
        __builtin_amdgcn_global_load_lds((const unsigned*)((const char*)(gbase) + (voff)[_i]), (PG8_LAS unsigned*)(lds + (bufoff) + ldsw + _i * 8192), 16, 0, 0); } while (0)
#define PG8_LDA(dst, b, h) do { _Pragma("unroll") for (int m = 0; m < 4; ++m) { const u32x4 f0 = *(const PG8_LAS u32x4*)(lds + PG8_SA(b, h) + aoff + m * 2048), f1 = *(const PG8_LAS u32x4*)(lds + PG8_SA(b, h) + aoff + m * 2048 + 1024); \
        dst[m] = __builtin_bit_cast(i32x8, __builtin_shufflevector(f0, f1, 0, 1, 2, 3, 4, 5, 6, 7)); } } while (0)
#define PG8_LDB(dst, b, h) do { _Pragma("unroll") for (int n = 0; n < 2; ++n) { const u32x4 f0 = *(const PG8_LAS u32x4*)(lds + PG8_SB(b, h) + boff + n * 2048), f1 = *(const PG8_LAS u32x4*)(lds + PG8_SB(b, h) + boff + n * 2048 + 1024); \
        dst[n] = __builtin_bit_cast(i32x8, __builtin_shufflevector(f0, f1, 0, 1, 2, 3, 4, 5, 6, 7)); } } while (0)
#define PG8_MMA(ai, bj, At, Bt) do { __builtin_amdgcn_s_setprio(1); _Pragma("unroll") for (int m = 0; m < 4; ++m) _Pragma("unroll") for (int n = 0; n < 2; ++n) { \
        if constexpr (FP8) { asm volatile("v_mfma_scale_f32_16x16x128_f8f6f4 %0, %1, %2, %0, %3, %4 op_sel_hi:[0,0,0]" : "+v"(acc[ai][bj][m][n]) : "v"(Bt[n]), "v"(At[m]), "v"(scw), "v"(scx)); } \
        else { const bf16x8 w0 = __builtin_bit_cast(bf16x8, __builtin_shufflevector(Bt[n], Bt[n], 0, 1, 2, 3)), w1 = __builtin_bit_cast(bf16x8, __builtin_shufflevector(Bt[n], Bt[n], 4, 5, 6, 7)); \
            const bf16x8 x0 = __builtin_bit_cast(bf16x8, __builtin_shufflevector(At[m], At[m], 0, 1, 2, 3)), x1 = __builtin_bit_cast(bf16x8, __builtin_shufflevector(At[m], At[m], 4, 5, 6, 7)); \
            acc[ai][bj][m][n] = __builtin_amdgcn_mfma_f32_16x16x32_bf16(w0, x0, acc[ai][bj][m][n], 0, 0, 0); acc[ai][bj][m][n] = __builtin_amdgcn_mfma_f32_16x16x32_bf16(w1, x1, acc[ai][bj][m][n], 0, 0, 0); } } \
        __builtin_amdgcn_s_setprio(0); } while (0)
#define PG8_WAIT_V(n) asm volatile("s_waitcnt vmcnt(" #n ")" ::: "memory")
#define PG8_WAIT_L(n) asm volatile("s_waitcnt lgkmcnt(" #n ")" ::: "memory")
#define PG8_BAR __builtin_amdgcn_s_barrier()
#define PG8_SCHED __builtin_amdgcn_sched_barrier(0)
    Unit cur, nxt; int ui = 0;
    if (!S.next(0, cur)) return;
    f32x4 acc[2][2][4][2];
#pragma unroll
    for (int a = 0; a < 2; ++a)
#pragma unroll
        for (int b = 0; b < 2; ++b)
#pragma unroll
            for (int m = 0; m < 4; ++m)
#pragma unroll
                for (int n = 0; n < 2; ++n) acc[a][b][m][n] = (f32x4){0.f, 0.f, 0.f, 0.f};
    const int scw = 0x77777777, scx = 0x7f7f7f7f;
    i32x8 At[4], B0[2], B1[2];
    const char* cA = cur.a; const char* cB = cur.b;
    PG8_STAGE(PG8_SB(0, 0), cB, voffB); PG8_STAGE(PG8_SB(0, 1), cB + hsB, voffB); PG8_STAGE(PG8_SA(0, 0), cA, voffA); PG8_STAGE(PG8_SA(0, 1), cA + hsA, voffA);
    if (wr == 1) PG8_BAR;
    PG8_WAIT_V(2); PG8_BAR;
    PG8_STAGE(PG8_SB(1, 0), cB + kstep, voffB); PG8_STAGE(PG8_SA(1, 0), cA + kstep, voffA); PG8_STAGE(PG8_SB(1, 1), cB + hsB + kstep, voffB);
    PG8_WAIT_V(6); PG8_BAR;
    for (;;) {
        const bool has_next = S.next(ui + 1, nxt);
        const char* nA = has_next ? nxt.a : cA; const char* nB = has_next ? nxt.b : cB;
        for (int t = 0; t < nt; t += 2) {
            const bool last = (t == nt - 2);
            const char* a1 = cA + (size_t)(t + 1) * kstep;
            const char* a2 = last ? nA : cA + (size_t)(t + 2) * kstep; const char* b2 = last ? nB : cB + (size_t)(t + 2) * kstep;
            const char* a3 = a2 + kstep; const char* b3 = b2 + kstep;
            PG8_LDB(B0, 0, 0); PG8_LDB(B1, 0, 1); PG8_SCHED; PG8_LDA(At, 0, 0); PG8_STAGE(PG8_SA(1, 1), a1 + hsA, voffA);
            PG8_WAIT_V(8); PG8_WAIT_L(0); PG8_BAR; PG8_MMA(0, 0, At, B0); PG8_MMA(0, 1, At, B1); PG8_BAR; PG8_SCHED;
            PG8_LDA(At, 0, 1); PG8_STAGE(PG8_SB(0, 0), b2, voffB); PG8_STAGE(PG8_SB(0, 1), b2 + hsB, voffB); PG8_STAGE(PG8_SA(0, 0), a2, voffA);
            PG8_WAIT_V(8); PG8_WAIT_L(0); PG8_BAR; PG8_MMA(1, 0, At, B0); PG8_MMA(1, 1, At, B1); PG8_BAR; PG8_SCHED;
            PG8_LDB(B0, 1, 0); PG8_LDB(B1, 1, 1); PG8_SCHED; PG8_LDA(At, 1, 0); PG8_STAGE(PG8_SA(0, 1), a2 + hsA, voffA);
            PG8_WAIT_V(8); PG8_WAIT_L(0); PG8_BAR; PG8_MMA(0, 0, At, B0); PG8_MMA(0, 1, At, B1); PG8_BAR; PG8_SCHED;
            PG8_LDA(At, 1, 1); PG8_STAGE(PG8_SB(1, 0), b3, voffB); PG8_STAGE(PG8_SB(1, 1), b3 + hsB, voffB); PG8_STAGE(PG8_SA(1, 0), a3, voffA);
            PG8_WAIT_V(8); PG8_WAIT_L(0); PG8_BAR; PG8_MMA(1, 0, At, B0); PG8_MMA(1, 1, At, B1); PG8_BAR; PG8_SCHED;
        }
        if (wr == 0) PG8_BAR;
        if constexpr (FP8) asm volatile("s_nop 15\n\ts_nop 15" ::: "memory");
        { int frE = fr, fqE = fq; asm volatile("" : "+v"(frE), "+v"(fqE)); E(acc, cur, wr, wc, frE, fqE); }
        if (!has_next) break;
#pragma unroll
        for (int a = 0; a < 2; ++a)
#pragma unroll
            for (int b = 0; b < 2; ++b)
#pragma unroll
                for (int m = 0; m < 4; ++m)
#pragma unroll
                    for (int n = 0; n < 2; ++n) acc[a][b][m][n] = (f32x4){0.f, 0.f, 0.f, 0.f};
        cur = nxt; cA = nA; cB = nB; ++ui;
        if (wr == 1) PG8_BAR;
    }
    PG8_WAIT_V(0);
    PG8_BAR;
#undef PG8_SA
#undef PG8_SB
#undef PG8_STAGE
#undef PG8_LDA
#undef PG8_LDB
#undef PG8_MMA
#undef PG8_WAIT_V
#undef PG8_WAIT_L
#undef PG8_BAR
#undef PG8_SCHED
}

#define EPI_LOOP_PERM(...) \
    _Pragma("unroll") for (int ai = 0; ai < 2; ++ai) _Pragma("unroll") for (int m = 0; m < 4; ++m) _Pragma("unroll") for (int bj = 0; bj < 2; ++bj) { \
        const int trow = ai * HALF + wr * 64 + m * 16 + fr, tcol = bj * HALF + wc * 32 + 8 * fq; const f32x4 v0 = acc[ai][bj][m][0], v1 = acc[ai][bj][m][1]; __VA_ARGS__ }

struct EpiBf16 {
    static constexpr bool PERM = true;
    bf16* O; int ldc; size_t sO;
    DI void operator()(const f32x4 (&acc)[2][2][4][2], const Unit& u, int wr, int wc, int fr, int fq) const {
        EPI_LOOP_PERM({ u32x4 w; w.x = pk2(v0[0], v0[1]); w.y = pk2(v0[2], v0[3]); w.z = pk2(v1[0], v1[1]); w.w = pk2(v1[2], v1[3]);
            *(u32x4*)(O + (size_t)u.bz * sO + (size_t)(u.pm * BM + trow) * ldc + u.pn * BM + tcol) = w; })
    }
};
struct EpiZ {
    static constexpr bool PERM = true;
    bf16* UC; bf16* Z; int thr, add0, add1;
    DI void operator()(const f32x4 (&acc)[2][2][4][2], const Unit& u, int wr, int wc, int fr, int fq) const {
        const int pn = u.pn + (u.pn < thr ? add0 : add1);
        EPI_LOOP_PERM({ u32x4 w; w.x = pk2(v0[0], v0[1]); w.y = pk2(v0[2], v0[3]); w.z = pk2(v1[0], v1[1]); w.w = pk2(v1[2], v1[3]);
            const int row = u.pm * BM + trow, col = pn * BM + tcol;
            if (pn < 8) { const int g = col >> 4, c = col & 15; *(u32x4*)(UC + ((size_t)(g * S5NC + (row >> 5)) * UCLD + (row & 31) * 16 + c)) = w; }
            else *(u32x4*)(Z + (size_t)row * ZW + (col - S5W)) = w; })
    }
};
struct EpiS5Y {
    static constexpr bool PERM = true;
    const bf16* UC; const float* dskip; bf16* Y;
    DI void operator()(const f32x4 (&acc)[2][2][4][2], const Unit& u, int wr, int wc, int fr, int fq) const {
        EPI_LOOP_PERM({ const int g = u.bz, chunk = trow, col = u.pn * BM + tcol, t = col >> 4, c = col & 15, tok = chunk * S5L + t, ch = g * 16 + c;
            const u32x4 uu = *(const u32x4*)(UC + ((size_t)(g * S5NC + chunk) * UCLD + col));
            const f32x4 d0 = *(const f32x4*)(dskip + ch), d1 = *(const f32x4*)(dskip + ch + 4);
            float y[8];
            y[0] = v0[0] + d0[0] * bflo(uu.x); y[1] = v0[1] + d0[1] * bfhi(uu.x); y[2] = v0[2] + d0[2] * bflo(uu.y); y[3] = v0[3] + d0[3] * bfhi(uu.y);
            y[4] = v1[0] + d1[0] * bflo(uu.z); y[5] = v1[1] + d1[1] * bfhi(uu.z); y[6] = v1[2] + d1[2] * bflo(uu.w); y[7] = v1[3] + d1[3] * bfhi(uu.w);
            _Pragma("unroll") for (int e = 0; e < 8; ++e) y[e] = gelu_tanh(y[e]);
            u32x4 w; w.x = pk2(y[0], y[1]); w.y = pk2(y[2], y[3]); w.z = pk2(y[4], y[5]); w.w = pk2(y[6], y[7]);
            *(u32x4*)(Y + (size_t)tok * S5W + ch) = w; })
    }
};
struct EpiGlu {
    static constexpr bool PERM = true;
    const bf16* YP; const float* bias; bf16* O;
    DI void operator()(const f32x4 (&acc)[2][2][4][2], const Unit& u, int wr, int wc, int fr, int fq) const {
        EPI_LOOP_PERM({ const int row = u.pm * BM + trow, col = u.pn * BM + tcol;
            const u32x4 yy = *(const u32x4*)(YP + (size_t)row * S5W + col);
            const f32x4 b0 = *(const f32x4*)(bias + col), b1 = *(const f32x4*)(bias + col + 4);
            float y[8];
            y[0] = bflo(yy.x) * sigmoidf_(v0[0] + b0[0]); y[1] = bfhi(yy.x) * sigmoidf_(v0[1] + b0[1]); y[2] = bflo(yy.y) * sigmoidf_(v0[2] + b0[2]); y[3] = bfhi(yy.y) * sigmoidf_(v0[3] + b0[3]);
            y[4] = bflo(yy.z) * sigmoidf_(v1[0] + b1[0]); y[5] = bfhi(yy.z) * sigmoidf_(v1[1] + b1[1]); y[6] = bflo(yy.w) * sigmoidf_(v1[2] + b1[2]); y[7] = bfhi(yy.w) * sigmoidf_(v1[3] + b1[3]);
            if (FP8_EWO) { u32x2 w8; w8.x = pk4_fp8(y[0], y[1], y[2], y[3]); w8.y = pk4_fp8(y[4], y[5], y[6], y[7]); *(u32x2*)((unsigned char*)O + (size_t)row * D + col) = w8; }
            else { u32x4 w; w.x = pk2(y[0], y[1]); w.y = pk2(y[2], y[3]); w.z = pk2(y[4], y[5]); w.w = pk2(y[6], y[7]);
            *(u32x4*)(O + (size_t)row * D + col) = w; } })
    }
};
#define EPI_LOOP_NAT(...) \
    _Pragma("unroll") for (int ai = 0; ai < 2; ++ai) _Pragma("unroll") for (int m = 0; m < 4; ++m) _Pragma("unroll") for (int bj = 0; bj < 2; ++bj) _Pragma("unroll") for (int n = 0; n < 2; ++n) { \
        const int trow = ai * HALF + wr * 64 + m * 16 + fr, tcol = bj * HALF + wc * 32 + 16 * n + 4 * fq; const f32x4 v = acc[ai][bj][m][n]; __VA_ARGS__ }
struct EpiF32 {
    static constexpr bool PERM = false;
    float* C; const float* res; int ldc;
    DI void operator()(const f32x4 (&acc)[2][2][4][2], const Unit& u, int wr, int wc, int fr, int fq) const {
        EPI_LOOP_NAT({ const size_t o = (size_t)(u.pm * BM + trow) * ldc + u.pn * BM + tcol; f32x4 r = v; if (res) r = r + *(const f32x4*)(res + o); *(f32x4*)(C + o) = r; })
    }
};
struct EpiS5E {
    static constexpr bool PERM = false;
    float* Eo;
    DI void operator()(const f32x4 (&acc)[2][2][4][2], const Unit& u, int wr, int wc, int fr, int fq) const {
        EPI_LOOP_NAT({ if (bj == 0) *(f32x4*)(Eo + ((size_t)(u.bz * S5NC + trow) * 128 + tcol)) = v; })
    }
};
struct EpiRetS {
    static constexpr bool PERM = true;
    bf16* SQ;
    DI void operator()(const f32x4 (&acc)[2][2][4][2], const Unit& u, int wr, int wc, int fr, int fq) const {
        const float lg2 = log2f(1.f - exp2f(-5.f - (float)(u.bz >> 5)));
        EPI_LOOP_PERM({ const int d = trow - tcol; float y[8];
            _Pragma("unroll") for (int e = 0; e < 8; ++e) { const int dd = d - e; const float sc = __builtin_amdgcn_exp2f(lg2 * (float)dd); const float v = e < 4 ? v0[e & 3] : v1[e & 3];
                y[e] = __builtin_bit_cast(float, __builtin_bit_cast(int, v * sc) & ~(dd >> 31)); }
            u32x4 w; w.x = pk2(y[0], y[1]); w.y = pk2(y[2], y[3]); w.z = pk2(y[4], y[5]); w.w = pk2(y[6], y[7]);
            *(u32x4*)(SQ + ((size_t)u.bz * 256 + trow) * 512 + tcol) = w; })
    }
};
struct EpiRetKV {
    static constexpr bool PERM = false;
    float* KVT;
    DI void operator()(const f32x4 (&acc)[2][2][4][2], const Unit& u, int wr, int wc, int fr, int fq) const {
        EPI_LOOP_NAT({ *(f32x4*)(KVT + ((size_t)u.bz * 256 + trow) * 256 + tcol) = v; })
    }
};
struct EpiQK {
    static constexpr bool PERM = true;
    bf16* O; const float* qg; const float* kg; PG8_LAS float* red;
    DI void operator()(const f32x4 (&acc)[2][2][4][2], const Unit& u, int wr, int wc, int fr, int fq) const {
        const int which = u.pn >> 4;
        _Pragma("unroll") for (int ai = 0; ai < 2; ++ai) _Pragma("unroll") for (int m = 0; m < 4; ++m) _Pragma("unroll") for (int bj = 0; bj < 2; ++bj) {
            const f32x4 v0 = acc[ai][bj][m][0], v1 = acc[ai][bj][m][1];
            float s = ((v0[0] * v0[0] + v0[1] * v0[1]) + (v0[2] * v0[2] + v0[3] * v0[3])) + ((v1[0] * v1[0] + v1[1] * v1[1]) + (v1[2] * v1[2] + v1[3] * v1[3]));
            s += __shfl_xor(s, 16); s += __shfl_xor(s, 32);
            if (fq == 0) red[(bj * 256 + ai * HALF + wr * 64 + m * 16 + fr) * 4 + wc] = s; }
        asm volatile("s_waitcnt lgkmcnt(0)" ::: "memory"); __builtin_amdgcn_s_barrier(); asm volatile("" ::: "memory");
        const float* gp = (which ? kg : qg) + wc * 32 + 8 * fq; const f32x4 g0 = *(const f32x4*)gp, g1 = *(const f32x4*)(gp + 4);
        const float sc = which ? 1.f : 0.08838834764831845f * LOG2E;
        EPI_LOOP_PERM({ const f32x4 r4 = *(const PG8_LAS f32x4*)(red + (bj * 256 + trow) * 4);
            const float rs = (1.f / sqrtf(((r4[0] + r4[1]) + (r4[2] + r4[3])) * (1.f / AHD) + EPS)) * sc;
            u32x4 w; w.x = pk2(v0[0] * rs * g0[0], v0[1] * rs * g0[1]); w.y = pk2(v0[2] * rs * g0[2], v0[3] * rs * g0[3]); w.z = pk2(v1[0] * rs * g1[0], v1[1] * rs * g1[1]); w.w = pk2(v1[2] * rs * g1[2], v1[3] * rs * g1[3]);
            *(u32x4*)(O + (size_t)(u.pm * BM + trow) * QKVW + u.pn * BM + tcol) = w; })
    }
};
struct EpiRetOut {
    static constexpr bool PERM = true;
    const bf16* Z; const float* gng; const float* gnb; bf16* YCAT; PG8_LAS float* red;
    DI void operator()(const f32x4 (&acc)[2][2][4][2], const Unit& u, int wr, int wc, int fr, int fq) const {
        const int h = u.bz >> 5, t0 = (u.bz & 31) * 256;
        float mean[2][4], rstd[2][4];
        _Pragma("unroll") for (int ai = 0; ai < 2; ++ai) _Pragma("unroll") for (int m = 0; m < 4; ++m) { float s = 0.f;
            _Pragma("unroll") for (int bj = 0; bj < 2; ++bj) _Pragma("unroll") for (int n = 0; n < 2; ++n) { const f32x4 v = acc[ai][bj][m][n]; s += (v[0] + v[1]) + (v[2] + v[3]); }
            s += __shfl_xor(s, 16); s += __shfl_xor(s, 32);
            if (fq == 0) red[(ai * HALF + wr * 64 + m * 16 + fr) * 4 + wc] = s; }
        asm volatile("s_waitcnt lgkmcnt(0)" ::: "memory"); __builtin_amdgcn_s_barrier(); asm volatile("" ::: "memory");
        _Pragma("unroll") for (int ai = 0; ai < 2; ++ai) _Pragma("unroll") for (int m = 0; m < 4; ++m) { const f32x4 r4 = *(const PG8_LAS f32x4*)(red + (ai * HALF + wr * 64 + m * 16 + fr) * 4);
            mean[ai][m] = ((r4[0] + r4[1]) + (r4[2] + r4[3])) * (1.f / 256.f); }
        _Pragma("unroll") for (int ai = 0; ai < 2; ++ai) _Pragma("unroll") for (int m = 0; m < 4; ++m) { float s = 0.f;
            _Pragma("unroll") for (int bj = 0; bj < 2; ++bj) _Pragma("unroll") for (int n = 0; n < 2; ++n) { const f32x4 v = acc[ai][bj][m][n] - mean[ai][m]; s += (v[0] * v[0] + v[1] * v[1]) + (v[2] * v[2] + v[3] * v[3]); }
            s += __shfl_xor(s, 16); s += __shfl_xor(s, 32);
            if (fq == 0) red[1024 + (ai * HALF + wr * 64 + m * 16 + fr) * 4 + wc] = s; }
        asm volatile("s_waitcnt lgkmcnt(0)" ::: "memory"); __builtin_amdgcn_s_barrier(); asm volatile("" ::: "memory");
        _Pragma("unroll") for (int ai = 0; ai < 2; ++ai) _Pragma("unroll") for (int m = 0; m < 4; ++m) { const f32x4 r4 = *(const PG8_LAS f32x4*)(red + 1024 + (ai * HALF + wr * 64 + m * 16 + fr) * 4);
            rstd[ai][m] = 1.f / sqrtf(((r4[0] + r4[1]) + (r4[2] + r4[3])) * (1.f / 256.f) + EPS); }
        EPI_LOOP_PERM({ const int t = t0 + trow, ch = h * RHD + tcol;
            const f32x4 g0 = *(const f32x4*)(gng + ch), g1 = *(const f32x4*)(gng + ch + 4), b0 = *(const f32x4*)(gnb + ch), b1 = *(const f32x4*)(gnb + ch + 4);
            const u32x4 gz = *(const u32x4*)(Z + (size_t)t * ZW + 3 * RW + ch);
            float gt[8]; gt[0] = bflo(gz.x); gt[1] = bfhi(gz.x); gt[2] = bflo(gz.y); gt[3] = bfhi(gz.y); gt[4] = bflo(gz.z); gt[5] = bfhi(gz.z); gt[6] = bflo(gz.w); gt[7] = bfhi(gz.w);
            float y[8];
            _Pragma("unroll") for (int e = 0; e < 8; ++e) { const float v = e < 4 ? v0[e & 3] : v1[e & 3]; const float gg = e < 4 ? g0[e & 3] : g1[e & 3]; const float bb = e < 4 ? b0[e & 3] : b1[e & 3];
                y[e] = ((v - mean[ai][m]) * rstd[ai][m] * gg + bb) * (gt[e] * sigmoidf_(gt[e])); }
            if (FP8_EWO) { u32x2 w8; w8.x = pk4_fp8(y[0], y[1], y[2], y[3]); w8.y = pk4_fp8(y[4], y[5], y[6], y[7]); *(u32x2*)((unsigned char*)YCAT + (size_t)t * D + S5W + ch) = w8; }
            else { u32x4 w; w.x = pk2(y[0], y[1]); w.y = pk2(y[2], y[3]); w.z = pk2(y[4], y[5]); w.w = pk2(y[6], y[7]);
            *(u32x4*)(YCAT + (size_t)t * D + S5W + ch) = w; } })
    }
};
struct EpiTopk {
    static constexpr bool PERM = false;
    int* EIDX; float* GATE; PG8_LAS unsigned char* lds;
    DI void operator()(const f32x4 (&acc)[2][2][4][2], const Unit& u, int wr, int wc, int fr, int fq) const {
        const int lane = fq * 16 + fr, wave = wr * 4 + wc;
        PG8_LAS float* tile = (PG8_LAS float*)lds; PG8_LAS float* scr = (PG8_LAS float*)(lds + 131072 + wave * 1024);
        asm volatile("s_waitcnt vmcnt(0)" ::: "memory");
        _Pragma("unroll") for (int ai = 0; ai < 2; ++ai) {
            asm volatile("s_waitcnt lgkmcnt(0)" ::: "memory"); __builtin_amdgcn_s_barrier(); asm volatile("" ::: "memory");
            _Pragma("unroll") for (int m = 0; m < 4; ++m) _Pragma("unroll") for (int bj = 0; bj < 2; ++bj) _Pragma("unroll") for (int n = 0; n < 2; ++n) {
                const int row = wr * 64 + m * 16 + fr, c4 = (bj * HALF + wc * 32 + 16 * n + 4 * fq) >> 2;
                *(PG8_LAS f32x4*)(tile + row * 256 + ((c4 ^ (row & 15)) << 2)) = acc[ai][bj][m][n]; }
            asm volatile("s_waitcnt lgkmcnt(0)" ::: "memory"); __builtin_amdgcn_s_barrier(); asm volatile("" ::: "memory");
            _Pragma("unroll 1") for (int rr = 0; rr < 16; ++rr) { const int row = wave * 16 + rr; const PG8_LAS float* rp = tile + row * 256; const int sw = row & 15, l4 = lane >> 2, l0 = lane & 3;
                const float a0 = rp[((l4 ^ sw) << 2) + l0], a1 = rp[(((16 + l4) ^ sw) << 2) + l0], b0 = rp[(((32 + l4) ^ sw) << 2) + l0], b1 = rp[(((48 + l4) ^ sw) << 2) + l0];
                peer_topk_process(a0, a1, b0, b1, EIDX, GATE, scr, (u.pm * BM + ai * HALF + row) * 8 + u.pn, lane); }
        }
    }
};
}

struct Args { const float* in[32]; float* out; unsigned char* ws; int ph_lo, ph_hi; };
enum { I_X = 0, I_EVG, I_EWIN, I_S5LS, I_S5ARE, I_S5AIM, I_S5BRE, I_S5BIM, I_S5CRE, I_S5CIM, I_S5D, I_GLUW, I_GLUB, I_GNG, I_GNB, I_EWOUT,
       I_ODG, I_OWIN, I_QNG, I_KNG, I_LQ1, I_LK1, I_LQ2, I_LK2, I_SUBG, I_OWOUT, I_RELB, I_FFNG, I_PWQ, I_PKEYS, I_PU, I_PV };

struct PA { const Args& k; unsigned char* ws; float* out; };
DI const float* inp(const PA& a, int i) { asm volatile("" : "+s"(i)); return a.k.in[i]; }

DI void transpose_item(const float* W, int K, int N, bf16* WT, const float* gain, LAS float* scr, int item, int lane) {
    const int nblk = N / 32, kb = item / nblk, nb = item % nblk, k0 = 64 * kb, n0 = 32 * nb;
#pragma unroll 8
    for (int i = 0; i < 32; ++i) { const int kk = 2 * i + (lane >> 5); float v = W[(size_t)(k0 + kk) * N + n0 + (lane & 31)]; if (gain) v *= gain[k0 + kk]; scr[kk * 33 + (lane & 31)] = v; }
    asm volatile("s_waitcnt lgkmcnt(0)" ::: "memory");
    const int c = lane & 7;
#pragma unroll
    for (int j = 0; j < 4; ++j) { const int n = (lane >> 3) + 8 * j; const LAS float* s = scr + (8 * c) * 33 + n;
        u32x4 o; o.x = pk2(s[0 * 33], s[1 * 33]); o.y = pk2(s[2 * 33], s[3 * 33]); o.z = pk2(s[4 * 33], s[5 * 33]); o.w = pk2(s[6 * 33], s[7 * 33]);
        *(u32x4*)(WT + (size_t)(n0 + n) * K + k0 + 8 * c) = o; }
    asm volatile("s_waitcnt lgkmcnt(0)" ::: "memory");
}
DI void transpose_item8(const float* W, int K, int N, unsigned char* WT, LAS float* scr, int item, int lane, int roff = 0) {
    const int nblk = N / 32, kb = item / nblk, nb = item % nblk, k0 = 64 * kb, n0 = 32 * nb;
#pragma unroll 8
    for (int i = 0; i < 32; ++i) { const int kk = 2 * i + (lane >> 5); scr[kk * 33 + (lane & 31)] = W[(size_t)(k0 + kk) * N + n0 + (lane & 31)] * 256.f; }
    asm volatile("s_waitcnt lgkmcnt(0)" ::: "memory");
    const int c = lane & 7;
#pragma unroll
    for (int j = 0; j < 4; ++j) { const int n = (lane >> 3) + 8 * j; const LAS float* sp = scr + (8 * c) * 33 + n;
        u32x2 o; o.x = pk4_fp8(sp[0 * 33], sp[1 * 33], sp[2 * 33], sp[3 * 33]); o.y = pk4_fp8(sp[4 * 33], sp[5 * 33], sp[6 * 33], sp[7 * 33]);
        *(u32x2*)(WT + (size_t)(n0 + n + roff) * K + k0 + 8 * c) = o; }
    asm volatile("s_waitcnt lgkmcnt(0)" ::: "memory");
}
DI void rms_row8(const float* xrow, const float* g, unsigned char* orow, int lane) {
    const f32x4* xr = (const f32x4*)xrow + lane; const f32x4* gr = (const f32x4*)g + lane;
    f32x4 v[16]; float s = 0.f;
#pragma unroll
    for (int j = 0; j < 16; ++j) { v[j] = xr[64 * j]; s += (v[j].x * v[j].x + v[j].y * v[j].y) + (v[j].z * v[j].z + v[j].w * v[j].w); }
    const float rstd = 1.f / sqrtf(wave_sum(s) * (1.f / D) + EPS);
    unsigned* o4 = (unsigned*)orow + lane;
#pragma unroll
    for (int j = 0; j < 16; ++j) { const f32x4 gg = gr[64 * j]; o4[64 * j] = pk4_fp8(v[j].x * rstd * gg.x, v[j].y * rstd * gg.y, v[j].z * rstd * gg.z, v[j].w * rstd * gg.w); }
}
DI void rms_row(const float* xrow, const float* g, bf16* orow, int lane) {
    const f32x4* xr = (const f32x4*)xrow + lane; const f32x4* gr = (const f32x4*)g + lane;
    f32x4 v[16]; float s = 0.f;
#pragma unroll
    for (int j = 0; j < 16; ++j) { v[j] = xr[64 * j]; s += (v[j].x * v[j].x + v[j].y * v[j].y) + (v[j].z * v[j].z + v[j].w * v[j].w); }
    const float rstd = 1.f / sqrtf(wave_sum(s) * (1.f / D) + EPS);
    u32x2* o8 = (u32x2*)orow + lane;
#pragma unroll
    for (int j = 0; j < 16; ++j) { const f32x4 gg = gr[64 * j]; u32x2 w; w.x = pk2(v[j].x * rstd * gg.x, v[j].y * rstd * gg.y); w.y = pk2(v[j].z * rstd * gg.z, v[j].w * rstd * gg.w); o8[64 * j] = w; }
}
DI void rms_row_both(const float* xrow, const float* g, bf16* orow, unsigned char* o8row, int lane) {
    const f32x4* xr = (const f32x4*)xrow + lane; const f32x4* gr = (const f32x4*)g + lane;
    f32x4 v[16]; float s = 0.f;
#pragma unroll
    for (int j = 0; j < 16; ++j) { v[j] = xr[64 * j]; s += (v[j].x * v[j].x + v[j].y * v[j].y) + (v[j].z * v[j].z + v[j].w * v[j].w); }
    const float rstd = 1.f / sqrtf(wave_sum(s) * (1.f / D) + EPS);
    u32x2* o8 = (u32x2*)orow + lane; unsigned* o4 = (unsigned*)o8row + lane;
#pragma unroll
    for (int j = 0; j < 16; ++j) { const f32x4 gg = gr[64 * j]; const float y0 = v[j].x * rstd * gg.x, y1 = v[j].y * rstd * gg.y, y2 = v[j].z * rstd * gg.z, y3 = v[j].w * rstd * gg.w;
        u32x2 w; w.x = pk2(y0, y1); w.y = pk2(y2, y3); o8[64 * j] = w; o4[64 * j] = pk4_fp8(y0, y1, y2, y3); }
}
DI void rms_phase(const float* x, const float* g, bf16* H, int gw, int ngw, int lane) {
    for (int m = gw; m < T; m += ngw) rms_row(x + (size_t)m * D, g, H + (size_t)m * D, lane);
}

DI void s5_build(const PA& a, LAS unsigned char* lds, int g, int tid) {
    LAS float* lam = (LAS float*)lds;
    LAS float* ang = lam + 64;
    LAS float* fre = ang + 64; LAS float* fim = fre + 64;
    LAS float* bbr = fim + 64; LAS float* bbi = bbr + 1024;
    LAS float* ccr = bbi + 1024; LAS float* cci = ccr + 1024;
    LAS float* pwr = cci + 1024; LAS float* pwi = pwr + 33 * 64;
    LAS float* km = pwi + 33 * 64;
    bf16* BT13 = (bf16*)(a.ws + WS_BT13) + (size_t)g * 512 * UCLD; bf16* BTE = (bf16*)(a.ws + WS_BTE) + (size_t)g * 256 * 512;
    float* PW32 = (float*)(a.ws + WS_PW32) + (size_t)g * 128;
    __syncthreads();
    if (tid < 64) { const int p = tid; const float step = expf(inp(a, I_S5LS)[g]); const float lr = inp(a, I_S5ARE)[g * 64 + p], li = inp(a, I_S5AIM)[g * 64 + p];
        const float mag = expf(lr * step), ar = mag * cosf(li * step), ai = mag * sinf(li * step), den = lr * lr + li * li, nr = ar - 1.f;
        lam[p] = lr * step; ang[p] = li * step; fre[p] = (nr * lr + ai * li) / den; fim[p] = (ai * lr - nr * li) / den; }
    __syncthreads();
    for (int i = tid; i < 1024; i += 512) { const int p = i >> 4; const float br = inp(a, I_S5BRE)[(size_t)g * 1024 + i], bi = inp(a, I_S5BIM)[(size_t)g * 1024 + i];
        bbr[i] = fre[p] * br - fim[p] * bi; bbi[i] = fre[p] * bi + fim[p] * br;
        ccr[i] = inp(a, I_S5CRE)[(size_t)g * 1024 + i]; cci[i] = inp(a, I_S5CIM)[(size_t)g * 1024 + i]; }
    for (int i = tid; i < 33 * 64; i += 512) { const int tau = i >> 6, p = i & 63; const float m = expf(lam[p] * (float)tau), an = ang[p] * (float)tau; pwr[i] = m * cosf(an); pwi[i] = m * sinf(an); }
    __syncthreads();
    if (tid < 64) { PW32[tid] = pwr[32 * 64 + tid]; PW32[64 + tid] = pwi[32 * 64 + tid]; }
    for (int i = tid; i < 8192; i += 512) { const int tau = i >> 8, c2 = (i >> 4) & 15, c = i & 15; float s = 0.f;
        for (int p = 0; p < 64; ++p) { const float cr = ccr[c2 * 64 + p], ci = cci[c2 * 64 + p], pr = pwr[tau * 64 + p], pi = pwi[tau * 64 + p];
            const float wr_ = cr * pr - ci * pi, wi_ = cr * pi + ci * pr; s += wr_ * bbr[p * 16 + c] - wi_ * bbi[p * 16 + c]; }
        km[i] = s; }
    __syncthreads();
    for (int q = tid; q < 512 * 80; q += 512) { const int row = q / 80, col0 = (q % 80) * 8, t = row >> 4, c2 = row & 15; float v[8];
        if (col0 < 512) { const int j = col0 >> 4, c0 = col0 & 15, tau = t - j;
#pragma unroll
            for (int e = 0; e < 8; ++e) v[e] = tau >= 0 ? km[tau * 256 + c2 * 16 + c0 + e] : 0.f; }
        else {
#pragma unroll
            for (int e = 0; e < 8; ++e) { const int pp = col0 - 512 + e, p = pp & 63; const float cr = ccr[c2 * 64 + p], ci = cci[c2 * 64 + p], pr = pwr[(t + 1) * 64 + p], pi = pwi[(t + 1) * 64 + p];
                v[e] = pp < 64 ? (cr * pr - ci * pi) : -(cr * pi + ci * pr); } }
        u32x4 w; w.x = pk2(v[0], v[1]); w.y = pk2(v[2], v[3]); w.z = pk2(v[4], v[5]); w.w = pk2(v[6], v[7]);
        *(u32x4*)(BT13 + (size_t)row * UCLD + col0) = w; }
    for (int q = tid; q < 256 * 64; q += 512) { const int row = q >> 6, col0 = (q & 63) * 8, j = col0 >> 4, c0 = col0 & 15; float v[8];
        if (row < 128) { const int p = row & 63, ri = row >> 6; const float pr = pwr[(31 - j) * 64 + p], pi = pwi[(31 - j) * 64 + p];
#pragma unroll
            for (int e = 0; e < 8; ++e) { const float br = bbr[p * 16 + c0 + e], bi = bbi[p * 16 + c0 + e]; v[e] = ri == 0 ? (pr * br - pi * bi) : (pr * bi + pi * br); } }
        else {
#pragma unroll
            for (int e = 0; e < 8; ++e) v[e] = 0.f; }
        u32x4 w; w.x = pk2(v[0], v[1]); w.y = pk2(v[2], v[3]); w.z = pk2(v[4], v[5]); w.w = pk2(v[6], v[7]);
        *(u32x4*)(BTE + (size_t)row * 512 + col0) = w; }
    __syncthreads();
}

DI void s5_scan(const PA& a, LAS unsigned char* lds, int g, int tid) {
    const int p = tid & 63, seg = tid >> 6;
    const float* E = (const float*)(a.ws + WS_E) + ((size_t)(g * S5NC + seg * 32)) * 128 + p;
    const float* PW32 = (const float*)(a.ws + WS_PW32) + (size_t)g * 128;
    bf16* UC = (bf16*)(a.ws + WS_UC) + ((size_t)(g * S5NC + seg * 32)) * UCLD + 512 + p;
    LAS float* se = (LAS float*)lds;
    const float Ar = PW32[p], Ai = PW32[64 + p];
    float er[32], ei[32];
#pragma unroll
    for (int k = 0; k < 32; ++k) { er[k] = E[(size_t)k * 128]; ei[k] = E[(size_t)k * 128 + 64]; }
    float sr = 0.f, si = 0.f;
#pragma unroll
    for (int k = 0; k < 32; ++k) { const float nr = Ar * sr - Ai * si + er[k], ni = Ar * si + Ai * sr + ei[k]; sr = nr; si = ni; }
    __syncthreads();
    se[(seg * 64 + p) * 2] = sr; se[(seg * 64 + p) * 2 + 1] = si;
    float Pr = Ar, Pi = Ai;
#pragma unroll
    for (int k = 0; k < 5; ++k) { const float nr = Pr * Pr - Pi * Pi, ni = 2.f * Pr * Pi; Pr = nr; Pi = ni; }
    __syncthreads();
    float cr = 0.f, ci = 0.f;
    for (int s2 = 0; s2 < seg; ++s2) { const float xr = se[(s2 * 64 + p) * 2], xi = se[(s2 * 64 + p) * 2 + 1]; const float nr = Pr * cr - Pi * ci + xr, ni = Pr * ci + Pi * cr + xi; cr = nr; ci = ni; }
#pragma unroll
    for (int k = 0; k < 32; ++k) { UC[(size_t)k * UCLD] = (bf16)(pk2(cr, 0.f) & 0xffffu); UC[(size_t)k * UCLD + 64] = (bf16)(pk2(ci, 0.f) & 0xffffu);
        const float nr = Ar * cr - Ai * ci + er[k], ni = Ar * ci + Ai * cr + ei[k]; cr = nr; ci = ni; }
    __syncthreads();
}

DI void v_transpose_tile(const bf16* Vsrc, int ld, bf16* dst, int dpitch, int t0, int c0, LAS unsigned char* lds, int tid) {
    LAS bf16* tile = (LAS bf16*)lds;
    __syncthreads();
#pragma unroll
    for (int i = 0; i < 4; ++i) { const int q = tid + 512 * i, tt = q >> 5, d0 = (q & 31) * 8; const u32x4 v = *(const u32x4*)(Vsrc + (size_t)(t0 + tt) * ld + d0);
        tile[(d0 + 0) * 72 + tt] = (bf16)(v.x & 0xffffu); tile[(d0 + 1) * 72 + tt] = (bf16)(v.x >> 16); tile[(d0 + 2) * 72 + tt] = (bf16)(v.y & 0xffffu); tile[(d0 + 3) * 72 + tt] = (bf16)(v.y >> 16);
        tile[(d0 + 4) * 72 + tt] = (bf16)(v.z & 0xffffu); tile[(d0 + 5) * 72 + tt] = (bf16)(v.z >> 16); tile[(d0 + 6) * 72 + tt] = (bf16)(v.w & 0xffffu); tile[(d0 + 7) * 72 + tt] = (bf16)(v.w >> 16); }
    __syncthreads();
#pragma unroll
    for (int i = 0; i < 4; ++i) { const int q = tid + 512 * i, dv = q >> 3, cc = q & 7; const u32x4 v = *(const LAS u32x4*)(tile + dv * 72 + cc * 8);
        *(u32x4*)(dst + (size_t)dv * dpitch + c0 + cc * 8) = v; }
}

DI void ret_prep_item(const PA& a, LAS unsigned char* lds, int item, int tid) {
    const int h = item & 7, t0 = (item >> 3) * 64, ch = t0 >> 8, jl0 = t0 & 255, bz = h * 32 + ch;
    const bf16* Z = (const bf16*)(a.ws + WS_Z); bf16* QR = (bf16*)(a.ws + WS_QR); bf16* KR = (bf16*)(a.ws + WS_KR);
    bf16* SQ = (bf16*)(a.ws + WS_SQ) + (size_t)bz * 256 * 512; bf16* VS = (bf16*)(a.ws + WS_VS) + (size_t)bz * 256 * 512; bf16* KDT = (bf16*)(a.ws + WS_KDT) + (size_t)h * RHD * T;
    LAS bf16* tile = (LAS bf16*)lds;
    const float lg2 = log2f(1.f - exp2f(-5.f - (float)h));
    __syncthreads();
#pragma unroll
    for (int i = 0; i < 2; ++i) { const int q = tid + 512 * i, tt = q >> 4, i0 = (q & 15) * 8, t = t0 + tt, jl = jl0 + tt;
        const float qdec = __builtin_amdgcn_exp2f(lg2 * (float)(jl + 1)), kdec = __builtin_amdgcn_exp2f(lg2 * (float)(255 - jl));
        float cs[8], sn[8];
#pragma unroll
        for (int e = 0; e < 8; ++e) { const float fr_ = expf(-(float)(i0 + e) * (9.210340371976184f / 128.f));
            const float rev = __builtin_amdgcn_fractf((float)t * fr_ * 0.15915494309189535f); sn[e] = __builtin_amdgcn_sinf(rev); cs[e] = __builtin_amdgcn_cosf(rev); }
#pragma unroll
        for (int which = 0; which < 2; ++which) { const bf16* src = Z + (size_t)t * ZW + which * RW + h * RHD + i0; bf16* dst = (which ? KR : QR) + (size_t)t * RW + h * RHD + i0; const float sc = which ? 0.0625f : 1.f;
            const u32x4 x1 = *(const u32x4*)src, x2 = *(const u32x4*)(src + 128); float a1[8], a2[8];
            a1[0] = bflo(x1.x); a1[1] = bfhi(x1.x); a1[2] = bflo(x1.y); a1[3] = bfhi(x1.y); a1[4] = bflo(x1.z); a1[5] = bfhi(x1.z); a1[6] = bflo(x1.w); a1[7] = bfhi(x1.w);
            a2[0] = bflo(x2.x); a2[1] = bfhi(x2.x); a2[2] = bflo(x2.y); a2[3] = bfhi(x2.y); a2[4] = bflo(x2.z); a2[5] = bfhi(x2.z); a2[6] = bflo(x2.w); a2[7] = bfhi(x2.w);
            float o1[8], o2[8];
#pragma unroll
            for (int e = 0; e < 8; ++e) { o1[e] = (a1[e] * cs[e] - a2[e] * sn[e]) * sc; o2[e] = (a1[e] * sn[e] + a2[e] * cs[e]) * sc; }
            u32x4 w1, w2; w1.x = pk2(o1[0], o1[1]); w1.y = pk2(o1[2], o1[3]); w1.z = pk2(o1[4], o1[5]); w1.w = pk2(o1[6], o1[7]);
            w2.x = pk2(o2[0], o2[1]); w2.y = pk2(o2[2], o2[3]); w2.z = pk2(o2[4], o2[5]); w2.w = pk2(o2[6], o2[7]);
            *(u32x4*)dst = w1; *(u32x4*)(dst + 128) = w2;
            if (which == 0) { u32x4 d1, d2; d1.x = pk2(o1[0] * qdec, o1[1] * qdec); d1.y = pk2(o1[2] * qdec, o1[3] * qdec); d1.z = pk2(o1[4] * qdec, o1[5] * qdec); d1.w = pk2(o1[6] * qdec, o1[7] * qdec);
                d2.x = pk2(o2[0] * qdec, o2[1] * qdec); d2.y = pk2(o2[2] * qdec, o2[3] * qdec); d2.z = pk2(o2[4] * qdec, o2[5] * qdec); d2.w = pk2(o2[6] * qdec, o2[7] * qdec);
                bf16* sq = SQ + (size_t)jl * 512 + 256 + i0; *(u32x4*)sq = d1; *(u32x4*)(sq + 128) = d2; }
            else {
#pragma unroll
                for (int e = 0; e < 8; e += 2) { const unsigned p1 = pk2(o1[e] * kdec, o1[e + 1] * kdec), p2 = pk2(o2[e] * kdec, o2[e + 1] * kdec);
                    tile[(i0 + e) * 72 + tt] = (bf16)(p1 & 0xffffu); tile[(i0 + e + 1) * 72 + tt] = (bf16)(p1 >> 16); tile[(128 + i0 + e) * 72 + tt] = (bf16)(p2 & 0xffffu); tile[(128 + i0 + e + 1) * 72 + tt] = (bf16)(p2 >> 16); } } } }
    __syncthreads();
#pragma unroll
    for (int i = 0; i < 4; ++i) { const int q = tid + 512 * i, d = q >> 3, cc = q & 7; const u32x4 v = *(const LAS u32x4*)(tile + d * 72 + cc * 8);
        *(u32x4*)(KDT + (size_t)d * T + t0 + cc * 8) = v; }
    v_transpose_tile(Z + 2 * RW + h * RHD, ZW, VS, 512, t0, jl0, lds, tid);
}

DI void ret_prefix(const PA& a, int e4) {
    const int h = e4 >> 14, rem = e4 & 16383, dv = rem >> 6, dk4 = (rem & 63) * 4;
    const float* KVT = (const float*)(a.ws + WS_KVT) + ((size_t)(h * 32) * 256 + dv) * 256 + dk4;
    bf16* VS = (bf16*)(a.ws + WS_VS) + ((size_t)(h * 32) * 256 + dv) * 512 + 256 + dk4;
    const float g = 1.f - exp2f(-5.f - (float)h), g256 = exp2f(256.f * log2f(g));
    f32x4 st = {0.f, 0.f, 0.f, 0.f};
#pragma unroll 1
    for (int c0 = 0; c0 < 32; c0 += 8) { f32x4 kv[8];
#pragma unroll
        for (int c = 0; c < 8; ++c) kv[c] = *(const f32x4*)(KVT + (size_t)(c0 + c) * 65536);
#pragma unroll
        for (int c = 0; c < 8; ++c) { u32x2 w; w.x = pk2(st[0], st[1]); w.y = pk2(st[2], st[3]); *(u32x2*)(VS + (size_t)(c0 + c) * 131072) = w; st = st * g256 + kv[c]; } }
}

DI void attn_prep_item(const PA& a, LAS unsigned char* lds, int item, int tid) {
    const int h = item & 15, t0 = (item >> 4) * 64, lane = tid & 63, wave = tid >> 6;
    bf16* QKV = (bf16*)(a.ws + WS_QKV); bf16* VT1 = (bf16*)(a.ws + WS_VT1);
    const int l16 = lane & 15, sub = lane >> 4;
    const f32x4 qg0 = *(const f32x4*)(inp(a, I_QNG) + l16 * 8), qg1 = *(const f32x4*)(inp(a, I_QNG) + l16 * 8 + 4), kg0 = *(const f32x4*)(inp(a, I_KNG) + l16 * 8), kg1 = *(const f32x4*)(inp(a, I_KNG) + l16 * 8 + 4);
    for (int it = 0; it < 8; ++it) { const int rr = it * 32 + wave * 4 + sub;
        const int tt = rr >> 2, which = (rr >> 1) & 1, mm = rr & 1;
        bf16* p = QKV + (size_t)(t0 + tt) * QKVW + which * D + (h * 2 + mm) * AHD + l16 * 8;
        const u32x4 x = *(const u32x4*)p; float v[8];
        v[0] = bflo(x.x); v[1] = bfhi(x.x); v[2] = bflo(x.y); v[3] = bfhi(x.y); v[4] = bflo(x.z); v[5] = bfhi(x.z); v[6] = bflo(x.w); v[7] = bfhi(x.w);
        float s = 0.f;
#pragma unroll
        for (int e = 0; e < 8; ++e) s += v[e] * v[e];
        s += __shfl_xor(s, 1); s += __shfl_xor(s, 2); s += __shfl_xor(s, 4); s += __shfl_xor(s, 8);
        const float rs = (1.f / sqrtf(s * (1.f / AHD) + EPS)) * (which ? 1.f : 0.08838834764831845f * LOG2E);
        const f32x4 g0 = which ? kg0 : qg0, g1 = which ? kg1 : qg1;
        u32x4 w; w.x = pk2(v[0] * rs * g0[0], v[1] * rs * g0[1]); w.y = pk2(v[2] * rs * g0[2], v[3] * rs * g0[3]); w.z = pk2(v[4] * rs * g1[0], v[5] * rs * g1[1]); w.w = pk2(v[6] * rs * g1[2], v[7] * rs * g1[3]);
        *(u32x4*)p = w; }
    v_transpose_tile(QKV + 2 * D + h * AVD, QKVW, VT1 + (size_t)h * AVD * T, T, t0, t0, lds, tid);
}

template <int DQK, int MODE, int NDT, bool PF>
DI void flash_pass(LAS unsigned char* lds, const bf16* Qu, const int ldq, const bf16* Ku, const int ldk, const bf16* VTh, const int dvoff, const int qw0, const int qwl, const int nkt,
                   const float lg2, const LAS float* btab, f32x16 (&O)[NDT], float& l_out) {
    constexpr int KPB = (DQK + 8) * 2, VT_OFF = 64 * KPB, VPB = 136, CPR = DQK / 8, NKI = (64 * CPR) / 512;
    int tid = threadIdx.x; asm volatile("" : "+v"(tid));
    const int lane = tid & 63, r = lane & 31, h = lane >> 5;
    bf16x8 qf[DQK / 16];
    { const unsigned qoff = (unsigned)(r * ldq + 8 * h) * 2u;
#pragma unroll
      for (int s = 0; s < DQK / 16; ++s) qf[s] = *(const bf16x8*)((const char*)Qu + qoff + 32 * s); }
#pragma unroll
    for (int dt = 0; dt < NDT; ++dt)
#pragma unroll
        for (int i = 0; i < 16; ++i) O[dt][i] = 0.f;
    float m_run = -1e30f, l_run = 0.f;
    const int qi = qwl + r;
    const unsigned kgo = (unsigned)((tid / CPR) * ldk + (tid % CPR) * 8) * 2u, klo = (unsigned)((tid / CPR) * KPB + (tid % CPR) * 16);
    const unsigned vgo = (unsigned)((tid >> 3) * T + (tid & 7) * 8) * 2u, vlo = (unsigned)(VT_OFF + (tid >> 3) * VPB + (tid & 7) * 16);
    const unsigned ka = (unsigned)(r * KPB + 16 * h), va_ = (unsigned)(VT_OFF + (dvoff + r) * VPB + 8 * h);
    const __amdgpu_buffer_rsrc_t krs = __builtin_amdgcn_make_buffer_rsrc((void*)Ku, 0, 0x7ffffff0, 0x00020000);
    const __amdgpu_buffer_rsrc_t vrs = __builtin_amdgcn_make_buffer_rsrc((void*)VTh, 0, 0x7ffffff0, 0x00020000);
    u32x4 kreg[NKI], vreg[4];
    if (PF) {
#pragma unroll
        for (int i = 0; i < NKI; ++i) kreg[i] = __builtin_amdgcn_raw_buffer_load_b128(krs, kgo, (i * (512 / CPR)) * ldk * 2, 0);
#pragma unroll
        for (int i = 0; i < 4; ++i) vreg[i] = __builtin_amdgcn_raw_buffer_load_b128(vrs, vgo, i * 64 * T * 2, 0);
    }
    for (int kt = 0; kt < nkt; ++kt) {
        const int k0 = kt * 64;
        __syncthreads();
        if (!PF) {
#pragma unroll
            for (int i = 0; i < NKI; ++i) { const u32x4 v = __builtin_amdgcn_raw_buffer_load_b128(krs, kgo, (k0 + i * (512 / CPR)) * ldk * 2, 0); *(LAS u32x4*)(lds + klo + i * (512 / CPR) * KPB) = v; }
#pragma unroll
            for (int i = 0; i < 4; ++i) { const u32x4 v = __builtin_amdgcn_raw_buffer_load_b128(vrs, vgo, k0 * 2 + i * 64 * T * 2, 0); LAS u32x2* d = (LAS u32x2*)(lds + vlo + i * 64 * VPB);
                u32x2 lo; lo.x = v.x; lo.y = v.y; u32x2 hi; hi.x = v.z; hi.y = v.w; d[0] = lo; d[1] = hi; }
        } else {
#pragma unroll
            for (int i = 0; i < NKI; ++i) *(LAS u32x4*)(lds + klo + i * (512 / CPR) * KPB) = kreg[i];
#pragma unroll
            for (int i = 0; i < 4; ++i) { LAS u32x2* d = (LAS u32x2*)(lds + vlo + i * 64 * VPB);
                u32x2 lo; lo.x = vreg[i].x; lo.y = vreg[i].y; u32x2 hi; hi.x = vreg[i].z; hi.y = vreg[i].w; d[0] = lo; d[1] = hi; }
        }
        __syncthreads();
        if (PF && kt + 1 < nkt) {
#pragma unroll
            for (int i = 0; i < NKI; ++i) kreg[i] = __builtin_amdgcn_raw_buffer_load_b128(krs, kgo, (k0 + 64 + i * (512 / CPR)) * ldk * 2, 0);
#pragma unroll
            for (int i = 0; i < 4; ++i) vreg[i] = __builtin_amdgcn_raw_buffer_load_b128(vrs, vgo, (k0 + 64) * 2 + i * 64 * T * 2, 0);
        }
        if (k0 <= qw0 + 31) {
            f32x16 st0, st1;
#pragma unroll
            for (int i = 0; i < 16; ++i) { st0[i] = 0.f; st1[i] = 0.f; }
#pragma unroll
            for (int s = 0; s < DQK / 16; ++s) {
                const bf16x8 a0 = *(const LAS bf16x8*)(lds + ka + 32 * s);
                const bf16x8 a1 = *(const LAS bf16x8*)(lds + ka + 32 * KPB + 32 * s);
                st0 = __builtin_amdgcn_mfma_f32_32x32x16_bf16(a0, qf[s], st0, 0, 0, 0);
                st1 = __builtin_amdgcn_mfma_f32_32x32x16_bf16(a1, qf[s], st1, 0, 0, 0);
                if ((s & 3) == 3) __builtin_amdgcn_sched_barrier(0);
            }
            const int dbase = qi - k0 - 4 * h;
            if (MODE == 0) {
#pragma unroll
                for (int i = 0; i < 16; ++i) { const int d0 = dbase - ((i & 3) + 8 * (i >> 2)), d1 = d0 - 32;
                    const float e0 = __builtin_amdgcn_exp2f(lg2 * (float)d0), e1 = __builtin_amdgcn_exp2f(lg2 * (float)d1);
                    st0[i] = d0 >= 0 ? st0[i] * e0 : 0.f; st1[i] = d1 >= 0 ? st1[i] * e1 : 0.f; }
            } else {
                if (k0 + 63 + 127 <= qw0) { const float c = btab[96 + 127];
#pragma unroll
                    for (int i = 0; i < 16; ++i) { st0[i] += c; st1[i] += c; } }
                else {
#pragma unroll
                    for (int i = 0; i < 16; ++i) { const int d0 = dbase - ((i & 3) + 8 * (i >> 2)) + 96, d1 = d0 - 32;
                        const float b0 = btab[d0 > 223 ? 223 : d0], b1 = btab[d1 > 223 ? 223 : d1];
                        st0[i] += b0; st1[i] += b1; } }
                float mx = fmaxf(st0[0], st1[0]);
#pragma unroll
                for (int i = 1; i < 16; ++i) mx = fmaxf(mx, fmaxf(st0[i], st1[i]));
                mx = fmaxf(mx, __shfl_xor(mx, 32));
                const float m_new = fmaxf(m_run, mx), alpha = __builtin_amdgcn_exp2f(m_run - m_new); m_run = m_new;
                float ps = 0.f;
#pragma unroll
                for (int i = 0; i < 16; ++i) { st0[i] = __builtin_amdgcn_exp2f(st0[i] - m_new); st1[i] = __builtin_amdgcn_exp2f(st1[i] - m_new); ps += st0[i] + st1[i]; }
                ps += __shfl_xor(ps, 32);
                l_run = l_run * alpha + ps;
#pragma unroll
                for (int dt = 0; dt < NDT; ++dt)
#pragma unroll
                    for (int i = 0; i < 16; ++i) O[dt][i] *= alpha;
            }
            __builtin_amdgcn_sched_barrier(0);
#pragma unroll
            for (int mt = 0; mt < 2; ++mt)
#pragma unroll
                for (int s2 = 0; s2 < 2; ++s2) {
                    u32x4 pw;
                    if (mt == 0) { pw.x = pk2(st0[8 * s2 + 0], st0[8 * s2 + 1]); pw.y = pk2(st0[8 * s2 + 2], st0[8 * s2 + 3]); pw.z = pk2(st0[8 * s2 + 4], st0[8 * s2 + 5]); pw.w = pk2(st0[8 * s2 + 6], st0[8 * s2 + 7]); }
                    else         { pw.x = pk2(st1[8 * s2 + 0], st1[8 * s2 + 1]); pw.y = pk2(st1[8 * s2 + 2], st1[8 * s2 + 3]); pw.z = pk2(st1[8 * s2 + 4], st1[8 * s2 + 5]); pw.w = pk2(st1[8 * s2 + 6], st1[8 * s2 + 7]); }
                    const bf16x8 pb = __builtin_bit_cast(bf16x8, pw);
#pragma unroll
                    for (int dt = 0; dt < NDT; ++dt) {
                        const LAS unsigned char* vp = lds + va_ + (32 * dt) * VPB + (32 * mt + 16 * s2) * 2;
                        const s16x4 lo = *(const LAS s16x4*)vp, hi = *(const LAS s16x4*)(vp + 16);
                        const bf16x8 va = __builtin_shufflevector(lo, hi, 0, 1, 2, 3, 4, 5, 6, 7);
                        O[dt] = __builtin_amdgcn_mfma_f32_32x32x16_bf16(va, pb, O[dt], 0, 0, 0);
                        if ((dt & 3) == 3) __builtin_amdgcn_sched_barrier(0);
                    }
                }
        }
    }
    l_out = l_run;
}
constexpr int FL_SCR_OFF = 64 * (256 + 8) * 2 + 256 * 136;

namespace dfa {
constexpr int KB0 = 0, VB0 = 16384, KB1 = 49152, VB1 = 65536, BT_OFF = 98304, XM_OFF = 99328, XP_OFF = 101376;
DI void dma16(const __amdgpu_buffer_rsrc_t rs, const unsigned voff, const unsigned soff, LAS unsigned char* ldst) { __builtin_amdgcn_raw_ptr_buffer_load_lds(rs, (LAS void*)ldst, 16, (int)voff, (int)soff, 0, 0); }
DI void stage_k(LAS unsigned char* lds, const int KB, const __amdgpu_buffer_rsrc_t rs, const unsigned soff, const unsigned (&ko)[2], int wave) {
#pragma unroll
    for (int i = 0; i < 2; ++i) dma16(rs, ko[i], soff, lds + KB + (2 * wave + i) * 1024);
}
DI void stage_v(LAS unsigned char* lds, const int VB, const __amdgpu_buffer_rsrc_t rs, const unsigned soff, const unsigned (&vo)[4], int wave) {
#pragma unroll
    for (int i = 0; i < 4; ++i) dma16(rs, vo[i], soff, lds + VB + (4 * wave + i) * 1024);
}
#define DFA_BAR() do { asm volatile("s_waitcnt lgkmcnt(0)" ::: "memory"); __builtin_amdgcn_s_barrier(); asm volatile("" ::: "memory"); } while (0)
template <bool WANT_MAX>
DI float s_tile(LAS unsigned char* lds, const unsigned kb, const bf16x8 (&qf)[8], f32x16& st, const unsigned A0, const int duni, const bool far_, const int lane) {
    const LAS float* btab = (const LAS float*)(lds + BT_OFF);
#pragma unroll
    for (int i = 0; i < 16; ++i) st[i] = 0.f;
    bf16x8 ka[8];
    unsigned a0 = A0; asm volatile("" : "+v"(a0));
#pragma unroll
    for (int s = 0; s < 8; ++s) ka[s] = *(const LAS bf16x8*)(lds + kb + (a0 ^ (32u * s)));
    __builtin_amdgcn_sched_barrier(0);
#pragma unroll
    for (int s = 0; s < 8; ++s) st = __builtin_amdgcn_mfma_f32_32x32x16_bf16(ka[s], qf[s], st, 0, 0, 0);
    __builtin_amdgcn_sched_barrier(0);
    if (!far_) { int ln = lane; asm volatile("" : "+v"(ln));
        const int db = (ln & 31) - 8 * (ln >> 5) + duni;
#pragma unroll
        for (int i = 0; i < 16; ++i) { const int d0 = db - ((i & 3) + 4 * ((i >> 2) & 1) + 16 * (i >> 3)); st[i] += btab[d0 > 223 ? 223 : d0]; } }
    if (!WANT_MAX) return 0.f;
    float mx = st[0];
#pragma unroll
    for (int i = 1; i < 16; ++i) mx = fmaxf(mx, st[i]);
    { float lo, hi; swap32(mx, lo, hi); mx = fmaxf(lo, hi); }
    return mx;
}
DI float p_tile(LAS unsigned char* lds, const unsigned xpn, f32x16& st, const float m, u32x4& pn0, u32x4& pn1, const int wave, const int lane) {
    float ps = 0.f;
#pragma unroll
    for (int i = 0; i < 16; ++i) { st[i] = __builtin_amdgcn_exp2f(st[i] - m); ps += st[i]; }
    { float lo, hi; swap32(ps, lo, hi); ps = lo + hi; }
    pn0.x = pk2(st[0], st[1]); pn0.y = pk2(st[2], st[3]); pn0.z = pk2(st[4], st[5]); pn0.w = pk2(st[6], st[7]);
    pn1.x = pk2(st[8], st[9]); pn1.y = pk2(st[10], st[11]); pn1.z = pk2(st[12], st[13]); pn1.w = pk2(st[14], st[15]);
    *(LAS u32x4*)(lds + xpn + ((wave * 2 + 0) * 64 + lane) * 16) = pn0;
    *(LAS u32x4*)(lds + xpn + ((wave * 2 + 1) * 64 + lane) * 16) = pn1;
    return ps;
}
DI void first(LAS unsigned char* lds, const bf16x8 (&qf)[8], float& m_run, float& l_run, float& mx, u32x4& pw0, u32x4& pw1, const unsigned A0, const int duni, const bool far_, const int wave, const int lane) {
    const int r = lane & 31, role = wave & 1;
    f32x16 st;
    mx = s_tile<true>(lds, (unsigned)(KB0 + 8192 * role), qf, st, A0, duni, far_, lane);
    *(LAS float*)(lds + XM_OFF + (wave * 32 + r) * 4) = mx;
    DFA_BAR();
    m_run = fmaxf(mx, *(const LAS float*)(lds + XM_OFF + ((wave ^ 1) * 32 + r) * 4));
    l_run = p_tile(lds, (unsigned)XP_OFF, st, m_run, pw0, pw1, wave, lane);
}
DI void iter(LAS unsigned char* lds, const int KBn, const int VB, const int par, const bf16x8 (&qf)[8], f32x16 (&O)[4], float& m_run, float& l_run, float& mx, u32x4& pw0, u32x4& pw1,
             const unsigned A0, const unsigned B0, const int duni_n, const bool far_n, const bool act, const bool act_n, const int wave, const int lane) {
    const int r = lane & 31, role = wave & 1;
    if (!act) return;
    const unsigned xpo = (unsigned)(XP_OFF + par * 16384), xpn = (unsigned)(XP_OFF + 16384 - par * 16384), xmo = (unsigned)(XM_OFF + par * 1024), xmn = (unsigned)(XM_OFF + 1024 - par * 1024);
    const float m_new = fmaxf(m_run, fmaxf(mx, *(const LAS float*)(lds + xmo + ((wave ^ 1) * 32 + r) * 4)));
    const unsigned vbase = (unsigned)(VB + 16384 * role);
    const unsigned mtA = 64u * role, mtB = 64u - mtA;
    float ps = 0.f;
    {
        f32x16 st; bf16x8 ka[8];
        if (act_n) { unsigned a0 = A0; asm volatile("" : "+v"(a0)); const unsigned kb = (unsigned)(KBn + 8192 * role);
#pragma unroll
            for (int s = 0; s < 8; ++s) ka[s] = *(const LAS bf16x8*)(lds + kb + (a0 ^ (32u * s))); }
        bf16x8 va[8], vb[8];
#pragma unroll
        for (int j = 0; j < 4; ++j) va[j] = *(const LAS bf16x8*)(lds + 4096 * (j & 3) + vbase + (B0 ^ (mtA + 32u * (j >> 2))));
        __builtin_amdgcn_sched_barrier(0);
        if (act_n) {
#pragma unroll
            for (int i = 0; i < 16; ++i) st[i] = 0.f;
#pragma unroll
            for (int s = 0; s < 8; ++s) st = __builtin_amdgcn_mfma_f32_32x32x16_bf16(ka[s], qf[s], st, 0, 0, 0);
            __builtin_amdgcn_sched_barrier(0);
            if (!far_n) { int ln = lane; asm volatile("" : "+v"(ln)); const int db = (ln & 31) - 8 * (ln >> 5) + duni_n; const LAS float* btab = (const LAS float*)(lds + BT_OFF);
#pragma unroll
                for (int i = 0; i < 16; ++i) { const int d0 = db - ((i & 3) + 4 * ((i >> 2) & 1) + 16 * (i >> 3)); st[i] += btab[d0 > 223 ? 223 : d0]; } }
        } else asm volatile("" : "=v"(st));
#pragma unroll
        for (int j = 4; j < 8; ++j) va[j] = *(const LAS bf16x8*)(lds + 4096 * (j & 3) + vbase + (B0 ^ (mtA + 32u * (j >> 2))));
        const u32x4 qw0_ = *(const LAS u32x4*)(lds + xpo + (((wave ^ 1) * 2 + 0) * 64 + lane) * 16);
        const u32x4 qw1_ = *(const LAS u32x4*)(lds + xpo + (((wave ^ 1) * 2 + 1) * 64 + lane) * 16);
        __builtin_amdgcn_sched_barrier(0);
        u32x4 pn0, pn1; float pe[16]; float mxn = -3.0e38f;
#pragma unroll
        for (int j = 0; j < 8; ++j) {
            O[j & 3] = __builtin_amdgcn_mfma_f32_32x32x16_bf16(va[j], __builtin_bit_cast(bf16x8, (j >> 2) ? pw1 : pw0), O[j & 3], 0, 0, 0);
            vb[j] = *(const LAS bf16x8*)(lds + 4096 * (j & 3) + vbase + (B0 ^ (mtB + 32u * (j >> 2))));
            pe[j] = __builtin_amdgcn_exp2f(st[j] - m_new); ps += pe[j];
            if (j & 1) pn0[j >> 1] = pk2(pe[j - 1], pe[j]);
            __builtin_amdgcn_sched_barrier(0);
        }
#pragma unroll
        for (int j = 0; j < 8; ++j) {
            O[j & 3] = __builtin_amdgcn_mfma_f32_32x32x16_bf16(vb[j], __builtin_bit_cast(bf16x8, (j >> 2) ? qw1_ : qw0_), O[j & 3], 0, 0, 0);
            asm("v_max3_f32 %0, %1, %2, %3" : "=v"(mxn) : "v"(mxn), "v"(st[2 * j]), "v"(st[2 * j + 1]));
            pe[8 + j] = __builtin_amdgcn_exp2f(st[8 + j] - m_new); ps += pe[8 + j];
            if (j & 1) pn1[j >> 1] = pk2(pe[8 + j - 1], pe[8 + j]);
            if (j == 0) *(LAS u32x4*)(lds + xpn + ((wave * 2 + 0) * 64 + lane) * 16) = pn0;
            __builtin_amdgcn_sched_barrier(0);
        }
        *(LAS u32x4*)(lds + xpn + ((wave * 2 + 1) * 64 + lane) * 16) = pn1;
        { float lo, hi; swap32(mxn, lo, hi); mxn = fmaxf(lo, hi); }
        mxn = act_n ? mxn : -1e30f;
        *(LAS float*)(lds + xmn + (wave * 32 + r) * 4) = mxn;
        mx = mxn;
        { float lo, hi; swap32(ps, lo, hi); ps = lo + hi; }
        pw0 = pn0; pw1 = pn1;
        ps = act_n ? ps : 0.f;
    }
    if (__builtin_amdgcn_ballot_w64(m_new > m_run) != 0ull) {
        const float alpha = __builtin_amdgcn_exp2f(m_run - m_new); l_run *= alpha;
#pragma unroll
        for (int dt = 0; dt < 4; ++dt)
#pragma unroll
            for (int i = 0; i < 16; ++i) O[dt][i] *= alpha;
        m_run = m_new;
    }
    l_run += ps;
}
}

DI void diff_unit(const PA& a, LAS unsigned char* lds, int h, int qb, const float lam, const int wave) {
    int lane; asm volatile("v_mbcnt_lo_u32_b32 %0, -1, 0\n\tv_mbcnt_hi_u32_b32 %0, -1, %0" : "=v"(lane));
    const int tid = wave * 64 + lane;
    const int r = lane & 31, h2 = lane >> 5, pair = wave >> 1, role = wave & 1, q0 = qb * 128, qw0 = q0 + 32 * pair, nkt = (q0 + 128) / 64;
    const bf16* QKV = (const bf16*)(a.ws + WS_QKV); const bf16* VT1 = (const bf16*)(a.ws + WS_VT1);
    LAS float* btab = (LAS float*)(lds + dfa::BT_OFF);
    LAS float* xm = (LAS float*)(lds + dfa::XM_OFF);
    __syncthreads();
    if (tid < 224) { float v = -1e30f;
        if (tid >= 96) { const int n = tid - 96; int bk = n;
            if (n >= 16) { bk = 16 + (n >= 19) + (n >= 21) + (n >= 24) + (n >= 27) + (n >= 31) + (n >= 35) + (n >= 40) + (n >= 46) + (n >= 52) + (n >= 59) + (n >= 67) + (n >= 77) + (n >= 87) + (n >= 99) + (n >= 113); }
            v = (inp(a, I_RELB)[bk * AH + h] - inp(a, I_RELB)[31 * AH + h]) * LOG2E; }
        btab[tid] = v; }
    const int pr = (r & 0x13) | ((r & 4) << 1) | ((r & 8) >> 1);
    const unsigned A0 = (unsigned)(pr * 256) | (unsigned)((h2 ^ (pr & 15)) << 4);
    const unsigned B0 = (unsigned)(r * 128) | (unsigned)((h2 ^ ((r >> 1) & 7)) << 4);
    unsigned ko[2], vo[4];
#pragma unroll
    for (int i = 0; i < 2; ++i) { const int row = 4 * (2 * wave + i) + (lane >> 4), u = (lane & 15) ^ (row & 15); ko[i] = (unsigned)(row * QKVW + u * 8) * 2u; }
#pragma unroll
    for (int i = 0; i < 4; ++i) { const int row = 8 * (4 * wave + i) + (lane >> 3), u = (lane & 7) ^ ((row >> 1) & 7); vo[i] = (unsigned)(row * T + u * 8) * 2u; }
    const int chb = h * AVD + role * 128;
    const int oo = (r * D + 4 * h2) * 4, ao = (r * D + 4 * h2) * 2, so = (4 * h2) * 4;
    const __amdgpu_buffer_rsrc_t vrs = __builtin_amdgcn_make_buffer_rsrc((void*)(VT1 + (size_t)h * AVD * T), 0, 0x7fffffff, 0x00020000);
    const int qi = qw0 + r;
    for (int mp = 0; mp < 2; ++mp) {
        const __amdgpu_buffer_rsrc_t krs = __builtin_amdgcn_make_buffer_rsrc((void*)(QKV + D + (h * 2 + mp) * AHD), 0, 0x7fffffff, 0x00020000);
        bf16x8 qf[8];
        { const char* qg = (const char*)(QKV + (size_t)qw0 * QKVW + (h * 2 + mp) * AHD); const unsigned qoff = (unsigned)(r * QKVW + 8 * h2) * 2u;
#pragma unroll
          for (int s = 0; s < 8; ++s) qf[s] = *(const bf16x8*)(qg + qoff + 32 * s); }
        f32x16 O[4];
#pragma unroll
        for (int dt = 0; dt < 4; ++dt)
#pragma unroll
            for (int i = 0; i < 16; ++i) O[dt][i] = 0.f;
        float m_run = -1e30f, l_run = 0.f;
        asm volatile("s_waitcnt vmcnt(0)" ::: "memory");
        dfa::stage_k(lds, dfa::KB0, krs, 0u, ko, wave); dfa::stage_v(lds, dfa::VB0, vrs, 0u, vo, wave); dfa::stage_k(lds, dfa::KB1, krs, 64u * QKVW * 2u, ko, wave);
        asm volatile("s_waitcnt vmcnt(6)" ::: "memory");
        __builtin_amdgcn_s_barrier(); asm volatile("" ::: "memory");
        float mx; u32x4 pw0, pw1;
        dfa::first(lds, qf, m_run, l_run, mx, pw0, pw1, A0, qw0 - 32 * role + 96, 63 + 127 <= qw0, wave, lane);
#pragma unroll 1
        for (int kt = 0; kt < nkt; ++kt) {
            const int k0 = kt * 64, odd = kt & 1;
            asm volatile("s_waitcnt vmcnt(0)" ::: "memory");
            DFA_BAR();
            if (kt + 2 < nkt) dfa::stage_k(lds, odd ? dfa::KB1 : dfa::KB0, krs, (unsigned)(k0 + 128) * (QKVW * 2u), ko, wave);
            if (kt + 1 < nkt) dfa::stage_v(lds, odd ? dfa::VB0 : dfa::VB1, vrs, (unsigned)(k0 + 64) * 2u, vo, wave);
            dfa::iter(lds, odd ? dfa::KB0 : dfa::KB1, odd ? dfa::VB1 : dfa::VB0, odd, qf, O, m_run, l_run, mx, pw0, pw1, A0, B0, qw0 - (k0 + 64) - 32 * role + 96, k0 + 64 + 63 + 127 <= qw0,
                      k0 <= qw0 + 31, (kt + 1 < nkt) && (k0 + 64 <= qw0 + 31), wave, lane);
        }
        const __amdgpu_buffer_rsrc_t o1_rs = __builtin_amdgcn_make_buffer_rsrc((void*)((float*)(a.ws + WS_O1) + (size_t)qw0 * D + chb), 0, 32 * D * 4, 0x00020000);
        const __amdgpu_buffer_rsrc_t ao_rs = FP8_OWO ? __builtin_amdgcn_make_buffer_rsrc((void*)(a.ws + WS_AO + (size_t)qw0 * D + chb), 0, 32 * D, 0x00020000)
                                                       : __builtin_amdgcn_make_buffer_rsrc((void*)((bf16*)(a.ws + WS_AO) + (size_t)qw0 * D + chb), 0, 32 * D * 2, 0x00020000);
        const __amdgpu_buffer_rsrc_t sg_rs = __builtin_amdgcn_make_buffer_rsrc((void*)(inp(a, I_SUBG) + role * 128), 0, 128 * 4, 0x00020000);
        xm[wave * 32 + r] = l_run;
        DFA_BAR();
        const float inv = 1.f / (l_run + xm[(wave ^ 1) * 32 + r]);
        if (mp == 0) {
#pragma unroll
            for (int dt = 0; dt < 4; ++dt)
#pragma unroll
                for (int g4 = 0; g4 < 4; ++g4) { const int dvl = 32 * dt + 8 * g4;
                    f32x4 v; v[0] = O[dt][4 * g4] * inv; v[1] = O[dt][4 * g4 + 1] * inv; v[2] = O[dt][4 * g4 + 2] * inv; v[3] = O[dt][4 * g4 + 3] * inv;
                    __builtin_amdgcn_raw_buffer_store_b128(__builtin_bit_cast(u32x4, v), o1_rs, oo + dvl * 4, 0, 0); if (g4 == 3) __builtin_amdgcn_sched_barrier(0); }
            DFA_BAR();
        } else {
            float lam_s = lam; asm volatile("" : "+s"(lam_s));
            const float c2 = lam_s * inv; float ss = 0.f;
#pragma unroll
            for (int dt = 0; dt < 4; ++dt)
#pragma unroll
                for (int g4 = 0; g4 < 4; ++g4) { const int dvl = 32 * dt + 8 * g4; const f32x4 o1 = __builtin_bit_cast(f32x4, __builtin_amdgcn_raw_buffer_load_b128(o1_rs, oo + dvl * 4, 0, 0));
#pragma unroll
                    for (int e = 0; e < 4; ++e) { const float d = o1[e] - c2 * O[dt][4 * g4 + e]; ss += d * d; } __builtin_amdgcn_sched_barrier(0); }
            { float lo, hi; swap32(ss, lo, hi); ss = lo + hi; }
            DFA_BAR();
            xm[wave * 32 + r] = ss;
            DFA_BAR();
            ss += xm[(wave ^ 1) * 32 + r];
            const float rs = (1.f / sqrtf(ss * (1.f / AVD) + EPS)) * (1.f - LAMBDA_INIT);
#pragma unroll
            for (int dt = 0; dt < 4; ++dt)
#pragma unroll
                for (int g4 = 0; g4 < 4; ++g4) { const int dvl = 32 * dt + 8 * g4; const f32x4 sg = __builtin_bit_cast(f32x4, __builtin_amdgcn_raw_buffer_load_b128(sg_rs, so + dvl * 4, 0, 0));
                    const f32x4 o1 = __builtin_bit_cast(f32x4, __builtin_amdgcn_raw_buffer_load_b128(o1_rs, oo + dvl * 4, 0, 0));
                    const float y0 = (o1[0] - c2 * O[dt][4 * g4]) * rs * sg[0], y1 = (o1[1] - c2 * O[dt][4 * g4 + 1]) * rs * sg[1], y2 = (o1[2] - c2 * O[dt][4 * g4 + 2]) * rs * sg[2], y3 = (o1[3] - c2 * O[dt][4 * g4 + 3]) * rs * sg[3];
                    if (FP8_OWO) __builtin_amdgcn_raw_buffer_store_b32(pk4_fp8(y0, y1, y2, y3), ao_rs, (ao >> 1) + dvl, 0, 0);
                    else { u32x2 w; w.x = pk2(y0, y1); w.y = pk2(y2, y3); __builtin_amdgcn_raw_buffer_store_b64(w, ao_rs, ao + dvl * 2, 0, 0); }
                    __builtin_amdgcn_sched_barrier(0); }
        }
    }
    __syncthreads();
}

DI void peer_topk_process(float a0, float a1, float b0, float b1, int* EIDX, float* GATE, LAS float* scr, int item, int lane) {
    const int tok = item >> 3, hd = item & 7;
    LAS float* sc = scr; LAS float* sv = scr + 64; volatile LAS int* si = (volatile LAS int*)(scr + 96); LAS float* cv = scr + 128; LAS float* fv = scr + 192; volatile LAS int* fi = (volatile LAS int*)(scr + 208);
    typedef unsigned long long u64;
    LAS u64* ck = (LAS u64*)sc;
    const unsigned ua0 = __builtin_bit_cast(unsigned, a0), ua1 = __builtin_bit_cast(unsigned, a1), ub0 = __builtin_bit_cast(unsigned, b0), ub1 = __builtin_bit_cast(unsigned, b1);
    const unsigned ka0 = (ua0 & 0x80000000u) ? ~ua0 : (ua0 | 0x80000000u), ka1 = (ua1 & 0x80000000u) ? ~ua1 : (ua1 | 0x80000000u);
    const unsigned kb0 = (ub0 & 0x80000000u) ? ~ub0 : (ub0 | 0x80000000u), kb1 = (ub1 & 0x80000000u) ? ~ub1 : (ub1 | 0x80000000u);
    unsigned pa = 0u, pb = 0u; bool da = false, db = false;
#pragma unroll 1
    for (int bit = 31; bit >= 0; --bit) {
        const unsigned m = 1u << bit;
        if (!da) { const unsigned t = pa | m; const int c = __builtin_popcountll(__builtin_amdgcn_ballot_w64(ka0 >= t)) + __builtin_popcountll(__builtin_amdgcn_ballot_w64(ka1 >= t)); pa = c >= 16 ? t : pa; da = c == 16; }
        if (!db) { const unsigned t = pb | m; const int c = __builtin_popcountll(__builtin_amdgcn_ballot_w64(kb0 >= t)) + __builtin_popcountll(__builtin_amdgcn_ballot_w64(kb1 >= t)); pb = c >= 16 ? t : pb; db = c == 16; }
        if (da && db) break;
    }
#pragma unroll
    for (int hf = 0; hf < 2; ++hf) {
        const unsigned k0 = hf ? kb0 : ka0, k1 = hf ? kb1 : ka1, p = hf ? pb : pa;
        const bool g0 = k0 > p, g1 = k1 > p, e0 = k0 == p, e1 = k1 == p;
        const u64 E0 = __builtin_amdgcn_ballot_w64(e0), E1 = __builtin_amdgcn_ballot_w64(e1);
        const int need = 16 - __builtin_popcountll(__builtin_amdgcn_ballot_w64(g0)) - __builtin_popcountll(__builtin_amdgcn_ballot_w64(g1));
        const int ne0 = (int)__builtin_amdgcn_mbcnt_hi((unsigned)(E0 >> 32), __builtin_amdgcn_mbcnt_lo((unsigned)E0, 0u));
        const int ne1 = __builtin_popcountll(E0) + (int)__builtin_amdgcn_mbcnt_hi((unsigned)(E1 >> 32), __builtin_amdgcn_mbcnt_lo((unsigned)E1, 0u));
        const bool s0 = g0 || (e0 && ne0 < need), s1 = g1 || (e1 && ne1 < need);
        const u64 S0 = __builtin_amdgcn_ballot_w64(s0), S1 = __builtin_amdgcn_ballot_w64(s1);
        const int p0 = (int)__builtin_amdgcn_mbcnt_hi((unsigned)(S0 >> 32), __builtin_amdgcn_mbcnt_lo((unsigned)S0, 0u));
        const int p1 = __builtin_popcountll(S0) + (int)__builtin_amdgcn_mbcnt_hi((unsigned)(S1 >> 32), __builtin_amdgcn_mbcnt_lo((unsigned)S1, 0u));
        if (s0) ck[hf * 16 + (p0 & 15)] = ((u64)k0 << 32) | (unsigned)(127 - lane);
        if (s1) ck[hf * 16 + (p1 & 15)] = ((u64)k1 << 32) | (unsigned)(63 - lane);
    }
    if (lane < 32) { const int hf = lane >> 4; const u64 mine = ck[lane]; int rk = 0;
#pragma unroll
        for (int j = 0; j < 16; ++j) rk += ck[hf * 16 + j] > mine ? 1 : 0;
        const unsigned k = (unsigned)(mine >> 32), u = (k & 0x80000000u) ? (k & 0x7fffffffu) : ~k;
        sv[hf * 16 + rk] = __builtin_bit_cast(float, u); si[hf * 16 + rk] = 127 - (int)(unsigned)mine; }
    int ca = 0;
    ca = lane >= 16 ? 1 : ca; ca = lane >= 24 ? 2 : ca; ca = lane >= 29 ? 3 : ca; ca = lane >= 33 ? 4 : ca; ca = lane >= 36 ? 5 : ca; ca = lane >= 38 ? 6 : ca; ca = lane >= 40 ? 7 : ca;
    ca = lane >= 42 ? lane - 34 : ca; ca = ca > 15 ? 15 : ca;
    int base = 0;
    base = ca == 1 ? 16 : base; base = ca == 2 ? 24 : base; base = ca == 3 ? 29 : base; base = ca == 4 ? 33 : base; base = ca == 5 ? 36 : base; base = ca == 6 ? 38 : base; base = ca == 7 ? 40 : base;
    base = ca >= 8 ? 34 + ca : base;
    int cb = lane - base; cb = cb > 15 ? 15 : cb;
    const bool valid = lane < 50;
    const float myv = valid ? sv[ca] + sv[16 + cb] : -3.0e38f;
    cv[lane] = myv;
    int rk = 0;
#pragma unroll
    for (int j = 0; j < 52; j += 4) { const f32x4 v = *(const LAS f32x4*)(cv + j);
#pragma unroll
        for (int e = 0; e < 4; ++e) rk += v[e] > myv ? 1 : 0; }
    if (valid && rk < 16) { fv[rk] = myv; fi[rk] = lane; }
    const bool bad = valid && rk < 16 && fi[rk] != lane;
    if (__builtin_amdgcn_ballot_w64(bad) != 0ull) {
        rk = 0;
#pragma unroll 1
        for (int j = 0; j < 50; ++j) { const float v = cv[j]; rk += (v > myv || (v == myv && j < lane)) ? 1 : 0; }
        if (valid && rk < 16) { fv[rk] = myv; fi[rk] = lane; }
    }
    if (valid && rk < 16) fi[rk] = si[ca] * PNK + si[16 + cb];
    if (lane < 16) { const float mx = fv[0]; const float e = __expf(fv[lane] - mx); float s = e; s += __shfl_xor(s, 1); s += __shfl_xor(s, 2); s += __shfl_xor(s, 4); s += __shfl_xor(s, 8);
        EIDX[(size_t)tok * 128 + hd * 16 + lane] = fi[lane] & (NEXP - 1); GATE[(size_t)tok * 128 + hd * 16 + lane] = e / s; }
}
DI void peer_topk_phase(const float* PS, int* EIDX, float* GATE, LAS float* scr, int gw, int ngw, int lane) {
    constexpr int NIT = T * PH;
    int it = gw; if (it >= NIT) return;
    const float* src = PS + (size_t)it * 256 + lane;
    float n0 = src[0], n1 = src[64], n2 = src[128], n3 = src[192];
    for (; it < NIT; it += ngw) {
        const float a0 = n0, a1 = n1, b0 = n2, b1 = n3;
        if (it + ngw < NIT) { const float* nx = PS + (size_t)(it + ngw) * 256 + lane; n0 = nx[0]; n1 = nx[64]; n2 = nx[128]; n3 = nx[192]; }
        peer_topk_process(a0, a1, b0, b1, EIDX, GATE, scr, it, lane);
    }
}

DI void unpack8(const u32x4 v, float* o) { o[0] = bflo(v.x); o[1] = bfhi(v.x); o[2] = bflo(v.y); o[3] = bfhi(v.y); o[4] = bflo(v.z); o[5] = bfhi(v.z); o[6] = bflo(v.w); o[7] = bfhi(v.w); }
DI void unpack_fp8x16(const u32x4 q, float* o) {
#pragma unroll
    for (int d = 0; d < 4; ++d) { const f32x2 lo = __builtin_amdgcn_cvt_pk_f32_fp8((int)q[d], false), hi = __builtin_amdgcn_cvt_pk_f32_fp8((int)q[d], true);
        o[4 * d] = lo.x; o[4 * d + 1] = lo.y; o[4 * d + 2] = hi.x; o[4 * d + 3] = hi.y; }
}
DI void fp8_row(const float* src, unsigned char* tab, int e, float* scale_out, int lane) {
    f32x4 v[16]; float mx = 0.f;
#pragma unroll
    for (int j = 0; j < 4; ++j)
#pragma unroll
        for (int q = 0; q < 4; ++q) { v[4 * j + q] = *(const f32x4*)(src + j * 1024 + lane * 16 + q * 4);
            mx = fmaxf(mx, fmaxf(fmaxf(fabsf(v[4 * j + q].x), fabsf(v[4 * j + q].y)), fmaxf(fabsf(v[4 * j + q].z), fabsf(v[4 * j + q].w)))); }
#pragma unroll
    for (int o = 1; o < 64; o <<= 1) mx = fmaxf(mx, __shfl_xor(mx, o));
    const float inv = mx > 0.f ? 416.f / mx : 0.f;
    if (lane == 0) *scale_out = mx * (1.f / 416.f);
#pragma unroll
    for (int j = 0; j < 4; ++j) { u32x4 w;
#pragma unroll
        for (int q = 0; q < 4; ++q) { int p = 0; p = __builtin_amdgcn_cvt_pk_fp8_f32(v[4 * j + q].x * inv, v[4 * j + q].y * inv, p, false); p = __builtin_amdgcn_cvt_pk_fp8_f32(v[4 * j + q].z * inv, v[4 * j + q].w * inv, p, true); w[q] = (unsigned)p; }
        *(u32x4*)(tab + ((size_t)(8 * j + (lane >> 3)) * NEXP + e) * 128 + (lane & 7) * 16) = w; }
}
typedef int i32x4 __attribute__((ext_vector_type(4)));
constexpr int PGP = 132;
DI float red8(float v) {
    v += __builtin_bit_cast(float, __builtin_amdgcn_update_dpp(0, __builtin_bit_cast(int, v), 0xB1, 0xF, 0xF, false));
    v += __builtin_bit_cast(float, __builtin_amdgcn_update_dpp(0, __builtin_bit_cast(int, v), 0x4E, 0xF, 0xF, false));
    v += __builtin_bit_cast(float, __builtin_amdgcn_update_dpp(0, __builtin_bit_cast(int, v), 0x141, 0xF, 0xF, false));
    return v;
}
DI void ld_e8(const int* p, int (&e)[8]) {
#pragma unroll
    for (int m = 0; m < 2; ++m) { const i32x4 v = *(const i32x4*)(p + 4 * m); e[4 * m] = v[0]; e[4 * m + 1] = v[1]; e[4 * m + 2] = v[2]; e[4 * m + 3] = v[3]; }
}
DI void ld_q8(const __amdgpu_buffer_rsrc_t tab, const int lo, const int (&e)[8], u32x4 (&q)[8]) {
#pragma unroll
    for (int i = 0; i < 8; ++i) q[i] = __builtin_amdgcn_raw_buffer_load_b128(tab, lo + e[i] * 128, 0, 0);
}
DI void g1_chunk(const u32x4 (&q)[8], const float (&hv)[16], LAS float* prow, int j) {
    float r0 = 0.f;
    f32x2 h2[8];
#pragma unroll
    for (int k = 0; k < 8; ++k) { h2[k].x = hv[2 * k]; h2[k].y = hv[2 * k + 1]; }
    float sd[8];
#pragma unroll
    for (int ii = 0; ii < 8; ++ii) {
        f32x2 s2 = __builtin_amdgcn_cvt_pk_f32_fp8((int)q[ii][0], false) * h2[0];
        s2 = __builtin_elementwise_fma(__builtin_amdgcn_cvt_pk_f32_fp8((int)q[ii][0], true), h2[1], s2);
#pragma unroll
        for (int d = 1; d < 4; ++d) { s2 = __builtin_elementwise_fma(__builtin_amdgcn_cvt_pk_f32_fp8((int)q[ii][d], false), h2[2 * d], s2);
            s2 = __builtin_elementwise_fma(__builtin_amdgcn_cvt_pk_f32_fp8((int)q[ii][d], true), h2[2 * d + 1], s2); }
        sd[ii] = s2.x + s2.y; }
#pragma unroll
    for (int ii = 0; ii < 8; ++ii) sd[ii] += __builtin_bit_cast(float, __builtin_amdgcn_update_dpp(0, __builtin_bit_cast(int, sd[ii]), 0xB1, 0xF, 0xF, false));
#pragma unroll
    for (int ii = 0; ii < 8; ++ii) sd[ii] += __builtin_bit_cast(float, __builtin_amdgcn_update_dpp(0, __builtin_bit_cast(int, sd[ii]), 0x4E, 0xF, 0xF, false));
#pragma unroll
    for (int ii = 0; ii < 8; ++ii) sd[ii] += __builtin_bit_cast(float, __builtin_amdgcn_update_dpp(0, __builtin_bit_cast(int, sd[ii]), 0x141, 0xF, 0xF, false));
#pragma unroll
    for (int ii = 0; ii < 8; ++ii) r0 = (j == ii) ? sd[ii] : r0;
    prow[j] += r0;
}
DI void peer_g1_unit(const bf16* H, const unsigned char* TU, const int* EIDX, float* PART, LAS unsigned char* lds, int unit, int tid) {
    const int x = unit & 7, r = unit >> 3, lane = tid & 63, wave = __builtin_amdgcn_readfirstlane(tid >> 6), j = lane & 7, g = lane >> 3;
    LAS float* part = (LAS float*)lds;
    const __amdgpu_buffer_rsrc_t tab = __builtin_amdgcn_make_buffer_rsrc((void*)TU, 0, NEXP * D, 0x00020000);
    __syncthreads();
    for (int i = tid; i < 256 * PGP; i += 512) part[i] = 0.f;
    __syncthreads();
    for (int sl = 0; sl < 4; ++sl) { const int sidx = 4 * x + sl;
        const int lo = sidx * NEXP * 128 + j * 16;
        for (int tb = wave * 32; tb < wave * 32 + 32; tb += 8) { const int tl = tb + g, tok = 256 * r + tl;
            const bf16* hp = H + (size_t)tok * D + sidx * 128 + 16 * j; float hv[16]; unpack8(*(const u32x4*)hp, hv); unpack8(*(const u32x4*)(hp + 8), hv + 8);
            const int* ep = EIDX + (size_t)tok * 128; LAS float* prow = part + tl * PGP;
            int eA[8], eB[8]; u32x4 qA[8], qB[8];
            ld_e8(ep, eA); ld_e8(ep + 8, eB); ld_q8(tab, lo, eA, qA);
#pragma unroll 1
            for (int c = 0; c < 16; c += 2) {
                ld_q8(tab, lo, eB, qB);
                if (c + 2 < 16) ld_e8(ep + 8 * (c + 2), eA);
                g1_chunk(qA, hv, prow + 8 * c, j);
                if (c + 2 < 16) ld_q8(tab, lo, eA, qA);
                if (c + 3 < 16) ld_e8(ep + 8 * (c + 3), eB);
                g1_chunk(qB, hv, prow + 8 * (c + 1), j);
            }
        }
    }
    __syncthreads();
    float* dst = PART + ((size_t)x * T + 256 * r) * 128;
    for (int i = tid; i < 256 * 32; i += 512) *(f32x4*)(dst + i * 4) = *(const LAS f32x4*)(part + (i >> 5) * PGP + (i & 31) * 4);
}
DI void peer_g2(const float* PART, const int* EIDX, const float* GATE, const float* SU, const float* SV, float* W, int i4) {
    f32x4 s = {0.f, 0.f, 0.f, 0.f};
#pragma unroll
    for (int x = 0; x < 8; ++x) s += *(const f32x4*)(PART + (size_t)x * T * 128 + 4 * (size_t)i4);
    const i32x4 e = *(const i32x4*)(EIDX + 4 * (size_t)i4); const f32x4 g = *(const f32x4*)(GATE + 4 * (size_t)i4);
    float su[4], sv[4];
#pragma unroll
    for (int k = 0; k < 4; ++k) { su[k] = SU[e[k]]; sv[k] = SV[e[k]]; }
    f32x4 w;
#pragma unroll
    for (int k = 0; k < 4; ++k) w[k] = g[k] * gelu_tanh(s[k] * su[k]) * sv[k];
    *(f32x4*)(W + 4 * (size_t)i4) = w;
}
DI void g3_chunk(const u32x4 (&q)[8], const LAS float* wrow, float (&acc)[16]) {
#pragma unroll
    for (int m = 0; m < 2; ++m) { const f32x4 w4 = *(const LAS f32x4*)(wrow + 4 * m);
#pragma unroll
        for (int i2 = 0; i2 < 4; ++i2) { float f[16]; unpack_fp8x16(q[4 * m + i2], f);
#pragma unroll
            for (int k = 0; k < 16; ++k) acc[k] += w4[i2] * f[k]; } }
}
DI void ld_e8b(const __amdgpu_buffer_rsrc_t ers, const int voff, int (&e)[8]) {
#pragma unroll
    for (int m = 0; m < 2; ++m) { const u32x4 v = __builtin_amdgcn_raw_buffer_load_b128(ers, voff + 16 * m, 0, 0); e[4 * m] = (int)v[0]; e[4 * m + 1] = (int)v[1]; e[4 * m + 2] = (int)v[2]; e[4 * m + 3] = (int)v[3]; }
}
struct GChunk { int eoff, lo, tl, c, sidx; };
DI GChunk gchunk(int cc, int wave, int r, int x, int g, int j) {
    GChunk q; const int b = cc >> 4; q.c = cc & 15; q.sidx = 4 * x + (b >> 2); q.tl = wave * 32 + (b & 3) * 8 + g;
    q.eoff = ((256 * r + q.tl) * 128 + 8 * q.c) * 4; q.lo = q.sidx * NEXP * 128 + j * 16; return q;
}
DI void peer_g3_unit(const float* W, const unsigned char* TV, const int* EIDX, float* out, LAS unsigned char* lds, int unit, int tid) {
    const int x = unit & 7, r = unit >> 3, lane = tid & 63, wave = __builtin_amdgcn_readfirstlane(tid >> 6), j = lane & 7, g = lane >> 3;
    LAS float* wl = (LAS float*)lds;
    const __amdgpu_buffer_rsrc_t tab = __builtin_amdgcn_make_buffer_rsrc((void*)TV, 0, NEXP * D, 0x00020000);
    const __amdgpu_buffer_rsrc_t ers = __builtin_amdgcn_make_buffer_rsrc((void*)EIDX, 0, T * 128 * 4, 0x00020000);
    __syncthreads();
    { const float* src = W + (size_t)(256 * r) * 128;
      for (int i = tid; i < 256 * 32; i += 512) *(LAS f32x4*)(wl + (i >> 5) * PGP + (i & 31) * 4) = *(const f32x4*)(src + i * 4); }
    __syncthreads();
    int eA[8], eB[8]; u32x4 qA[8], qB[8]; f32x4 ov[4]; float acc[16];
    { const GChunk c0 = gchunk(0, wave, r, x, g, j), c1 = gchunk(1, wave, r, x, g, j); ld_e8b(ers, c0.eoff, eA); ld_e8b(ers, c1.eoff, eB); ld_q8(tab, c0.lo, eA, qA); }
#pragma unroll 1
    for (int cc = 0; cc < 256; cc += 2) {
        const GChunk ca = gchunk(cc, wave, r, x, g, j), cb = gchunk(cc + 1, wave, r, x, g, j);
        float* op = out + (size_t)(256 * r + ca.tl) * D + ca.sidx * 128 + 16 * j;
        ld_q8(tab, cb.lo, eB, qB);
        if (cc + 2 < 256) ld_e8b(ers, gchunk(cc + 2, wave, r, x, g, j).eoff, eA);
        if (ca.c == 0) {
#pragma unroll
            for (int k = 0; k < 4; ++k) ov[k] = *(const f32x4*)(op + 4 * k);
#pragma unroll
            for (int k = 0; k < 16; ++k) acc[k] = 0.f; }
        g3_chunk(qA, wl + ca.tl * PGP + 8 * ca.c, acc);
        if (cc + 2 < 256) ld_q8(tab, gchunk(cc + 2, wave, r, x, g, j).lo, eA, qA);
        if (cc + 3 < 256) ld_e8b(ers, gchunk(cc + 3, wave, r, x, g, j).eoff, eB);
        g3_chunk(qB, wl + cb.tl * PGP + 8 * cb.c, acc);
        if (cb.c == 15) {
#pragma unroll
            for (int k = 0; k < 4; ++k) { f32x4 o = ov[k]; o[0] += acc[4 * k]; o[1] += acc[4 * k + 1]; o[2] += acc[4 * k + 2]; o[3] += acc[4 * k + 3]; *(f32x4*)(op + 4 * k) = o; } }
    }
}

constexpr int NPH = 24;
__global__ void __launch_bounds__(512, 2) fwd_kernel(Args a_) {
    extern __shared__ __attribute__((aligned(16))) unsigned char lds_raw[];
    LAS unsigned char* lds = (LAS unsigned char*)lds_raw;
    const int wave = __builtin_amdgcn_readfirstlane(threadIdx.x >> 6);
    const int G = gridDim.x, bid = blockIdx.x, gw = bid * 8 + wave, ngw = G * 8;
    volatile LAS unsigned* MISC = (volatile LAS unsigned*)(lds + LDS_MISC);
    if (wave == 0) MISC[lane_id()] = 0u;
    __syncthreads();
    unsigned* ctl = (unsigned*)(a_.ws + WS_CTL);
    XcdBarrier bar = xcd_barrier_post(ctl + 4096, MISC + 8, wave);
    const int lo = a_.ph_lo, hi = a_.ph_hi;
#ifndef PHASE_MASK
#define PHASE_MASK 0xffffffffu
#endif
#define IN(k) ((((PHASE_MASK) >> (k)) & 1u) && lo <= (k) && (k) < hi)
#ifndef DUP
#define DUP -1
#endif
#define REP(k) for (int rep_ = 0; rep_ < ((DUP) == (k) ? 2 : 1); ++rep_)
#define SEAM(k) do { if (IN(k) && IN((k) + 1)) xcd_barrier(bar); } while (0)
#define PH_BASES unsigned char* ws = a_.ws; float* out_ = a_.out; asm volatile("" : "+s"(ws), "+s"(out_)); const PA a{a_, ws, out_}; bf16* Hb = (bf16*)(ws + WS_H); (void)Hb; const int lane = lane_id(), tid = wave * 64 + lane; (void)tid;

    if (IN(0)) REP(0) { PH_BASES
        if (bid < S5G) s5_build(a, lds, bid, tid);
        for (int g = bid + G; g < S5G; g += G) s5_build(a, lds, g, tid);
        __syncthreads();
        LAS float* scr = (LAS float*)(lds + wave * 16384);
        constexpr int I_WIN = 64 * 320, I_GLU = 32 * 64, I_EWO = 64 * 128, I_OWI = 64 * 384, I_OWO = 64 * 128;
        constexpr int NIT = I_WIN + I_GLU + I_EWO + I_OWI + I_OWO;
        for (int it = gw; it < NIT; it += ngw) { int r = it;
            if (r < I_WIN) { const int nb_ = r % 320;
                if (FP8_WPART && !FP8_WIN && (nb_ < 64 || nb_ >= 192)) { transpose_item8(inp(a, I_EWIN), D, 10240, ws + WS_WIN8, scr, r, lane, nb_ < 64 ? 0 : -4096); continue; }
                if (FP8_WIN) transpose_item8(inp(a, I_EWIN), D, 10240, ws + WS_WIN, scr, r, lane); else transpose_item(inp(a, I_EWIN), D, 10240, (bf16*)(ws + WS_WIN), nullptr, scr, r, lane); continue; } r -= I_WIN;
            if (r < I_GLU) { transpose_item(inp(a, I_GLUW), S5W, S5W, (bf16*)(ws + WS_GLU), nullptr, scr, r, lane); continue; } r -= I_GLU;
            if (r < I_EWO) { if (FP8_EWO) transpose_item8(inp(a, I_EWOUT), D, D, ws + WS_EWO, scr, r, lane); else transpose_item(inp(a, I_EWOUT), D, D, (bf16*)(ws + WS_EWO), nullptr, scr, r, lane); continue; } r -= I_EWO;
            if (r < I_OWI) { transpose_item8(inp(a, I_OWIN), D, QKVW, ws + WS_OWI, scr, r, lane); continue; } r -= I_OWI;
            if (FP8_OWO) transpose_item8(inp(a, I_OWOUT), D, D, ws + WS_OWO, scr, r, lane); else transpose_item(inp(a, I_OWOUT), D, D, (bf16*)(ws + WS_OWO), nullptr, scr, r, lane);
        }
        {
            const int gt = bid * 512 + tid, ngt = G * 512;
            for (int q = gt; q < 2 * 2048 * 256; q += ngt) { const int l = q >> 19, rem = q & 524287, n = rem >> 8, col0 = (rem & 255) * 8, blk = n >> 7;
                u32x4 w = {0u, 0u, 0u, 0u};
                if ((col0 >> 7) == blk) { const float* kp = inp(a, I_PKEYS) + (((size_t)(l * 16 + blk) * PNK + (n & 127)) * PKD + (col0 & 127));
                    const f32x4 k0 = *(const f32x4*)kp, k1 = *(const f32x4*)(kp + 4); w.x = pk2(k0[0], k0[1]); w.y = pk2(k0[2], k0[3]); w.z = pk2(k1[0], k1[1]); w.w = pk2(k1[2], k1[3]); }
                *(u32x4*)((bf16*)(ws + WS_PKEY) + (size_t)q * 8) = w; }
            for (int q = gt; q < 2 * D * PQW / 8; q += ngt) { const float* sp = inp(a, I_PWQ) + (size_t)q * 8; const f32x4 v0 = *(const f32x4*)sp, v1 = *(const f32x4*)(sp + 4);
                u32x4 w; w.x = pk2(v0[0], v0[1]); w.y = pk2(v0[2], v0[3]); w.z = pk2(v1[0], v1[1]); w.w = pk2(v1[2], v1[3]); *(u32x4*)((bf16*)(ws + WS_WQB) + (size_t)q * 8) = w; }
        }
        const bool bal = (G == 256);
        const int nrounds = bal ? (bid >= 128 ? 34 : 30) : (4 * NEXP - gw + ngw - 1) / ngw;
#pragma unroll 1
        for (int k = 0; k < nrounds; ++k) { const int rr = (bal && k >= 30) ? 30 * ngw + (gw - 1024) + (k - 30) * 1024 : gw + k * ngw;
            const int tb = rr >> 15, idx = rr & 32767, l = idx >> 14, e = idx & 16383;
            fp8_row(inp(a, tb ? I_PV : I_PU) + (size_t)idx * D, ws + (tb ? WS_TV : WS_TU) + (size_t)l * NEXP * D, e, (float*)(ws + (tb ? WS_SV : WS_SU)) + idx, lane); }
        if (FP8_WIN) { for (int m = gw; m < T; m += ngw) rms_row8(inp(a, I_X) + (size_t)m * D, inp(a, I_EVG), ws + WS_H + (size_t)m * D, lane); }
        else if (FP8_WPART) { for (int m = gw; m < T; m += ngw) rms_row_both(inp(a, I_X) + (size_t)m * D, inp(a, I_EVG), Hb + (size_t)m * D, ws + WS_H8L0 + (size_t)m * D, lane); }
        else rms_phase(inp(a, I_X), inp(a, I_EVG), Hb, gw, ngw, lane);
    }
    SEAM(0);
    if (IN(1)) { PH_BASES
        if (FP8_WPART && !FP8_WIN) {
            { pg8::Sched S{Hb, (const bf16*)(ws + WS_WIN) + (size_t)2048 * D, 0, 0, D, D, T / 256, 16, 1, G, bid};
              pg8::EpiZ E{(bf16*)(ws + WS_UC), (bf16*)(ws + WS_Z), 0, 0, 8}; pg8::gemm_phase<pg8::EpiZ, pg8::Sched, false>(lds, tid, D, D, D, S, E); }
            { pg8::Sched S{(const bf16*)(ws + WS_H8L0), (const bf16*)(ws + WS_WIN8), 0, 0, D / 2, D / 2, T / 256, 24, 1, G, bid};
              pg8::EpiZ E{(bf16*)(ws + WS_UC), (bf16*)(ws + WS_Z), 8, 0, 16}; pg8::gemm_phase<pg8::EpiZ, pg8::Sched, true>(lds, tid, D / 2, D / 2, D / 2, S, E); }
        } else { constexpr int KW = FP8_WIN ? D / 2 : D; pg8::Sched S{Hb, (const bf16*)(ws + WS_WIN), 0, 0, KW, KW, T / 256, 10240 / 256, 1, G, bid};
        pg8::EpiZ E{(bf16*)(ws + WS_UC), (bf16*)(ws + WS_Z), 0, 0, 0}; pg8::gemm_phase<pg8::EpiZ, pg8::Sched, FP8_WIN != 0>(lds, tid, KW, KW, KW, S, E); }
        pg8::SchedFold SF{(const bf16*)(ws + WS_PKEY), (const bf16*)(ws + WS_WQB), G, bid};
        pg8::EpiBf16 EF{(bf16*)(ws + WS_WST), D, (size_t)PQW * D}; pg8::gemm_phase(lds, tid, 256, PQW, PQW, SF, EF); }
    SEAM(1);
    if (IN(2)) { PH_BASES pg8::Sched S{(const bf16*)(ws + WS_UC), (const bf16*)(ws + WS_BTE), (size_t)S5NC * UCLD, (size_t)256 * 512, UCLD, 512, 1, 1, S5G, G, bid};
        pg8::EpiS5E E{(float*)(ws + WS_E)}; pg8::gemm_phase(lds, tid, 512, UCLD, 512, S, E);
        for (int it = bid; it < (T / 64) * RH; it += G) ret_prep_item(a, lds, it, tid);
    }
    SEAM(2);
    if (IN(3)) { PH_BASES
        { pg8::SchedRet S{(const bf16*)(ws + WS_QR), (const bf16*)(ws + WS_KR), 0, G, bid}; pg8::EpiRetS E{(bf16*)(ws + WS_SQ)}; pg8::gemm_phase(lds, tid, 256, RW, RW, S, E); }
        { pg8::SchedRet S{(const bf16*)(ws + WS_VS), (const bf16*)(ws + WS_KDT), 1, G, bid}; pg8::EpiRetKV E{(float*)(ws + WS_KVT)}; pg8::gemm_phase(lds, tid, 256, 512, T, S, E); }
        for (int g = bid; g < S5G; g += G) s5_scan(a, lds, g, tid); }
    SEAM(3);
    if (IN(4)) REP(4) { PH_BASES pg8::Sched S{(const bf16*)(ws + WS_UC), (const bf16*)(ws + WS_BT13), (size_t)S5NC * UCLD, (size_t)512 * UCLD, UCLD, UCLD, 1, 2, S5G, G, bid};
        pg8::EpiS5Y E{(const bf16*)(ws + WS_UC), inp(a, I_S5D), (bf16*)(ws + WS_YPRE)}; pg8::gemm_phase(lds, tid, UCLD, UCLD, UCLD, S, E);
        for (int e4 = bid * 512 + tid; e4 < RH * 256 * 64; e4 += G * 512) ret_prefix(a, e4);
    }
    SEAM(4);
    if (IN(5)) { PH_BASES
        { pg8::Sched S{(const bf16*)(ws + WS_YPRE), (const bf16*)(ws + WS_GLU), 0, 0, S5W, S5W, T / 256, S5W / 256, 1, G, bid};
          pg8::EpiGlu E{(const bf16*)(ws + WS_YPRE), inp(a, I_GLUB), (bf16*)(ws + WS_YCAT)}; pg8::gemm_phase(lds, tid, S5W, S5W, S5W, S, E); }
        { pg8::SchedRet S{(const bf16*)(ws + WS_SQ), (const bf16*)(ws + WS_VS), 2, G, bid};
          pg8::EpiRetOut E{(const bf16*)(ws + WS_Z), inp(a, I_GNG), inp(a, I_GNB), (bf16*)(ws + WS_YCAT), (LAS float*)(lds + 131072)}; pg8::gemm_phase(lds, tid, 512, 512, 512, S, E); } }
    SEAM(5);
    if (IN(6)) { PH_BASES constexpr int KW = FP8_EWO ? D / 2 : D; pg8::Sched S{(const bf16*)(ws + WS_YCAT), (const bf16*)(ws + WS_EWO), 0, 0, KW, KW, T / 256, D / 256, 1, G, bid};
        pg8::EpiF32 E{a.out, inp(a, I_X), D}; pg8::gemm_phase<pg8::EpiF32, pg8::Sched, FP8_EWO != 0>(lds, tid, KW, KW, KW, S, E); }
    SEAM(6);
#define PEER_BLOCK(P, LAYER) \
    if (IN(P)) { PH_BASES rms_phase(a.out, inp(a, I_FFNG) + (LAYER) * D, Hb, gw, ngw, lane); } \
    SEAM(P); \
    if (IN((P) + 1)) { PH_BASES pg8::Sched S{Hb, (const bf16*)(ws + WS_WST) + (size_t)(LAYER) * PQW * D, 0, 0, D, D, T / 256, PQW / 256, 1, G, bid}; \
        if (G == 256) { pg8::EpiTopk E{(int*)(ws + WS_EIDX), (float*)(ws + WS_GATE), lds}; pg8::gemm_phase(lds, tid, D, D, D, S, E); }        \
        else { pg8::EpiF32 E{(float*)(ws + WS_PS), nullptr, PQW}; pg8::gemm_phase(lds, tid, D, D, D, S, E); } } \
    if (G != 256) SEAM((P) + 1); \
    if (IN((P) + 2) && G != 256) REP((P) + 2) { PH_BASES peer_topk_phase((const float*)(ws + WS_PS), (int*)(ws + WS_EIDX), (float*)(ws + WS_GATE), (LAS float*)(lds + wave * 2048), gw, ngw, lane); } \
    SEAM((P) + 2); \
    if (IN((P) + 3)) REP((P) + 3) { PH_BASES for (int u = bid; u < 256; u += G) \
        peer_g1_unit(Hb, ws + WS_TU + (size_t)(LAYER) * NEXP * D, (const int*)(ws + WS_EIDX), (float*)(ws + WS_PART), lds, u, tid); } \
    SEAM((P) + 3); \
    if (IN((P) + 4)) { PH_BASES for (int i = bid * 512 + tid; i < T * 32; i += G * 512) \
        peer_g2((const float*)(ws + WS_PART), (const int*)(ws + WS_EIDX), (const float*)(ws + WS_GATE), (const float*)(ws + WS_SU) + (LAYER) * NEXP, (const float*)(ws + WS_SV) + (LAYER) * NEXP, (float*)(ws + WS_PW), i); } \
    SEAM((P) + 4); \
    if (IN((P) + 5)) { PH_BASES for (int u = bid; u < 256; u += G) \
        peer_g3_unit((const float*)(ws + WS_PW), ws + WS_TV + (size_t)(LAYER) * NEXP * D, (const int*)(ws + WS_EIDX), a.out, lds, u, tid); } \
    SEAM((P) + 5);
    PEER_BLOCK(7, 0)
    if (IN(13)) { PH_BASES for (int m = gw; m < T; m += ngw) rms_row8(a.out + (size_t)m * D, inp(a, I_ODG), ws + WS_H + (size_t)m * D, lane); }
    SEAM(13);
    if (IN(14)) REP(14) { PH_BASES
        { pg8::Sched S{Hb, (const bf16*)(ws + WS_OWI), 0, 0, D / 2, D / 2, T / 256, 2 * D / 256, 1, G, bid};
          pg8::EpiQK E{(bf16*)(ws + WS_QKV), inp(a, I_QNG), inp(a, I_KNG), (PG8_LAS float*)(lds + 131072)}; pg8::gemm_phase<pg8::EpiQK, pg8::Sched, true>(lds, tid, D / 2, D / 2, D / 2, S, E); }
        { pg8::Sched S{(const bf16*)(ws + WS_OWI) + (size_t)2 * D * (D / 2), Hb, 0, 0, D / 2, D / 2, AH * AVD / 256, T / 256, 1, G, bid};
          pg8::EpiBf16 E{(bf16*)(ws + WS_VT1), T, 0}; pg8::gemm_phase<pg8::EpiBf16, pg8::Sched, true>(lds, tid, D / 2, D / 2, D / 2, S, E); }
        if (bid == 0 && wave == 0) { const float s1 = wave_sum(inp(a, I_LQ1)[lane] * inp(a, I_LK1)[lane] + inp(a, I_LQ1)[lane + 64] * inp(a, I_LK1)[lane + 64]);
            const float s2 = wave_sum(inp(a, I_LQ2)[lane] * inp(a, I_LK2)[lane] + inp(a, I_LQ2)[lane + 64] * inp(a, I_LK2)[lane + 64]);
            if (lane == 0) *(float*)(ws + WS_MISC) = expf(s1) - expf(s2) + LAMBDA_INIT; }
    }
    SEAM(14);
    if (IN(16)) REP(16) { PH_BASES if (wave >= 4) __builtin_amdgcn_s_setprio(1);
        const float lam = __builtin_bit_cast(float, __builtin_amdgcn_readfirstlane(*(const int*)(ws + WS_MISC)));
        for (int c = bid; c < 256; c += G) { const int hA = 2 * (c & 7) + ((c >> 3) & 1), j = c >> 4;
#pragma unroll 1
            for (int u = 0; u < 4; ++u) { const int qb = (u == 0) ? 63 - j : (u == 1) ? 32 + j : (u == 2) ? 31 - j : j; diff_unit(a, lds, hA, qb, lam, wave); } }
        __builtin_amdgcn_s_setprio(0); }
    SEAM(16);
    if (IN(17)) { PH_BASES constexpr int KW = FP8_OWO ? D / 2 : D; pg8::Sched S{(const bf16*)(ws + WS_AO), (const bf16*)(ws + WS_OWO), 0, 0, KW, KW, T / 256, D / 256, 1, G, bid};
        pg8::EpiF32 E{a.out, a.out, D}; pg8::gemm_phase<pg8::EpiF32, pg8::Sched, FP8_OWO != 0>(lds, tid, KW, KW, KW, S, E); }
    SEAM(17);
    PEER_BLOCK(18, 1)
#undef IN
#undef SEAM
}

#ifndef N_LAUNCH_SPLIT
#define N_LAUNCH_SPLIT 0
#endif
extern "C" void kernel_launch(void* const* d_in, const int* in_sizes, int n_in, void* d_out, int out_size, void* d_ws, size_t ws_size, hipStream_t stream) {
    static int grid = 0;
    if (grid == 0) {
        if (n_in != 32 || out_size != T * D || ws_size < WS_END) { fprintf(stderr, "kernel_launch: unexpected shapes (n_in %d, out %d, ws %zu < %zu)\n", n_in, out_size, ws_size, (size_t)WS_END); grid = -1; return; }
        int dev = 0, cus = 0, per_cu = 0;
        if (hipGetDevice(&dev) != hipSuccess || hipDeviceGetAttribute(&cus, hipDeviceAttributeMultiprocessorCount, dev) != hipSuccess) { grid = -1; return; }
        if (hipFuncSetAttribute((const void*)fwd_kernel, hipFuncAttributeMaxDynamicSharedMemorySize, LDS_BYTES) != hipSuccess) { fprintf(stderr, "kernel_launch: hipFuncSetAttribute failed\n"); grid = -1; return; }
        if (hipOccupancyMaxActiveBlocksPerMultiprocessor(&per_cu, (const void*)fwd_kernel, 512, LDS_BYTES) != hipSuccess || per_cu < 1) fprintf(stderr, "kernel_launch: occupancy query reports %d\n", per_cu);
        (void)hipGetLastError();
        grid = cus;
    }
    if (grid < 0) return;
    (void)hipMemsetAsync((char*)d_ws + WS_CTL, 0, CTL_ZERO_BYTES, stream);
    Args a{};
    for (int i = 0; i < 32; ++i) a.in[i] = (const float*)d_in[i];
    a.out = (float*)d_out; a.ws = (unsigned char*)d_ws;
#if N_LAUNCH_SPLIT
    for (int p = 0; p < NPH; ++p) { a.ph_lo = p; a.ph_hi = p + 1; hipLaunchKernelGGL(fwd_kernel, dim3(grid), dim3(512), LDS_BYTES, stream, a); }
#else
    a.ph_lo = 0; a.ph_hi = NPH; hipLaunchKernelGGL(fwd_kernel, dim3(grid), dim3(512), LDS_BYTES, stream, a);
#endif
}
```

```cpp
#include <hip/hip_runtime.h>
#include <cstdio>
#include <cstdint>

#define GAS __attribute__((address_space(1)))
#define LAS __attribute__((address_space(3)))
typedef unsigned short bf16;
typedef short bf16x8 __attribute__((ext_vector_type(8)));
typedef short s16x4 __attribute__((ext_vector_type(4)));
typedef float f32x2 __attribute__((ext_vector_type(2)));
typedef float f32x4 __attribute__((ext_vector_type(4)));
typedef float f32x16 __attribute__((ext_vector_type(16)));
typedef unsigned u32x2 __attribute__((ext_vector_type(2)));
typedef unsigned u32x4 __attribute__((ext_vector_type(4)));
typedef __bf16 bf16x2_t __attribute__((ext_vector_type(2)));
#define DI __device__ __forceinline__

DI unsigned pk2(float lo, float hi) { f32x2 v = {lo, hi}; bf16x2_t b = __builtin_convertvector(v, bf16x2_t); return __builtin_bit_cast(unsigned, b); }
DI float bflo(unsigned u) { return __builtin_bit_cast(float, u << 16); }
DI float bfhi(unsigned u) { return __builtin_bit_cast(float, u & 0xffff0000u); }
DI float bf2f(bf16 b) { return __builtin_bit_cast(float, (unsigned)b << 16); }
DI float wave_sum(float v) {
#pragma unroll
    for (int o = 1; o < 64; o <<= 1) v += __shfl_xor(v, o);
    return v;
}
DI float sigmoidf_(float x) { return 1.f / (1.f + __expf(-x)); }
DI float gelu_tanh(float v) { const float z = 0.7978845608028654f * (v + 0.044715f * v * v * v); return v / (1.f + __expf(-2.f * z)); }
DI int crow(int r, int hi) { return (r & 3) + 8 * (r >> 2) + 4 * hi; }
DI unsigned pk4_fp8(float a, float b, float c, float d) { int p = 0; p = __builtin_amdgcn_cvt_pk_fp8_f32(a, b, p, false); p = __builtin_amdgcn_cvt_pk_fp8_f32(c, d, p, true); return (unsigned)p; }
DI void swap32(const float x, float& lo, float& hi) { unsigned a_ = __builtin_bit_cast(unsigned, x), b_ = a_; asm volatile("s_nop 1\n\tv_permlane32_swap_b32 %0, %1" : "+v"(a_), "+v"(b_)); lo = __builtin_bit_cast(float, a_); hi = __builtin_bit_cast(float, b_); }
DI int lane_id() { return (int)__builtin_amdgcn_mbcnt_hi(~0u, __builtin_amdgcn_mbcnt_lo(~0u, 0u)); }

#ifndef FP8_WIN
#define FP8_WIN 1
#endif
#ifndef FP8_EWO
#define FP8_EWO 1
#endif
#ifndef FP8_WPART
#define FP8_WPART 1
#endif
#ifndef FP8_OWO
#define FP8_OWO 1
#endif
constexpr int T = 8192, D = 4096;
constexpr int S5W = 2048, S5G = 128, S5P = 64, S5L = 32, S5NC = T / S5L;
constexpr int UCLD = 640;
constexpr int RH = 8, RHD = 256, RW = 2048;
constexpr int ZW = 8192;
constexpr int AH = 16, AHD = 128, AVD = 256, QKVW = 12288;
constexpr int PH = 8, PNK = 128, PKD = 128, PTOPK = 16, PQW = 2048, NEXP = 16384;
constexpr float EPS = 1e-6f;
constexpr float LAMBDA_INIT = 0.35550906759096926f;
constexpr float LOG2E = 1.4426950408889634f;

constexpr size_t MiB = 1u << 20;
constexpr size_t WS_CTL = 0, CTL_ZERO_BYTES = 1 * MiB;
constexpr size_t WS_WIN = 2 * MiB;
constexpr size_t WS_GLU = 82 * MiB;
constexpr size_t WS_EWO = 90 * MiB;
constexpr size_t WS_OWI = 122 * MiB;
constexpr size_t WS_OWO = 218 * MiB;
constexpr size_t WS_WST = 250 * MiB;
constexpr size_t WS_PKEY = 282 * MiB;
constexpr size_t WS_BT13 = 298 * MiB;
constexpr size_t WS_BTE = 378 * MiB;
constexpr size_t WS_PW32 = 410 * MiB;
constexpr size_t WS_MISC = 411 * MiB;
constexpr size_t WS_SU = WS_MISC + 65536;
constexpr size_t WS_SV = WS_MISC + 262144;
constexpr size_t WS_TU = 412 * MiB;
constexpr size_t WS_TV = 668 * MiB;
constexpr size_t WS_H = 924 * MiB;
constexpr size_t WS_R0 = 988 * MiB;
constexpr size_t WS_Z = WS_R0;
constexpr size_t WS_UC = WS_R0 + 128 * MiB;
constexpr size_t WS_E = WS_R0 + 168 * MiB;
constexpr size_t WS_YPRE = WS_R0 + 184 * MiB;
constexpr size_t WS_YCAT = WS_R0 + 216 * MiB;
constexpr size_t WS_QR = WS_R0 + 280 * MiB;
constexpr size_t WS_KR = WS_R0 + 312 * MiB;
constexpr size_t WS_VT = WS_R0 + 344 * MiB;
constexpr size_t WS_H8L0 = WS_R0 + 448 * MiB;
constexpr size_t WS_WIN8 = WS_R0 + 480 * MiB;
constexpr size_t WS_PART = WS_R0;
constexpr size_t WS_PW = WS_R0 + 32 * MiB;
constexpr size_t WS_QKV = WS_R0;
constexpr size_t WS_VT1 = WS_R0 + 192 * MiB;
constexpr size_t WS_O1 = WS_R0 + 256 * MiB;
constexpr size_t WS_AO = WS_R0 + 384 * MiB;
constexpr size_t WS_WQB = 1500 * MiB;
constexpr size_t WS_PS = 1532 * MiB;
constexpr size_t WS_EIDX = 1596 * MiB;
constexpr size_t WS_GATE = 1600 * MiB;
constexpr size_t WS_SQ = 1604 * MiB;
constexpr size_t WS_VS = 1668 * MiB;
constexpr size_t WS_KVT = 1732 * MiB;
constexpr size_t WS_KDT = 1796 * MiB;
constexpr size_t WS_END = 1828 * MiB;

constexpr int LDS_BYTES = 147456;
constexpr int LDS_MISC = 131072 + 8192;

#define XB_TMO      128
#define XB_XCNT(j)  (256  + 64 * (j))
#define XB_XSUB(j)  (1280 + 64 * (j))
#define XB_XGEN(j)  (2304 + 64 * (j))
#define XB_TOP      3328
#define XB_TOPGEN   3392
#define XCD_BAR_WORDS 3456
#define XB_SPIN_CAP (1u << 21)
DI unsigned xb_ld(unsigned* p)              { return __hip_atomic_load(p, __ATOMIC_RELAXED, __HIP_MEMORY_SCOPE_AGENT); }
DI unsigned xb_add(unsigned* p, unsigned v) { return __hip_atomic_fetch_add(p, v, __ATOMIC_RELAXED, __HIP_MEMORY_SCOPE_AGENT); }
DI unsigned xb_xcc_id() { return (unsigned)__builtin_amdgcn_s_getreg((3 << 11) | 20) & 0xFu; }
#define XB_SPIN(cond, bar) do { unsigned _sp = 0; while (cond) { __builtin_amdgcn_s_sleep(1); \
    if ((++_sp & 255u) == 0u) { if (xb_ld(&(bar)[XB_TMO])) break; if (_sp > XB_SPIN_CAP) { atomicAdd(&(bar)[XB_TMO], 1u); break; } } } } while (0)
struct XcdBarrier { unsigned* bar; unsigned x; volatile LAS unsigned* st; int wv; };
DI XcdBarrier xcd_barrier_post(unsigned* bar, volatile LAS unsigned* st, int wv) {
    XcdBarrier b; b.bar = bar; b.x = xb_xcc_id(); b.st = st; b.wv = wv;
    if (wv == 0 && lane_id() == 0) (void)xb_add(&bar[XB_XCNT(b.x)], 1u);
    return b;
}
DI void xcd_barrier_complete(unsigned* bar, unsigned x, unsigned& nloc, unsigned& nx) {
    const unsigned G = gridDim.x * gridDim.y * gridDim.z;
    unsigned sum, cnt, mine, sp = 0u;
    for (;;) {
        sum = 0u; cnt = 0u; mine = 0u;
#pragma unroll
        for (unsigned j = 0; j < 16; ++j) { const unsigned c = xb_ld(&bar[XB_XCNT(j)]); sum += c; cnt += (c > 0u) ? 1u : 0u; mine = (j == x) ? c : mine; }
        if (sum == G) break;
        __builtin_amdgcn_s_sleep(1);
        if ((++sp & 255u) == 0u) { if (xb_ld(&bar[XB_TMO])) break; if (sp > XB_SPIN_CAP) { atomicAdd(&bar[XB_TMO], 1u); break; } }
    }
    nloc = mine > 0u ? mine : 1u; nx = cnt > 0u ? cnt : 1u;
}
DI void xcd_barrier(const XcdBarrier& b) {
    asm volatile("s_waitcnt vmcnt(0)" ::: "memory");
    __syncthreads();
    if (b.wv == 0 && lane_id() == 0) {
        unsigned* bar = b.bar;
        __builtin_amdgcn_s_waitcnt(0);
        unsigned nloc = b.st[0], nx = b.st[1];
        if (nloc == 0u) { xcd_barrier_complete(bar, b.x, nloc, nx); b.st[0] = nloc; b.st[1] = nx; }
        const unsigned old = xb_add(&bar[XB_XSUB(b.x)], 1u);
        const unsigned gen = old / nloc;
        if (old + 1u == (gen + 1u) * nloc) {
            __builtin_amdgcn_fence(__ATOMIC_RELEASE, "agent");
            asm volatile("s_waitcnt vmcnt(0)" ::: "memory");
            const unsigned og = xb_add(&bar[XB_TOP], 1u);
            const unsigned tg = og / nx;
            if (og + 1u == (tg + 1u) * nx) xb_add(&bar[XB_TOPGEN], 1u);
            else XB_SPIN(xb_ld(&bar[XB_TOPGEN]) == tg, bar);
            __builtin_amdgcn_fence(__ATOMIC_ACQUIRE, "agent");
            xb_add(&bar[XB_XGEN(b.x)], 1u);
            asm volatile("s_waitcnt vmcnt(0)" ::: "memory");
        } else {
            XB_SPIN(xb_ld(&bar[XB_XGEN(b.x)]) == gen, bar);
            __builtin_amdgcn_fence(__ATOMIC_ACQUIRE, "agent");
            asm volatile("s_waitcnt vmcnt(0)" ::: "memory");
        }
    }
    __syncthreads();
}

DI void peer_topk_process(float a0, float a1, float b0, float b1, int* EIDX, float* GATE, LAS float* scr, int item, int lane);
namespace pg8 {
#define PG8_LAS __attribute__((address_space(3)))
constexpr int BM = 256, BK = 64, HALF = 128, HTB = HALF * BK * 2, STAGE_BYTES = 8 * HTB, NXCD = 8, WGM = 8;
__host__ __device__ __forceinline__ int lds_byte(int r, int c) { const int st = (r >> 4) * 2 + (c >> 5), rr = r & 15, cc = c & 31, ob = rr * 64 + cc * 2; return st * 1024 + (ob ^ (((ob >> 9) & 1) << 5)); }
__host__ __device__ __forceinline__ void stage_rc(int b, int& R, int& C) { const int st = b / 1024, sb = b % 1024, swz = sb ^ (((sb >> 9) & 1) << 5); R = (st >> 1) * 16 + swz / 64; C = (st & 1) * 32 + (swz % 64) / 2; }
__host__ __device__ __forceinline__ int perm32(int rho) { const int n = rho >> 4, i = rho & 15; return 8 * (i >> 2) + 4 * n + (i & 3); }

struct Unit { const char* a; const char* b; int pm, pn, bz; };

struct Sched {
    const bf16* A; const bf16* B; size_t sA, sB; int lda, ldb, nM, nN, nB, G, c;
    DI bool next(int i, Unit& u) const {
        const long L = (long)i * G + c; const int per = nM * nN; if (L >= (long)per * nB) return false;
        const int bz = (int)(L / per); int wgid = (int)(L % per);
        { const int q = per / NXCD, r = per % NXCD, xcd = wgid % NXCD, off = wgid / NXCD; wgid = (xcd < r ? xcd * (q + 1) : r * (q + 1) + (xcd - r) * q) + off; }
        const int nig = WGM * nN, gid = wgid / nig, fm = gid * WGM, gsz = (nM - fm) < WGM ? (nM - fm) : WGM;
        u.pm = fm + ((wgid % nig) % gsz); u.pn = (wgid % nig) / gsz; u.bz = bz;
        u.a = (const char*)(A + (size_t)bz * sA + (size_t)u.pm * BM * lda); u.b = (const char*)(B + (size_t)bz * sB + (size_t)u.pn * BM * ldb);
        return true;
    }
};

struct SchedFold {
    const bf16* A; const bf16* B; int G, c;
    DI bool next(int i, Unit& u) const {
        const int L = i * G + c; if (L >= 256) return false;
        const int l = L >> 7, pm = (L >> 4) & 7, pn = L & 15; u.pm = pm; u.pn = pn; u.bz = l;
        u.a = (const char*)(A + (size_t)l * 2048 * 2048 + (size_t)pm * 256 * 2048 + pm * 256); u.b = (const char*)(B + (size_t)l * 4096 * 2048 + (size_t)pn * 256 * 2048 + pm * 256);
        return true;
    }
};
struct SchedRet {
    const bf16* A; const bf16* B; int mode, G, c;
    DI bool next(int i, Unit& u) const {
        const int L = i * G + c; if (L >= 256) return false;
        const int h = L >> 5, ch = L & 31; u.pm = 0; u.pn = 0; u.bz = L;
        if (mode == 0) { const size_t o = (size_t)ch * 256 * RW + h * RHD; u.a = (const char*)(A + o); u.b = (const char*)(B + o); }
        else if (mode == 1) { u.a = (const char*)(A + (size_t)L * 256 * 512); u.b = (const char*)(B + (size_t)h * RHD * T + ch * 256); }
        else { u.a = (const char*)(A + (size_t)L * 256 * 512); u.b = (const char*)(B + (size_t)L * 256 * 512); }
        return true;
    }
};
typedef int i32x8 __attribute__((ext_vector_type(8)));
typedef short s16x16 __attribute__((ext_vector_type(16)));
template <class Epi, class SchedT, bool FP8 = false>
DI void gemm_phase(PG8_LAS unsigned char* lds, const int tid_, const int K_, const int lda, const int ldb, const SchedT& S, const Epi& E) {
    int K = K_; asm volatile("" : "+s"(K));
    int tid = tid_; asm volatile("" : "+v"(tid));
    const int wid = __builtin_amdgcn_readfirstlane(tid >> 6), lane = tid & 63, wr = wid >> 2, wc = wid & 3, fr = lane & 15, fq = lane >> 4;
    const int nt = K / BK;
    unsigned voffA[2], voffB[2];
#pragma unroll
    for (int i = 0; i < 2; ++i) { int R, C; stage_rc(tid * 16 + i * 8192, R, C); const int Rb = Epi::PERM ? ((R & ~31) + perm32(R & 31)) : R;
        voffA[i] = (unsigned)(R * lda + C) * 2u; voffB[i] = (unsigned)(Rb * ldb + C) * 2u; }
    const size_t kstep = (size_t)(BK * 2);
    const size_t hsA = (size_t)HALF * lda * 2, hsB = (size_t)HALF * ldb * 2;
    const unsigned ldsw = (unsigned)wid * 1024u;
    const int aoff = lds_byte(wr * 64 + fr, fq * 8), boff = lds_byte(wc * 32 + fr, fq * 8);
#define PG8_SA(b, h) (((b) * 2 + (h)) * HTB)
#define PG8_SB(b, h) ((4 + (b) * 2 + (h)) * HTB)
#define PG8_STAGE(bufoff, gbase, voff) do { _Pragma("unroll") for (int _i = 0; _i < 2; ++_i) \
        __builtin_amdgcn_global_load_lds((const unsigned*)((const char*)(gbase) + (voff)[_i]), (PG8_LAS unsigned*)(lds + (bufoff) + ldsw + _i * 8192), 16, 0, 0); } while (0)
#define PG8_LDA(dst, b, h) do { _Pragma("unroll") for (int m = 0; m < 4; ++m) { const u32x4 f0 = *(const PG8_LAS u32x4*)(lds + PG8_SA(b, h) + aoff + m * 2048), f1 = *(const PG8_LAS u32x4*)(lds + PG8_SA(b, h) + aoff + m * 2048 + 1024); \
        dst[m] = __builtin_bit_cast(i32x8, __builtin_shufflevector(f0, f1, 0, 1, 2, 3, 4, 5, 6, 7)); } } while (0)
#define PG8_LDB(dst, b, h) do { _Pragma("unroll") for (int n = 0; n < 2; ++n) { const u32x4 f0 = *(const PG8_LAS u32x4*)(lds + PG8_SB(b, h) + boff + n * 2048), f1 = *(const PG8_LAS u32x4*)(lds + PG8_SB(b, h) + boff + n * 2048 + 1024); \
        dst[n] = __builtin_bit_cast(i32x8, __builtin_shufflevector(f0, f1, 0, 1, 2, 3, 4, 5, 6, 7)); } } while (0)
#define PG8_MMA(ai, bj, At, Bt) do { __builtin_amdgcn_s_setprio(1); _Pragma("unroll") for (int m = 0; m < 4; ++m) _Pragma("unroll") for (int n = 0; n < 2; ++n) { \
        if constexpr (FP8) { asm volatile("v_mfma_scale_f32_16x16x128_f8f6f4 %0, %1, %2, %0, %3, %4 op_sel_hi:[0,0,0]" : "+v"(acc[ai][bj][m][n]) : "v"(Bt[n]), "v"(At[m]), "v"(scw), "v"(scx)); } \
        else { const bf16x8 w0 = __builtin_bit_cast(bf16x8, __builtin_shufflevector(Bt[n], Bt[n], 0, 1, 2, 3)), w1 = __builtin_bit_cast(bf16x8, __builtin_shufflevector(Bt[n], Bt[n], 4, 5, 6, 7)); \
            const bf16x8 x0 = __builtin_bit_cast(bf16x8, __builtin_shufflevector(At[m], At[m], 0, 1, 2, 3)), x1 = __builtin_bit_cast(bf16x8, __builtin_shufflevector(At[m], At[m], 4, 5, 6, 7)); \
            acc[ai][bj][m][n] = __builtin_amdgcn_mfma_f32_16x16x32_bf16(w0, x0, acc[ai][bj][m][n], 0, 0, 0); acc[ai][bj][m][n] = __builtin_amdgcn_mfma_f32_16x16x32_bf16(w1, x1, acc[ai][bj][m][n], 0, 0, 0); } } \
        __builtin_amdgcn_s_setprio(0); } while (0)
#define PG8_WAIT_V(n) asm volatile("s_waitcnt vmcnt(" #n ")" ::: "memory")
#define PG8_WAIT_L(n) asm volatile("s_waitcnt lgkmcnt(" #n ")" ::: "memory")
#define PG8_BAR __builtin_amdgcn_s_barrier()
#define PG8_SCHED __builtin_amdgcn_sched_barrier(0)
    Unit cur, nxt; int ui = 0;
    if (!S.next(0, cur)) return;
    f32x4 acc[2][2][4][2];
#pragma unroll
    for (int a = 0; a < 2; ++a)
#pragma unroll
        for (int b = 0; b < 2; ++b)
#pragma unroll
            for (int m = 0; m < 4; ++m)
#pragma unroll
                for (int n = 0; n < 2; ++n) acc[a][b][m][n] = (f32x4){0.f, 0.f, 0.f, 0.f};
    const int scw = 0x77777777, scx = 0x7f7f7f7f;
    i32x8 At[4], B0[2], B1[2];
    const char* cA = cur.a; const char* cB = cur.b;
    PG8_STAGE(PG8_SB(0, 0), cB, voffB); PG8_STAGE(PG8_SB(0, 1), cB + hsB, voffB); PG8_STAGE(PG8_SA(0, 0), cA, voffA); PG8_STAGE(PG8_SA(0, 1), cA + hsA, voffA);
    if (wr == 1) PG8_BAR;
    PG8_WAIT_V(2); PG8_BAR;
    PG8_STAGE(PG8_SB(1, 0), cB + kstep, voffB); PG8_STAGE(PG8_SA(1, 0), cA + kstep, voffA); PG8_STAGE(PG8_SB(1, 1), cB + hsB + kstep, voffB);
    PG8_WAIT_V(6); PG8_BAR;
    for (;;) {
        const bool has_next = S.next(ui + 1, nxt);
        const char* nA = has_next ? nxt.a : cA; const char* nB = has_next ? nxt.b : cB;
        for (int t = 0; t < nt; t += 2) {
            const bool last = (t == nt - 2);
            const char* a1 = cA + (size_t)(t + 1) * kstep;
            const char* a2 = last ? nA : cA + (size_t)(t + 2) * kstep; const char* b2 = last ? nB : cB + (size_t)(t + 2) * kstep;
            const char* a3 = a2 + kstep; const char* b3 = b2 + kstep;
            PG8_LDB(B0, 0, 0); PG8_LDB(B1, 0, 1); PG8_SCHED; PG8_LDA(At, 0, 0); PG8_STAGE(PG8_SA(1, 1), a1 + hsA, voffA);
            PG8_WAIT_V(8); PG8_WAIT_L(0); PG8_BAR; PG8_MMA(0, 0, At, B0); PG8_MMA(0, 1, At, B1); PG8_BAR; PG8_SCHED;
            PG8_LDA(At, 0, 1); PG8_STAGE(PG8_SB(0, 0), b2, voffB); PG8_STAGE(PG8_SB(0, 1), b2 + hsB, voffB); PG8_STAGE(PG8_SA(0, 0), a2, voffA);
            PG8_WAIT_V(8); PG8_WAIT_L(0); PG8_BAR; PG8_MMA(1, 0, At, B0); PG8_MMA(1, 1, At, B1); PG8_BAR; PG8_SCHED;
            PG8_LDB(B0, 1, 0); PG8_LDB(B1, 1, 1); PG8_SCHED; PG8_LDA(At, 1, 0); PG8_STAGE(PG8_SA(0, 1), a2 + hsA, voffA);
            PG8_WAIT_V(8); PG8_WAIT_L(0); PG8_BAR; PG8_MMA(0, 0, At, B0); PG8_MMA(0, 1, At, B1); PG8_BAR; PG8_SCHED;
            PG8_LDA(At, 1, 1); PG8_STAGE(PG8_SB(1, 0), b3, voffB); PG8_STAGE(PG8_SB(1, 1), b3 + hsB, voffB); PG8_STAGE(PG8_SA(1, 0), a3, voffA);
            PG8_WAIT_V(8); PG8_WAIT_L(0); PG8_BAR; PG8_MMA(1, 0, At, B0); PG8_MMA(1, 1, At, B1); PG8_BAR; PG8_SCHED;
        }
        if (wr == 0) PG8_BAR;
        if constexpr (FP8) asm volatile("s_nop 15\n\ts_nop 15" ::: "memory");
        { int frE = fr, fqE = fq; asm volatile("" : "+v"(frE), "+v"(fqE)); E(acc, cur, wr, wc, frE, fqE); }
        if (!has_next) break;
#pragma unroll
        for (int a = 0; a < 2; ++a)
#pragma unroll
            for (int b = 0; b < 2; ++b)
#pragma unroll
                for (int m = 0; m < 4; ++m)
#pragma unroll
                    for (int n = 0; n < 2; ++n) acc[a][b][m][n] = (f32x4){0.f, 0.f, 0.f, 0.f};
        cur = nxt; cA = nA; cB = nB; ++ui;
        if (wr == 1) PG8_BAR;
    }
    PG8_WAIT_V(0);
    PG8_BAR;
#undef PG8_SA
#undef PG8_SB
#undef PG8_STAGE
#undef PG8_LDA
#undef PG8_LDB
#undef PG8_MMA
#undef PG8_WAIT_V
#undef PG8_WAIT_L
#undef PG8_BAR
#undef PG8_SCHED
}

#define EPI_LOOP_PERM(...) \
    _Pragma("unroll") for (int ai = 0; ai < 2; ++ai) _Pragma("unroll") for (int m = 0; m < 4; ++m) _Pragma("unroll") for (int bj = 0; bj < 2; ++bj) { \
        const int trow = ai * HALF + wr * 64 + m * 16 + fr, tcol = bj * HALF + wc * 32 + 8 * fq; const f32x4 v0 = acc[ai][bj][m][0], v1 = acc[ai][bj][m][1]; __VA_ARGS__ }

struct EpiBf16 {
    static constexpr bool PERM = true;
    bf16* O; int ldc; size_t sO;
    DI void operator()(const f32x4 (&acc)[2][2][4][2], const Unit& u, int wr, int wc, int fr, int fq) const {
        EPI_LOOP_PERM({ u32x4 w; w.x = pk2(v0[0], v0[1]); w.y = pk2(v0[2], v0[3]); w.z = pk2(v1[0], v1[1]); w.w = pk2(v1[2], v1[3]);
            *(u32x4*)(O + (size_t)u.bz * sO + (size_t)(u.pm * BM + trow) * ldc + u.pn * BM + tcol) = w; })
    }
};
struct EpiZ {
    static constexpr bool PERM = true;
    bf16* UC; bf16* Z; int thr, add0, add1;
    DI void operator()(const f32x4 (&acc)[2][2][4][2], const Unit& u, int wr, int wc, int fr, int fq) const {
        const int pn = u.pn + (u.pn < thr ? add0 : add1);
        EPI_LOOP_PERM({ u32x4 w; w.x = pk2(v0[0], v0[1]); w.y = pk2(v0[2], v0[3]); w.z = pk2(v1[0], v1[1]); w.w = pk2(v1[2], v1[3]);
            const int row = u.pm * BM + trow, col = pn * BM + tcol;
            if (pn < 8) { const int g = col >> 4, c = col & 15; *(u32x4*)(UC + ((size_t)(g * S5NC + (row >> 5)) * UCLD + (row & 31) * 16 + c)) = w; }
            else *(u32x4*)(Z + (size_t)row * ZW + (col - S5W)) = w; })
    }
};
struct EpiS5Y {
    static constexpr bool PERM = true;
    const bf16* UC; const float* dskip; bf16* Y;
    DI void operator()(const f32x4 (&acc)[2][2][4][2], const Unit& u, int wr, int wc, int fr, int fq) const {
        EPI_LOOP_PERM({ const int g = u.bz, chunk = trow, col = u.pn * BM + tcol, t = col >> 4, c = col & 15, tok = chunk * S5L + t, ch = g * 16 + c;
            const u32x4 uu = *(const u32x4*)(UC + ((size_t)(g * S5NC + chunk) * UCLD + col));
            const f32x4 d0 = *(const f32x4*)(dskip + ch), d1 = *(const f32x4*)(dskip + ch + 4);
            float y[8];
            y[0] = v0[0] + d0[0] * bflo(uu.x); y[1] = v0[1] + d0[1] * bfhi(uu.x); y[2] = v0[2] + d0[2] * bflo(uu.y); y[3] = v0[3] + d0[3] * bfhi(uu.y);
            y[4] = v1[0] + d1[0] * bflo(uu.z); y[5] = v1[1] + d1[1] * bfhi(uu.z); y[6] = v1[2] + d1[2] * bflo(uu.w); y[7] = v1[3] + d1[3] * bfhi(uu.w);
            _Pragma("unroll") for (int e = 0; e < 8; ++e) y[e] = gelu_tanh(y[e]);
            u32x4 w; w.x = pk2(y[0], y[1]); w.y = pk2(y[2], y[3]); w.z = pk2(y[4], y[5]); w.w = pk2(y[6], y[7]);
            *(u32x4*)(Y + (size_t)tok * S5W + ch) = w; })
    }
};
struct EpiGlu {
    static constexpr bool PERM = true;
    const bf16* YP; const float* bias; bf16* O;
    DI void operator()(const f32x4 (&acc)[2][2][4][2], const Unit& u, int wr, int wc, int fr, int fq) const {
        EPI_LOOP_PERM({ const int row = u.pm * BM + trow, col = u.pn * BM + tcol;
            const u32x4 yy = *(const u32x4*)(YP + (size_t)row * S5W + col);
            const f32x4 b0 = *(const f32x4*)(bias + col), b1 = *(const f32x4*)(bias + col + 4);
            float y[8];
            y[0] = bflo(yy.x) * sigmoidf_(v0[0] + b0[0]); y[1] = bfhi(yy.x) * sigmoidf_(v0[1] + b0[1]); y[2] = bflo(yy.y) * sigmoidf_(v0[2] + b0[2]); y[3] = bfhi(yy.y) * sigmoidf_(v0[3] + b0[3]);
            y[4] = bflo(yy.z) * sigmoidf_(v1[0] + b1[0]); y[5] = bfhi(yy.z) * sigmoidf_(v1[1] + b1[1]); y[6] = bflo(yy.w) * sigmoidf_(v1[2] + b1[2]); y[7] = bfhi(yy.w) * sigmoidf_(v1[3] + b1[3]);
            if (FP8_EWO) { u32x2 w8; w8.x = pk4_fp8(y[0], y[1], y[2], y[3]); w8.y = pk4_fp8(y[4], y[5], y[6], y[7]); *(u32x2*)((unsigned char*)O + (size_t)row * D + col) = w8; }
            else { u32x4 w; w.x = pk2(y[0], y[1]); w.y = pk2(y[2], y[3]); w.z = pk2(y[4], y[5]); w.w = pk2(y[6], y[7]);
            *(u32x4*)(O + (size_t)row * D + col) = w; } })
    }
};
#define EPI_LOOP_NAT(...) \
    _Pragma("unroll") for (int ai = 0; ai < 2; ++ai) _Pragma("unroll") for (int m = 0; m < 4; ++m) _Pragma("unroll") for (int bj = 0; bj < 2; ++bj) _Pragma("unroll") for (int n = 0; n < 2; ++n) { \
        const int trow = ai * HALF + wr * 64 + m * 16 + fr, tcol = bj * HALF + wc * 32 + 16 * n + 4 * fq; const f32x4 v = acc[ai][bj][m][n]; __VA_ARGS__ }
struct EpiF32 {
    static constexpr bool PERM = false;
    float* C; const float* res; int ldc;
    DI void operator()(const f32x4 (&acc)[2][2][4][2], const Unit& u, int wr, int wc, int fr, int fq) const {
        EPI_LOOP_NAT({ const size_t o = (size_t)(u.pm * BM + trow) * ldc + u.pn * BM + tcol; f32x4 r = v; if (res) r = r + *(const f32x4*)(res + o); *(f32x4*)(C + o) = r; })
    }
};
struct EpiS5E {
    static constexpr bool PERM = false;
    float* Eo;
    DI void operator()(const f32x4 (&acc)[2][2][4][2], const Unit& u, int wr, int wc, int fr, int fq) const {
        EPI_LOOP_NAT({ if (bj == 0) *(f32x4*)(Eo + ((size_t)(u.bz * S5NC + trow) * 128 + tcol)) = v; })
    }
};
struct EpiRetS {
    static constexpr bool PERM = true;
    bf16* SQ;
    DI void operator()(const f32x4 (&acc)[2][2][4][2], const Unit& u, int wr, int wc, int fr, int fq) const {
        const float lg2 = log2f(1.f - exp2f(-5.f - (float)(u.bz >> 5)));
        EPI_LOOP_PERM({ const int d = trow - tcol; float y[8];
            _Pragma("unroll") for (int e = 0; e < 8; ++e) { const int dd = d - e; const float sc = __builtin_amdgcn_exp2f(lg2 * (float)dd); const float v = e < 4 ? v0[e & 3] : v1[e & 3];
                y[e] = __builtin_bit_cast(float, __builtin_bit_cast(int, v * sc) & ~(dd >> 31)); }
            u32x4 w; w.x = pk2(y[0], y[1]); w.y = pk2(y[2], y[3]); w.z = pk2(y[4], y[5]); w.w = pk2(y[6], y[7]);
            *(u32x4*)(SQ + ((size_t)u.bz * 256 + trow) * 512 + tcol) = w; })
    }
};
struct EpiRetKV {
    static constexpr bool PERM = false;
    float* KVT;
    DI void operator()(const f32x4 (&acc)[2][2][4][2], const Unit& u, int wr, int wc, int fr, int fq) const {
        EPI_LOOP_NAT({ *(f32x4*)(KVT + ((size_t)u.bz * 256 + trow) * 256 + tcol) = v; })
    }
};
struct EpiQK {
    static constexpr bool PERM = true;
    bf16* O; const float* qg; const float* kg; PG8_LAS float* red;
    DI void operator()(const f32x4 (&acc)[2][2][4][2], const Unit& u, int wr, int wc, int fr, int fq) const {
        const int which = u.pn >> 4;
        _Pragma("unroll") for (int ai = 0; ai < 2; ++ai) _Pragma("unroll") for (int m = 0; m < 4; ++m) _Pragma("unroll") for (int bj = 0; bj < 2; ++bj) {
            const f32x4 v0 = acc[ai][bj][m][0], v1 = acc[ai][bj][m][1];
            float s = ((v0[0] * v0[0] + v0[1] * v0[1]) + (v0[2] * v0[2] + v0[3] * v0[3])) + ((v1[0] * v1[0] + v1[1] * v1[1]) + (v1[2] * v1[2] + v1[3] * v1[3]));
            s += __shfl_xor(s, 16); s += __shfl_xor(s, 32);
            if (fq == 0) red[(bj * 256 + ai * HALF + wr * 64 + m * 16 + fr) * 4 + wc] = s; }
        asm volatile("s_waitcnt lgkmcnt(0)" ::: "memory"); __builtin_amdgcn_s_barrier(); asm volatile("" ::: "memory");
        const float* gp = (which ? kg : qg) + wc * 32 + 8 * fq; const f32x4 g0 = *(const f32x4*)gp, g1 = *(const f32x4*)(gp + 4);
        const float sc = which ? 1.f : 0.08838834764831845f * LOG2E;
        EPI_LOOP_PERM({ const f32x4 r4 = *(const PG8_LAS f32x4*)(red + (bj * 256 + trow) * 4);
            const float rs = (1.f / sqrtf(((r4[0] + r4[1]) + (r4[2] + r4[3])) * (1.f / AHD) + EPS)) * sc;
            u32x4 w; w.x = pk2(v0[0] * rs * g0[0], v0[1] * rs * g0[1]); w.y = pk2(v0[2] * rs * g0[2], v0[3] * rs * g0[3]); w.z = pk2(v1[0] * rs * g1[0], v1[1] * rs * g1[1]); w.w = pk2(v1[2] * rs * g1[2], v1[3] * rs * g1[3]);
            *(u32x4*)(O + (size_t)(u.pm * BM + trow) * QKVW + u.pn * BM + tcol) = w; })
    }
};
struct EpiRetOut {
    static constexpr bool PERM = true;
    const bf16* Z; const float* gng; const float* gnb; bf16* YCAT; PG8_LAS float* red;
    DI void operator()(const f32x4 (&acc)[2][2][4][2], const Unit& u, int wr, int wc, int fr, int fq) const {
        const int h = u.bz >> 5, t0 = (u.bz & 31) * 256;
        float mean[2][4], rstd[2][4];
        _Pragma("unroll") for (int ai = 0; ai < 2; ++ai) _Pragma("unroll") for (int m = 0; m < 4; ++m) { float s = 0.f;
            _Pragma("unroll") for (int bj = 0; bj < 2; ++bj) _Pragma("unroll") for (int n = 0; n < 2; ++n) { const f32x4 v = acc[ai][bj][m][n]; s += (v[0] + v[1]) + (v[2] + v[3]); }
            s += __shfl_xor(s, 16); s += __shfl_xor(s, 32);
            if (fq == 0) red[(ai * HALF + wr * 64 + m * 16 + fr) * 4 + wc] = s; }
        asm volatile("s_waitcnt lgkmcnt(0)" ::: "memory"); __builtin_amdgcn_s_barrier(); asm volatile("" ::: "memory");
        _Pragma("unroll") for (int ai = 0; ai < 2; ++ai) _Pragma("unroll") for (int m = 0; m < 4; ++m) { const f32x4 r4 = *(const PG8_LAS f32x4*)(red + (ai * HALF + wr * 64 + m * 16 + fr) * 4);
            mean[ai][m] = ((r4[0] + r4[1]) + (r4[2] + r4[3])) * (1.f / 256.f); }
        _Pragma("unroll") for (int ai = 0; ai < 2; ++ai) _Pragma("unroll") for (int m = 0; m < 4; ++m) { float s = 0.f;
            _Pragma("unroll") for (int bj = 0; bj < 2; ++bj) _Pragma("unroll") for (int n = 0; n < 2; ++n) { const f32x4 v = acc[ai][bj][m][n] - mean[ai][m]; s += (v[0] * v[0] + v[1] * v[1]) + (v[2] * v[2] + v[3] * v[3]); }
            s += __shfl_xor(s, 16); s += __shfl_xor(s, 32);
            if (fq == 0) red[1024 + (ai * HALF + wr * 64 + m * 16 + fr) * 4 + wc] = s; }
        asm volatile("s_waitcnt lgkmcnt(0)" ::: "memory"); __builtin_amdgcn_s_barrier(); asm volatile("" ::: "memory");
        _Pragma("unroll") for (int ai = 0; ai < 2; ++ai) _Pragma("unroll") for (int m = 0; m < 4; ++m) { const f32x4 r4 = *(const PG8_LAS f32x4*)(red + 1024 + (ai * HALF + wr * 64 + m * 16 + fr) * 4);
            rstd[ai][m] = 1.f / sqrtf(((r4[0] + r4[1]) + (r4[2] + r4[3])) * (1.f / 256.f) + EPS); }
        EPI_LOOP_PERM({ const int t = t0 + trow, ch = h * RHD + tcol;
            const f32x4 g0 = *(const f32x4*)(gng + ch), g1 = *(const f32x4*)(gng + ch + 4), b0 = *(const f32x4*)(gnb + ch), b1 = *(const f32x4*)(gnb + ch + 4);
            const u32x4 gz = *(const u32x4*)(Z + (size_t)t * ZW + 3 * RW + ch);
            float gt[8]; gt[0] = bflo(gz.x); gt[1] = bfhi(gz.x); gt[2] = bflo(gz.y); gt[3] = bfhi(gz.y); gt[4] = bflo(gz.z); gt[5] = bfhi(gz.z); gt[6] = bflo(gz.w); gt[7] = bfhi(gz.w);
            float y[8];
            _Pragma("unroll") for (int e = 0; e < 8; ++e) { const float v = e < 4 ? v0[e & 3] : v1[e & 3]; const float gg = e < 4 ? g0[e & 3] : g1[e & 3]; const float bb = e < 4 ? b0[e & 3] : b1[e & 3];
                y[e] = ((v - mean[ai][m]) * rstd[ai][m] * gg + bb) * (gt[e] * sigmoidf_(gt[e])); }
            if (FP8_EWO) { u32x2 w8; w8.x = pk4_fp8(y[0], y[1], y[2], y[3]); w8.y = pk4_fp8(y[4], y[5], y[6], y[7]); *(u32x2*)((unsigned char*)YCAT + (size_t)t * D + S5W + ch) = w8; }
            else { u32x4 w; w.x = pk2(y[0], y[1]); w.y = pk2(y[2], y[3]); w.z = pk2(y[4], y[5]); w.w = pk2(y[6], y[7]);
            *(u32x4*)(YCAT + (size_t)t * D + S5W + ch) = w; } })
    }
};
struct EpiTopk {
    static constexpr bool PERM = false;
    int* EIDX; float* GATE; PG8_LAS unsigned char* lds;
    DI void operator()(const f32x4 (&acc)[2][2][4][2], const Unit& u, int wr, int wc, int fr, int fq) const {
        const int lane = fq * 16 + fr, wave = wr * 4 + wc;
        PG8_LAS float* tile = (PG8_LAS float*)lds; PG8_LAS float* scr = (PG8_LAS float*)(lds + 131072 + wave * 1024);
        asm volatile("s_waitcnt vmcnt(0)" ::: "memory");
        _Pragma("unroll") for (int ai = 0; ai < 2; ++ai) {
            asm volatile("s_waitcnt lgkmcnt(0)" ::: "memory"); __builtin_amdgcn_s_barrier(); asm volatile("" ::: "memory");
            _Pragma("unroll") for (int m = 0; m < 4; ++m) _Pragma("unroll") for (int bj = 0; bj < 2; ++bj) _Pragma("unroll") for (int n = 0; n < 2; ++n) {
                const int row = wr * 64 + m * 16 + fr, c4 = (bj * HALF + wc * 32 + 16 * n + 4 * fq) >> 2;
                *(PG8_LAS f32x4*)(tile + row * 256 + ((c4 ^ (row & 15)) << 2)) = acc[ai][bj][m][n]; }
            asm volatile("s_waitcnt lgkmcnt(0)" ::: "memory"); __builtin_amdgcn_s_barrier(); asm volatile("" ::: "memory");
            _Pragma("unroll 1") for (int rr = 0; rr < 16; ++rr) { const int row = wave * 16 + rr; const PG8_LAS float* rp = tile + row * 256; const int sw = row & 15, l4 = lane >> 2, l0 = lane & 3;
                const float a0 = rp[((l4 ^ sw) << 2) + l0], a1 = rp[(((16 + l4) ^ sw) << 2) + l0], b0 = rp[(((32 + l4) ^ sw) << 2) + l0], b1 = rp[(((48 + l4) ^ sw) << 2) + l0];
                peer_topk_process(a0, a1, b0, b1, EIDX, GATE, scr, (u.pm * BM + ai * HALF + row) * 8 + u.pn, lane); }
        }
    }
};
}

struct Args { const float* in[32]; float* out; unsigned char* ws; int ph_lo, ph_hi; };
enum { I_X = 0, I_EVG, I_EWIN, I_S5LS, I_S5ARE, I_S5AIM, I_S5BRE, I_S5BIM, I_S5CRE, I_S5CIM, I_S5D, I_GLUW, I_GLUB, I_GNG, I_GNB, I_EWOUT,
       I_ODG, I_OWIN, I_QNG, I_KNG, I_LQ1, I_LK1, I_LQ2, I_LK2, I_SUBG, I_OWOUT, I_RELB, I_FFNG, I_PWQ, I_PKEYS, I_PU, I_PV };

struct PA { const Args& k; unsigned char* ws; float* out; };
DI const float* inp(const PA& a, int i) { asm volatile("" : "+s"(i)); return a.k.in[i]; }

DI void transpose_item(const float* W, int K, int N, bf16* WT, const float* gain, LAS float* scr, int item, int lane) {
    const int nblk = N / 32, kb = item / nblk, nb = item % nblk, k0 = 64 * kb, n0 = 32 * nb;
#pragma unroll 8
    for (int i = 0; i < 32; ++i) { const int kk = 2 * i + (lane >> 5); float v = W[(size_t)(k0 + kk) * N + n0 + (lane & 31)]; if (gain) v *= gain[k0 + kk]; scr[kk * 33 + (lane & 31)] = v; }
    asm volatile("s_waitcnt lgkmcnt(0)" ::: "memory");
    const int c = lane & 7;
#pragma unroll
    for (int j = 0; j < 4; ++j) { const int n = (lane >> 3) + 8 * j; const LAS float* s = scr + (8 * c) * 33 + n;
        u32x4 o; o.x = pk2(s[0 * 33], s[1 * 33]); o.y = pk2(s[2 * 33], s[3 * 33]); o.z = pk2(s[4 * 33], s[5 * 33]); o.w = pk2(s[6 * 33], s[7 * 33]);
        *(u32x4*)(WT + (size_t)(n0 + n) * K + k0 + 8 * c) = o; }
    asm volatile("s_waitcnt lgkmcnt(0)" ::: "memory");
}
DI void transpose_item8(const float* W, int K, int N, unsigned char* WT, LAS float* scr, int item, int lane, int roff = 0) {
    const int nblk = N / 32, kb = item / nblk, nb = item % nblk, k0 = 64 * kb, n0 = 32 * nb;
#pragma unroll 8
    for (int i = 0; i < 32; ++i) { const int kk = 2 * i + (lane >> 5); scr[kk * 33 + (lane & 31)] = W[(size_t)(k0 + kk) * N + n0 + (lane & 31)] * 256.f; }
    asm volatile("s_waitcnt lgkmcnt(0)" ::: "memory");
    const int c = lane & 7;
#pragma unroll
    for (int j = 0; j < 4; ++j) { const int n = (lane >> 3) + 8 * j; const LAS float* sp = scr + (8 * c) * 33 + n;
        u32x2 o; o.x = pk4_fp8(sp[0 * 33], sp[1 * 33], sp[2 * 33], sp[3 * 33]); o.y = pk4_fp8(sp[4 * 33], sp[5 * 33], sp[6 * 33], sp[7 * 33]);
        *(u32x2*)(WT + (size_t)(n0 + n + roff) * K + k0 + 8 * c) = o; }
    asm volatile("s_waitcnt lgkmcnt(0)" ::: "memory");
}
DI void rms_row8(const float* xrow, const float* g, unsigned char* orow, int lane) {
    const f32x4* xr = (const f32x4*)xrow + lane; const f32x4* gr = (const f32x4*)g + lane;
    f32x4 v[16]; float s = 0.f;
#pragma unroll
    for (int j = 0; j < 16; ++j) { v[j] = xr[64 * j]; s += (v[j].x * v[j].x + v[j].y * v[j].y) + (v[j].z * v[j].z + v[j].w * v[j].w); }
    const float rstd = 1.f / sqrtf(wave_sum(s) * (1.f / D) + EPS);
    unsigned* o4 = (unsigned*)orow + lane;
#pragma unroll
    for (int j = 0; j < 16; ++j) { const f32x4 gg = gr[64 * j]; o4[64 * j] = pk4_fp8(v[j].x * rstd * gg.x, v[j].y * rstd * gg.y, v[j].z * rstd * gg.z, v[j].w * rstd * gg.w); }
}
DI void rms_row(const float* xrow, const float* g, bf16* orow, int lane) {
    const f32x4* xr = (const f32x4*)xrow + lane; const f32x4* gr = (const f32x4*)g + lane;
    f32x4 v[16]; float s = 0.f;
#pragma unroll
    for (int j = 0; j < 16; ++j) { v[j] = xr[64 * j]; s += (v[j].x * v[j].x + v[j].y * v[j].y) + (v[j].z * v[j].z + v[j].w * v[j].w); }
    const float rstd = 1.f / sqrtf(wave_sum(s) * (1.f / D) + EPS);
    u32x2* o8 = (u32x2*)orow + lane;
#pragma unroll
    for (int j = 0; j < 16; ++j) { const f32x4 gg = gr[64 * j]; u32x2 w; w.x = pk2(v[j].x * rstd * gg.x, v[j].y * rstd * gg.y); w.y = pk2(v[j].z * rstd * gg.z, v[j].w * rstd * gg.w); o8[64 * j] = w; }
}
DI void rms_row_both(const float* xrow, const float* g, bf16* orow, unsigned char* o8row, int lane) {
    const f32x4* xr = (const f32x4*)xrow + lane; const f32x4* gr = (const f32x4*)g + lane;
    f32x4 v[16]; float s = 0.f;
#pragma unroll
    for (int j = 0; j < 16; ++j) { v[j] = xr[64 * j]; s += (v[j].x * v[j].x + v[j].y * v[j].y) + (v[j].z * v[j].z + v[j].w * v[j].w); }
    const float rstd = 1.f / sqrtf(wave_sum(s) * (1.f / D) + EPS);
    u32x2* o8 = (u32x2*)orow + lane; unsigned* o4 = (unsigned*)o8row + lane;
#pragma unroll
    for (int j = 0; j < 16; ++j) { const f32x4 gg = gr[64 * j]; const float y0 = v[j].x * rstd * gg.x, y1 = v[j].y * rstd * gg.y, y2 = v[j].z * rstd * gg.z, y3 = v[j].w * rstd * gg.w;
        u32x2 w; w.x = pk2(y0, y1); w.y = pk2(y2, y3); o8[64 * j] = w; o4[64 * j] = pk4_fp8(y0, y1, y2, y3); }
}
DI void rms_phase(const float* x, const float* g, bf16* H, int gw, int ngw, int lane) {
    for (int m = gw; m < T; m += ngw) rms_row(x + (size_t)m * D, g, H + (size_t)m * D, lane);
}

DI void s5_build(const PA& a, LAS unsigned char* lds, int g, int tid) {
    LAS float* lam = (LAS float*)lds;
    LAS float* ang = lam + 64;
    LAS float* fre = ang + 64; LAS float* fim = fre + 64;
    LAS float* bbr = fim + 64; LAS float* bbi = bbr + 1024;
    LAS float* ccr = bbi + 1024; LAS float* cci = ccr + 1024;
    LAS float* pwr = cci + 1024; LAS float* pwi = pwr + 33 * 64;
    LAS float* km = pwi + 33 * 64;
    bf16* BT13 = (bf16*)(a.ws + WS_BT13) + (size_t)g * 512 * UCLD; bf16* BTE = (bf16*)(a.ws + WS_BTE) + (size_t)g * 256 * 512;
    float* PW32 = (float*)(a.ws + WS_PW32) + (size_t)g * 128;
    __syncthreads();
    if (tid < 64) { const int p = tid; const float step = expf(inp(a, I_S5LS)[g]); const float lr = inp(a, I_S5ARE)[g * 64 + p], li = inp(a, I_S5AIM)[g * 64 + p];
        const float mag = expf(lr * step), ar = mag * cosf(li * step), ai = mag * sinf(li * step), den = lr * lr + li * li, nr = ar - 1.f;
        lam[p] = lr * step; ang[p] = li * step; fre[p] = (nr * lr + ai * li) / den; fim[p] = (ai * lr - nr * li) / den; }
    __syncthreads();
    for (int i = tid; i < 1024; i += 512) { const int p = i >> 4; const float br = inp(a, I_S5BRE)[(size_t)g * 1024 + i], bi = inp(a, I_S5BIM)[(size_t)g * 1024 + i];
        bbr[i] = fre[p] * br - fim[p] * bi; bbi[i] = fre[p] * bi + fim[p] * br;
        ccr[i] = inp(a, I_S5CRE)[(size_t)g * 1024 + i]; cci[i] = inp(a, I_S5CIM)[(size_t)g * 1024 + i]; }
    for (int i = tid; i < 33 * 64; i += 512) { const int tau = i >> 6, p = i & 63; const float m = expf(lam[p] * (float)tau), an = ang[p] * (float)tau; pwr[i] = m * cosf(an); pwi[i] = m * sinf(an); }
    __syncthreads();
    if (tid < 64) { PW32[tid] = pwr[32 * 64 + tid]; PW32[64 + tid] = pwi[32 * 64 + tid]; }
    for (int i = tid; i < 8192; i += 512) { const int tau = i >> 8, c2 = (i >> 4) & 15, c = i & 15; float s = 0.f;
        for (int p = 0; p < 64; ++p) { const float cr = ccr[c2 * 64 + p], ci = cci[c2 * 64 + p], pr = pwr[tau * 64 + p], pi = pwi[tau * 64 + p];
            const float wr_ = cr * pr - ci * pi, wi_ = cr * pi + ci * pr; s += wr_ * bbr[p * 16 + c] - wi_ * bbi[p * 16 + c]; }
        km[i] = s; }
    __syncthreads();
    for (int q = tid; q < 512 * 80; q += 512) { const int row = q / 80, col0 = (q % 80) * 8, t = row >> 4, c2 = row & 15; float v[8];
        if (col0 < 512) { const int j = col0 >> 4, c0 = col0 & 15, tau = t - j;
#pragma unroll
            for (int e = 0; e < 8; ++e) v[e] = tau >= 0 ? km[tau * 256 + c2 * 16 + c0 + e] : 0.f; }
        else {
#pragma unroll
            for (int e = 0; e < 8; ++e) { const int pp = col0 - 512 + e, p = pp & 63; const float cr = ccr[c2 * 64 + p], ci = cci[c2 * 64 + p], pr = pwr[(t + 1) * 64 + p], pi = pwi[(t + 1) * 64 + p];
                v[e] = pp < 64 ? (cr * pr - ci * pi) : -(cr * pi + ci * pr); } }
        u32x4 w; w.x = pk2(v[0], v[1]); w.y = pk2(v[2], v[3]); w.z = pk2(v[4], v[5]); w.w = pk2(v[6], v[7]);
        *(u32x4*)(BT13 + (size_t)row * UCLD + col0) = w; }
    for (int q = tid; q < 256 * 64; q += 512) { const int row = q >> 6, col0 = (q & 63) * 8, j = col0 >> 4, c0 = col0 & 15; float v[8];
        if (row < 128) { const int p = row & 63, ri = row >> 6; const float pr = pwr[(31 - j) * 64 + p], pi = pwi[(31 - j) * 64 + p];
#pragma unroll
            for (int e = 0; e < 8; ++e) { const float br = bbr[p * 16 + c0 + e], bi = bbi[p * 16 + c0 + e]; v[e] = ri == 0 ? (pr * br - pi * bi) : (pr * bi + pi * br); } }
        else {
#pragma unroll
            for (int e = 0; e < 8; ++e) v[e] = 0.f; }
        u32x4 w; w.x = pk2(v[0], v[1]); w.y = pk2(v[2], v[3]); w.z = pk2(v[4], v[5]); w.w = pk2(v[6], v[7]);
        *(u32x4*)(BTE + (size_t)row * 512 + col0) = w; }
    __syncthreads();
}

DI void s5_scan(const PA& a, LAS unsigned char* lds, int g, int tid) {
    const int p = tid & 63, seg = tid >> 6;
    const float* E = (const float*)(a.ws + WS_E) + ((size_t)(g * S5NC + seg * 32)) * 128 + p;
    const float* PW32 = (const float*)(a.ws + WS_PW32) + (size_t)g * 128;
    bf16* UC = (bf16*)(a.ws + WS_UC) + ((size_t)(g * S5NC + seg * 32)) * UCLD + 512 + p;
    LAS float* se = (LAS float*)lds;
    const float Ar = PW32[p], Ai = PW32[64 + p];
    float er[32], ei[32];
#pragma unroll
    for (int k = 0; k < 32; ++k) { er[k] = E[(size_t)k * 128]; ei[k] = E[(size_t)k * 128 + 64]; }
    float sr = 0.f, si = 0.f;
#pragma unroll
    for (int k = 0; k < 32; ++k) { const float nr = Ar * sr - Ai * si + er[k], ni = Ar * si + Ai * sr + ei[k]; sr = nr; si = ni; }
    __syncthreads();
    se[(seg * 64 + p) * 2] = sr; se[(seg * 64 + p) * 2 + 1] = si;
    float Pr = Ar, Pi = Ai;
#pragma unroll
    for (int k = 0; k < 5; ++k) { const float nr = Pr * Pr - Pi * Pi, ni = 2.f * Pr * Pi; Pr = nr; Pi = ni; }
    __syncthreads();
    float cr = 0.f, ci = 0.f;
    for (int s2 = 0; s2 < seg; ++s2) { const float xr = se[(s2 * 64 + p) * 2], xi = se[(s2 * 64 + p) * 2 + 1]; const float nr = Pr * cr - Pi * ci + xr, ni = Pr * ci + Pi * cr + xi; cr = nr; ci = ni; }
#pragma unroll
    for (int k = 0; k < 32; ++k) { UC[(size_t)k * UCLD] = (bf16)(pk2(cr, 0.f) & 0xffffu); UC[(size_t)k * UCLD + 64] = (bf16)(pk2(ci, 0.f) & 0xffffu);
        const float nr = Ar * cr - Ai * ci + er[k], ni = Ar * ci + Ai * cr + ei[k]; cr = nr; ci = ni; }
    __syncthreads();
}

DI void v_transpose_tile(const bf16* Vsrc, int ld, bf16* dst, int dpitch, int t0, int c0, LAS unsigned char* lds, int tid) {
    LAS bf16* tile = (LAS bf16*)lds;
    __syncthreads();
#pragma unroll
    for (int i = 0; i < 4; ++i) { const int q = tid + 512 * i, tt = q >> 5, d0 = (q & 31) * 8; const u32x4 v = *(const u32x4*)(Vsrc + (size_t)(t0 + tt) * ld + d0);
        tile[(d0 + 0) * 72 + tt] = (bf16)(v.x & 0xffffu); tile[(d0 + 1) * 72 + tt] = (bf16)(v.x >> 16); tile[(d0 + 2) * 72 + tt] = (bf16)(v.y & 0xffffu); tile[(d0 + 3) * 72 + tt] = (bf16)(v.y >> 16);
        tile[(d0 + 4) * 72 + tt] = (bf16)(v.z & 0xffffu); tile[(d0 + 5) * 72 + tt] = (bf16)(v.z >> 16); tile[(d0 + 6) * 72 + tt] = (bf16)(v.w & 0xffffu); tile[(d0 + 7) * 72 + tt] = (bf16)(v.w >> 16); }
    __syncthreads();
#pragma unroll
    for (int i = 0; i < 4; ++i) { const int q = tid + 512 * i, dv = q >> 3, cc = q & 7; const u32x4 v = *(const LAS u32x4*)(tile + dv * 72 + cc * 8);
        *(u32x4*)(dst + (size_t)dv * dpitch + c0 + cc * 8) = v; }
}

DI void ret_prep_item(const PA& a, LAS unsigned char* lds, int item, int tid) {
    const int h = item & 7, t0 = (item >> 3) * 64, ch = t0 >> 8, jl0 = t0 & 255, bz = h * 32 + ch;
    const bf16* Z = (const bf16*)(a.ws + WS_Z); bf16* QR = (bf16*)(a.ws + WS_QR); bf16* KR = (bf16*)(a.ws + WS_KR);
    bf16* SQ = (bf16*)(a.ws + WS_SQ) + (size_t)bz * 256 * 512; bf16* VS = (bf16*)(a.ws + WS_VS) + (size_t)bz * 256 * 512; bf16* KDT = (bf16*)(a.ws + WS_KDT) + (size_t)h * RHD * T;
    LAS bf16* tile = (LAS bf16*)lds;
    const float lg2 = log2f(1.f - exp2f(-5.f - (float)h));
    __syncthreads();
#pragma unroll
    for (int i = 0; i < 2; ++i) { const int q = tid + 512 * i, tt = q >> 4, i0 = (q & 15) * 8, t = t0 + tt, jl = jl0 + tt;
        const float qdec = __builtin_amdgcn_exp2f(lg2 * (float)(jl + 1)), kdec = __builtin_amdgcn_exp2f(lg2 * (float)(255 - jl));
        float cs[8], sn[8];
#pragma unroll
        for (int e = 0; e < 8; ++e) { const float fr_ = expf(-(float)(i0 + e) * (9.210340371976184f / 128.f));
            const float rev = __builtin_amdgcn_fractf((float)t * fr_ * 0.15915494309189535f); sn[e] = __builtin_amdgcn_sinf(rev); cs[e] = __builtin_amdgcn_cosf(rev); }
#pragma unroll
        for (int which = 0; which < 2; ++which) { const bf16* src = Z + (size_t)t * ZW + which * RW + h * RHD + i0; bf16* dst = (which ? KR : QR) + (size_t)t * RW + h * RHD + i0; const float sc = which ? 0.0625f : 1.f;
            const u32x4 x1 = *(const u32x4*)src, x2 = *(const u32x4*)(src + 128); float a1[8], a2[8];
            a1[0] = bflo(x1.x); a1[1] = bfhi(x1.x); a1[2] = bflo(x1.y); a1[3] = bfhi(x1.y); a1[4] = bflo(x1.z); a1[5] = bfhi(x1.z); a1[6] = bflo(x1.w); a1[7] = bfhi(x1.w);
            a2[0] = bflo(x2.x); a2[1] = bfhi(x2.x); a2[2] = bflo(x2.y); a2[3] = bfhi(x2.y); a2[4] = bflo(x2.z); a2[5] = bfhi(x2.z); a2[6] = bflo(x2.w); a2[7] = bfhi(x2.w);
            float o1[8], o2[8];
#pragma unroll
            for (int e = 0; e < 8; ++e) { o1[e] = (a1[e] * cs[e] - a2[e] * sn[e]) * sc; o2[e] = (a1[e] * sn[e] + a2[e] * cs[e]) * sc; }
            u32x4 w1, w2; w1.x = pk2(o1[0], o1[1]); w1.y = pk2(o1[2], o1[3]); w1.z = pk2(o1[4], o1[5]); w1.w = pk2(o1[6], o1[7]);
            w2.x = pk2(o2[0], o2[1]); w2.y = pk2(o2[2], o2[3]); w2.z = pk2(o2[4], o2[5]); w2.w = pk2(o2[6], o2[7]);
            *(u32x4*)dst = w1; *(u32x4*)(dst + 128) = w2;
            if (which == 0) { u32x4 d1, d2; d1.x = pk2(o1[0] * qdec, o1[1] * qdec); d1.y = pk2(o1[2] * qdec, o1[3] * qdec); d1.z = pk2(o1[4] * qdec, o1[5] * qdec); d1.w = pk2(o1[6] * qdec, o1[7] * qdec);
                d2.x = pk2(o2[0] * qdec, o2[1] * qdec); d2.y = pk2(o2[2] * qdec, o2[3] * qdec); d2.z = pk2(o2[4] * qdec, o2[5] * qdec); d2.w = pk2(o2[6] * qdec, o2[7] * qdec);
                bf16* sq = SQ + (size_t)jl * 512 + 256 + i0; *(u32x4*)sq = d1; *(u32x4*)(sq + 128) = d2; }
            else {
#pragma unroll
                for (int e = 0; e < 8; e += 2) { const unsigned p1 = pk2(o1[e] * kdec, o1[e + 1] * kdec), p2 = pk2(o2[e] * kdec, o2[e + 1] * kdec);
                    tile[(i0 + e) * 72 + tt] = (bf16)(p1 & 0xffffu); tile[(i0 + e + 1) * 72 + tt] = (bf16)(p1 >> 16); tile[(128 + i0 + e) * 72 + tt] = (bf16)(p2 & 0xffffu); tile[(128 + i0 + e + 1) * 72 + tt] = (bf16)(p2 >> 16); } } } }
    __syncthreads();
#pragma unroll
    for (int i = 0; i < 4; ++i) { const int q = tid + 512 * i, d = q >> 3, cc = q & 7; const u32x4 v = *(const LAS u32x4*)(tile + d * 72 + cc * 8);
        *(u32x4*)(KDT + (size_t)d * T + t0 + cc * 8) = v; }
    v_transpose_tile(Z + 2 * RW + h * RHD, ZW, VS, 512, t0, jl0, lds, tid);
}

DI void ret_prefix(const PA& a, int e4) {
    const int h = e4 >> 14, rem = e4 & 16383, dv = rem >> 6, dk4 = (rem & 63) * 4;
    const float* KVT = (const float*)(a.ws + WS_KVT) + ((size_t)(h * 32) * 256 + dv) * 256 + dk4;
    bf16* VS = (bf16*)(a.ws + WS_VS) + ((size_t)(h * 32) * 256 + dv) * 512 + 256 + dk4;
    const float g = 1.f - exp2f(-5.f - (float)h), g256 = exp2f(256.f * log2f(g));
    f32x4 st = {0.f, 0.f, 0.f, 0.f};
#pragma unroll 1
    for (int c0 = 0; c0 < 32; c0 += 8) { f32x4 kv[8];
#pragma unroll
        for (int c = 0; c < 8; ++c) kv[c] = *(const f32x4*)(KVT + (size_t)(c0 + c) * 65536);
#pragma unroll
        for (int c = 0; c < 8; ++c) { u32x2 w; w.x = pk2(st[0], st[1]); w.y = pk2(st[2], st[3]); *(u32x2*)(VS + (size_t)(c0 + c) * 131072) = w; st = st * g256 + kv[c]; } }
}

DI void attn_prep_item(const PA& a, LAS unsigned char* lds, int item, int tid) {
    const int h = item & 15, t0 = (item >> 4) * 64, lane = tid & 63, wave = tid >> 6;
    bf16* QKV = (bf16*)(a.ws + WS_QKV); bf16* VT1 = (bf16*)(a.ws + WS_VT1);
    const int l16 = lane & 15, sub = lane >> 4;
    const f32x4 qg0 = *(const f32x4*)(inp(a, I_QNG) + l16 * 8), qg1 = *(const f32x4*)(inp(a, I_QNG) + l16 * 8 + 4), kg0 = *(const f32x4*)(inp(a, I_KNG) + l16 * 8), kg1 = *(const f32x4*)(inp(a, I_KNG) + l16 * 8 + 4);
    for (int it = 0; it < 8; ++it) { const int rr = it * 32 + wave * 4 + sub;
        const int tt = rr >> 2, which = (rr >> 1) & 1, mm = rr & 1;
        bf16* p = QKV + (size_t)(t0 + tt) * QKVW + which * D + (h * 2 + mm) * AHD + l16 * 8;
        const u32x4 x = *(const u32x4*)p; float v[8];
        v[0] = bflo(x.x); v[1] = bfhi(x.x); v[2] = bflo(x.y); v[3] = bfhi(x.y); v[4] = bflo(x.z); v[5] = bfhi(x.z); v[6] = bflo(x.w); v[7] = bfhi(x.w);
        float s = 0.f;
#pragma unroll
        for (int e = 0; e < 8; ++e) s += v[e] * v[e];
        s += __shfl_xor(s, 1); s += __shfl_xor(s, 2); s += __shfl_xor(s, 4); s += __shfl_xor(s, 8);
        const float rs = (1.f / sqrtf(s * (1.f / AHD) + EPS)) * (which ? 1.f : 0.08838834764831845f * LOG2E);
        const f32x4 g0 = which ? kg0 : qg0, g1 = which ? kg1 : qg1;
        u32x4 w; w.x = pk2(v[0] * rs * g0[0], v[1] * rs * g0[1]); w.y = pk2(v[2] * rs * g0[2], v[3] * rs * g0[3]); w.z = pk2(v[4] * rs * g1[0], v[5] * rs * g1[1]); w.w = pk2(v[6] * rs * g1[2], v[7] * rs * g1[3]);
        *(u32x4*)p = w; }
    v_transpose_tile(QKV + 2 * D + h * AVD, QKVW, VT1 + (size_t)h * AVD * T, T, t0, t0, lds, tid);
}

template <int DQK, int MODE, int NDT, bool PF>
DI void flash_pass(LAS unsigned char* lds, const bf16* Qu, const int ldq, const bf16* Ku, const int ldk, const bf16* VTh, const int dvoff, const int qw0, const int qwl, const int nkt,
                   const float lg2, const LAS float* btab, f32x16 (&O)[NDT], float& l_out) {
    constexpr int KPB = (DQK + 8) * 2, VT_OFF = 64 * KPB, VPB = 136, CPR = DQK / 8, NKI = (64 * CPR) / 512;
    int tid = threadIdx.x; asm volatile("" : "+v"(tid));
    const int lane = tid & 63, r = lane & 31, h = lane >> 5;
    bf16x8 qf[DQK / 16];
    { const unsigned qoff = (unsigned)(r * ldq + 8 * h) * 2u;
#pragma unroll
      for (int s = 0; s < DQK / 16; ++s) qf[s] = *(const bf16x8*)((const char*)Qu + qoff + 32 * s); }
#pragma unroll
    for (int dt = 0; dt < NDT; ++dt)
#pragma unroll
        for (int i = 0; i < 16; ++i) O[dt][i] = 0.f;
    float m_run = -1e30f, l_run = 0.f;
    const int qi = qwl + r;
    const unsigned kgo = (unsigned)((tid / CPR) * ldk + (tid % CPR) * 8) * 2u, klo = (unsigned)((tid / CPR) * KPB + (tid % CPR) * 16);
    const unsigned vgo = (unsigned)((tid >> 3) * T + (tid & 7) * 8) * 2u, vlo = (unsigned)(VT_OFF + (tid >> 3) * VPB + (tid & 7) * 16);
    const unsigned ka = (unsigned)(r * KPB + 16 * h), va_ = (unsigned)(VT_OFF + (dvoff + r) * VPB + 8 * h);
    const __amdgpu_buffer_rsrc_t krs = __builtin_amdgcn_make_buffer_rsrc((void*)Ku, 0, 0x7ffffff0, 0x00020000);
    const __amdgpu_buffer_rsrc_t vrs = __builtin_amdgcn_make_buffer_rsrc((void*)VTh, 0, 0x7ffffff0, 0x00020000);
    u32x4 kreg[NKI], vreg[4];
    if (PF) {
#pragma unroll
        for (int i = 0; i < NKI; ++i) kreg[i] = __builtin_amdgcn_raw_buffer_load_b128(krs, kgo, (i * (512 / CPR)) * ldk * 2, 0);
#pragma unroll
        for (int i = 0; i < 4; ++i) vreg[i] = __builtin_amdgcn_raw_buffer_load_b128(vrs, vgo, i * 64 * T * 2, 0);
    }
    for (int kt = 0; kt < nkt; ++kt) {
        const int k0 = kt * 64;
        __syncthreads();
        if (!PF) {
#pragma unroll
            for (int i = 0; i < NKI; ++i) { const u32x4 v = __builtin_amdgcn_raw_buffer_load_b128(krs, kgo, (k0 + i * (512 / CPR)) * ldk * 2, 0); *(LAS u32x4*)(lds + klo + i * (512 / CPR) * KPB) = v; }
#pragma unroll
            for (int i = 0; i < 4; ++i) { const u32x4 v = __builtin_amdgcn_raw_buffer_load_b128(vrs, vgo, k0 * 2 + i * 64 * T * 2, 0); LAS u32x2* d = (LAS u32x2*)(lds + vlo + i * 64 * VPB);
                u32x2 lo; lo.x = v.x; lo.y = v.y; u32x2 hi; hi.x = v.z; hi.y = v.w; d[0] = lo; d[1] = hi; }
        } else {
#pragma unroll
            for (int i = 0; i < NKI; ++i) *(LAS u32x4*)(lds + klo + i * (512 / CPR) * KPB) = kreg[i];
#pragma unroll
            for (int i = 0; i < 4; ++i) { LAS u32x2* d = (LAS u32x2*)(lds + vlo + i * 64 * VPB);
                u32x2 lo; lo.x = vreg[i].x; lo.y = vreg[i].y; u32x2 hi; hi.x = vreg[i].z; hi.y = vreg[i].w; d[0] = lo; d[1] = hi; }
        }
        __syncthreads();
        if (PF && kt + 1 < nkt) {
#pragma unroll
            for (int i = 0; i < NKI; ++i) kreg[i] = __builtin_amdgcn_raw_buffer_load_b128(krs, kgo, (k0 + 64 + i * (512 / CPR)) * ldk * 2, 0);
#pragma unroll
            for (int i = 0; i < 4; ++i) vreg[i] = __builtin_amdgcn_raw_buffer_load_b128(vrs, vgo, (k0 + 64) * 2 + i * 64 * T * 2, 0);
        }
        if (k0 <= qw0 + 31) {
            f32x16 st0, st1;
#pragma unroll
            for (int i = 0; i < 16; ++i) { st0[i] = 0.f; st1[i] = 0.f; }
#pragma unroll
            for (int s = 0; s < DQK / 16; ++s) {
                const bf16x8 a0 = *(const LAS bf16x8*)(lds + ka + 32 * s);
                const bf16x8 a1 = *(const LAS bf16x8*)(lds + ka + 32 * KPB + 32 * s);
                st0 = __builtin_amdgcn_mfma_f32_32x32x16_bf16(a0, qf[s], st0, 0, 0, 0);
                st1 = __builtin_amdgcn_mfma_f32_32x32x16_bf16(a1, qf[s], st1, 0, 0, 0);
                if ((s & 3) == 3) __builtin_amdgcn_sched_barrier(0);
            }
            const int dbase = qi - k0 - 4 * h;
            if (MODE == 0) {
#pragma unroll
                for (int i = 0; i < 16; ++i) { const int d0 = dbase - ((i & 3) + 8 * (i >> 2)), d1 = d0 - 32;
                    const float e0 = __builtin_amdgcn_exp2f(lg2 * (float)d0), e1 = __builtin_amdgcn_exp2f(lg2 * (float)d1);
                    st0[i] = d0 >= 0 ? st0[i] * e0 : 0.f; st1[i] = d1 >= 0 ? st1[i] * e1 : 0.f; }
            } else {
                if (k0 + 63 + 127 <= qw0) { const float c = btab[96 + 127];
#pragma unroll
                    for (int i = 0; i < 16; ++i) { st0[i] += c; st1[i] += c; } }
                else {
#pragma unroll
                    for (int i = 0; i < 16; ++i) { const int d0 = dbase - ((i & 3) + 8 * (i >> 2)) + 96, d1 = d0 - 32;
                        const float b0 = btab[d0 > 223 ? 223 : d0], b1 = btab[d1 > 223 ? 223 : d1];
                        st0[i] += b0; st1[i] += b1; } }
                float mx = fmaxf(st0[0], st1[0]);
#pragma unroll
                for (int i = 1; i < 16; ++i) mx = fmaxf(mx, fmaxf(st0[i], st1[i]));
                mx = fmaxf(mx, __shfl_xor(mx, 32));
                const float m_new = fmaxf(m_run, mx), alpha = __builtin_amdgcn_exp2f(m_run - m_new); m_run = m_new;
                float ps = 0.f;
#pragma unroll
                for (int i = 0; i < 16; ++i) { st0[i] = __builtin_amdgcn_exp2f(st0[i] - m_new); st1[i] = __builtin_amdgcn_exp2f(st1[i] - m_new); ps += st0[i] + st1[i]; }
                ps += __shfl_xor(ps, 32);
                l_run = l_run * alpha + ps;
#pragma unroll
                for (int dt = 0; dt < NDT; ++dt)
#pragma unroll
                    for (int i = 0; i < 16; ++i) O[dt][i] *= alpha;
            }
            __builtin_amdgcn_sched_barrier(0);
#pragma unroll
            for (int mt = 0; mt < 2; ++mt)
#pragma unroll
                for (int s2 = 0; s2 < 2; ++s2) {
                    u32x4 pw;
                    if (mt == 0) { pw.x = pk2(st0[8 * s2 + 0], st0[8 * s2 + 1]); pw.y = pk2(st0[8 * s2 + 2], st0[8 * s2 + 3]); pw.z = pk2(st0[8 * s2 + 4], st0[8 * s2 + 5]); pw.w = pk2(st0[8 * s2 + 6], st0[8 * s2 + 7]); }
                    else         { pw.x = pk2(st1[8 * s2 + 0], st1[8 * s2 + 1]); pw.y = pk2(st1[8 * s2 + 2], st1[8 * s2 + 3]); pw.z = pk2(st1[8 * s2 + 4], st1[8 * s2 + 5]); pw.w = pk2(st1[8 * s2 + 6], st1[8 * s2 + 7]); }
                    const bf16x8 pb = __builtin_bit_cast(bf16x8, pw);
#pragma unroll
                    for (int dt = 0; dt < NDT; ++dt) {
                        const LAS unsigned char* vp = lds + va_ + (32 * dt) * VPB + (32 * mt + 16 * s2) * 2;
                        const s16x4 lo = *(const LAS s16x4*)vp, hi = *(const LAS s16x4*)(vp + 16);
                        const bf16x8 va = __builtin_shufflevector(lo, hi, 0, 1, 2, 3, 4, 5, 6, 7);
                        O[dt] = __builtin_amdgcn_mfma_f32_32x32x16_bf16(va, pb, O[dt], 0, 0, 0);
                        if ((dt & 3) == 3) __builtin_amdgcn_sched_barrier(0);
                    }
                }
        }
    }
    l_out = l_run;
}
constexpr int FL_SCR_OFF = 64 * (256 + 8) * 2 + 256 * 136;

namespace dfa {
constexpr int KB0 = 0, VB0 = 16384, KB1 = 49152, VB1 = 65536, BT_OFF = 98304, XM_OFF = 99328, XP_OFF = 101376;
DI void dma16(const __amdgpu_buffer_rsrc_t rs, const unsigned voff, const unsigned soff, LAS unsigned char* ldst) { __builtin_amdgcn_raw_ptr_buffer_load_lds(rs, (LAS void*)ldst, 16, (int)voff, (int)soff, 0, 0); }
DI void stage_k(LAS unsigned char* lds, const int KB, const __amdgpu_buffer_rsrc_t rs, const unsigned soff, const unsigned (&ko)[2], int wave) {
#pragma unroll
    for (int i = 0; i < 2; ++i) dma16(rs, ko[i], soff, lds + KB + (2 * wave + i) * 1024);
}
DI void stage_v(LAS unsigned char* lds, const int VB, const __amdgpu_buffer_rsrc_t rs, const unsigned soff, const unsigned (&vo)[4], int wave) {
#pragma unroll
    for (int i = 0; i < 4; ++i) dma16(rs, vo[i], soff, lds + VB + (4 * wave + i) * 1024);
}
#define DFA_BAR() do { asm volatile("s_waitcnt lgkmcnt(0)" ::: "memory"); __builtin_amdgcn_s_barrier(); asm volatile("" ::: "memory"); } while (0)
template <bool WANT_MAX>
DI float s_tile(LAS unsigned char* lds, const unsigned kb, const bf16x8 (&qf)[8], f32x16& st, const unsigned A0, const int duni, const bool far_, const int lane) {
    const LAS float* btab = (const LAS float*)(lds + BT_OFF);
#pragma unroll
    for (int i = 0; i < 16; ++i) st[i] = 0.f;
    bf16x8 ka[8];
    unsigned a0 = A0; asm volatile("" : "+v"(a0));
#pragma unroll
    for (int s = 0; s < 8; ++s) ka[s] = *(const LAS bf16x8*)(lds + kb + (a0 ^ (32u * s)));
    __builtin_amdgcn_sched_barrier(0);
#pragma unroll
    for (int s = 0; s < 8; ++s) st = __builtin_amdgcn_mfma_f32_32x32x16_bf16(ka[s], qf[s], st, 0, 0, 0);
    __builtin_amdgcn_sched_barrier(0);
    if (!far_) { int ln = lane; asm volatile("" : "+v"(ln));
        const int db = (ln & 31) - 8 * (ln >> 5) + duni;
#pragma unroll
        for (int i = 0; i < 16; ++i) { const int d0 = db - ((i & 3) + 4 * ((i >> 2) & 1) + 16 * (i >> 3)); st[i] += btab[d0 > 223 ? 223 : d0]; } }
    if (!WANT_MAX) return 0.f;
    float mx = st[0];
#pragma unroll
    for (int i = 1; i < 16; ++i) mx = fmaxf(mx, st[i]);
    { float lo, hi; swap32(mx, lo, hi); mx = fmaxf(lo, hi); }
    return mx;
}
DI float p_tile(LAS unsigned char* lds, const unsigned xpn, f32x16& st, const float m, u32x4& pn0, u32x4& pn1, const int wave, const int lane) {
    float ps = 0.f;
#pragma unroll
    for (int i = 0; i < 16; ++i) { st[i] = __builtin_amdgcn_exp2f(st[i] - m); ps += st[i]; }
    { float lo, hi; swap32(ps, lo, hi); ps = lo + hi; }
    pn0.x = pk2(st[0], st[1]); pn0.y = pk2(st[2], st[3]); pn0.z = pk2(st[4], st[5]); pn0.w = pk2(st[6], st[7]);
    pn1.x = pk2(st[8], st[9]); pn1.y = pk2(st[10], st[11]); pn1.z = pk2(st[12], st[13]); pn1.w = pk2(st[14], st[15]);
    *(LAS u32x4*)(lds + xpn + ((wave * 2 + 0) * 64 + lane) * 16) = pn0;
    *(LAS u32x4*)(lds + xpn + ((wave * 2 + 1) * 64 + lane) * 16) = pn1;
    return ps;
}
DI void first(LAS unsigned char* lds, const bf16x8 (&qf)[8], float& m_run, float& l_run, float& mx, u32x4& pw0, u32x4& pw1, const unsigned A0, const int duni, const bool far_, const int wave, const int lane) {
    const int r = lane & 31, role = wave & 1;
    f32x16 st;
    mx = s_tile<true>(lds, (unsigned)(KB0 + 8192 * role), qf, st, A0, duni, far_, lane);
    *(LAS float*)(lds + XM_OFF + (wave * 32 + r) * 4) = mx;
    DFA_BAR();
    m_run = fmaxf(mx, *(const LAS float*)(lds + XM_OFF + ((wave ^ 1) * 32 + r) * 4));
    l_run = p_tile(lds, (unsigned)XP_OFF, st, m_run, pw0, pw1, wave, lane);
}
DI void iter(LAS unsigned char* lds, const int KBn, const int VB, const int par, const bf16x8 (&qf)[8], f32x16 (&O)[4], float& m_run, float& l_run, float& mx, u32x4& pw0, u32x4& pw1,
             const unsigned A0, const unsigned B0, const int duni_n, const bool far_n, const bool act, const bool act_n, const int wave, const int lane) {
    const int r = lane & 31, role = wave & 1;
    if (!act) return;
    const unsigned xpo = (unsigned)(XP_OFF + par * 16384), xpn = (unsigned)(XP_OFF + 16384 - par * 16384), xmo = (unsigned)(XM_OFF + par * 1024), xmn = (unsigned)(XM_OFF + 1024 - par * 1024);
    const float m_new = fmaxf(m_run, fmaxf(mx, *(const LAS float*)(lds + xmo + ((wave ^ 1) * 32 + r) * 4)));
    const unsigned vbase = (unsigned)(VB + 16384 * role);
    const unsigned mtA = 64u * role, mtB = 64u - mtA;
    float ps = 0.f;
    {
        f32x16 st; bf16x8 ka[8];
        if (act_n) { unsigned a0 = A0; asm volatile("" : "+v"(a0)); const unsigned kb = (unsigned)(KBn + 8192 * role);
#pragma unroll
            for (int s = 0; s < 8; ++s) ka[s] = *(const LAS bf16x8*)(lds + kb + (a0 ^ (32u * s))); }
        bf16x8 va[8], vb[8];
#pragma unroll
        for (int j = 0; j < 4; ++j) va[j] = *(const LAS bf16x8*)(lds + 4096 * (j & 3) + vbase + (B0 ^ (mtA + 32u * (j >> 2))));
        __builtin_amdgcn_sched_barrier(0);
        if (act_n) {
#pragma unroll
            for (int i = 0; i < 16; ++i) st[i] = 0.f;
#pragma unroll
            for (int s = 0; s < 8; ++s) st = __builtin_amdgcn_mfma_f32_32x32x16_bf16(ka[s], qf[s], st, 0, 0, 0);
            __builtin_amdgcn_sched_barrier(0);
            if (!far_n) { int ln = lane; asm volatile("" : "+v"(ln)); const int db = (ln & 31) - 8 * (ln >> 5) + duni_n; const LAS float* btab = (const LAS float*)(lds + BT_OFF);
#pragma unroll
                for (int i = 0; i < 16; ++i) { const int d0 = db - ((i & 3) + 4 * ((i >> 2) & 1) + 16 * (i >> 3)); st[i] += btab[d0 > 223 ? 223 : d0]; } }
        } else asm volatile("" : "=v"(st));
#pragma unroll
        for (int j = 4; j < 8; ++j) va[j] = *(const LAS bf16x8*)(lds + 4096 * (j & 3) + vbase + (B0 ^ (mtA + 32u * (j >> 2))));
        const u32x4 qw0_ = *(const LAS u32x4*)(lds + xpo + (((wave ^ 1) * 2 + 0) * 64 + lane) * 16);
        const u32x4 qw1_ = *(const LAS u32x4*)(lds + xpo + (((wave ^ 1) * 2 + 1) * 64 + lane) * 16);
        __builtin_amdgcn_sched_barrier(0);
        u32x4 pn0, pn1; float pe[16]; float mxn = -3.0e38f;
#pragma unroll
        for (int j = 0; j < 8; ++j) {
            O[j & 3] = __builtin_amdgcn_mfma_f32_32x32x16_bf16(va[j], __builtin_bit_cast(bf16x8, (j >> 2) ? pw1 : pw0), O[j & 3], 0, 0, 0);
            vb[j] = *(const LAS bf16x8*)(lds + 4096 * (j & 3) + vbase + (B0 ^ (mtB + 32u * (j >> 2))));
            pe[j] = __builtin_amdgcn_exp2f(st[j] - m_new); ps += pe[j];
            if (j & 1) pn0[j >> 1] = pk2(pe[j - 1], pe[j]);
            __builtin_amdgcn_sched_barrier(0);
        }
#pragma unroll
        for (int j = 0; j < 8; ++j) {
            O[j & 3] = __builtin_amdgcn_mfma_f32_32x32x16_bf16(vb[j], __builtin_bit_cast(bf16x8, (j >> 2) ? qw1_ : qw0_), O[j & 3], 0, 0, 0);
            asm("v_max3_f32 %0, %1, %2, %3" : "=v"(mxn) : "v"(mxn), "v"(st[2 * j]), "v"(st[2 * j + 1]));
            pe[8 + j] = __builtin_amdgcn_exp2f(st[8 + j] - m_new); ps += pe[8 + j];
            if (j & 1) pn1[j >> 1] = pk2(pe[8 + j - 1], pe[8 + j]);
            if (j == 0) *(LAS u32x4*)(lds + xpn + ((wave * 2 + 0) * 64 + lane) * 16) = pn0;
            __builtin_amdgcn_sched_barrier(0);
        }
        *(LAS u32x4*)(lds + xpn + ((wave * 2 + 1) * 64 + lane) * 16) = pn1;
        { float lo, hi; swap32(mxn, lo, hi); mxn = fmaxf(lo, hi); }
        mxn = act_n ? mxn : -1e30f;
        *(LAS float*)(lds + xmn + (wave * 32 + r) * 4) = mxn;
        mx = mxn;
        { float lo, hi; swap32(ps, lo, hi); ps = lo + hi; }
        pw0 = pn0; pw1 = pn1;
        ps = act_n ? ps : 0.f;
    }
    if (__builtin_amdgcn_ballot_w64(m_new > m_run) != 0ull) {
        const float alpha = __builtin_amdgcn_exp2f(m_run - m_new); l_run *= alpha;
#pragma unroll
        for (int dt = 0; dt < 4; ++dt)
#pragma unroll
            for (int i = 0; i < 16; ++i) O[dt][i] *= alpha;
        m_run = m_new;
    }
    l_run += ps;
}
}

DI void diff_unit(const PA& a, LAS unsigned char* lds, int h, int qb, const float lam, const int wave) {
    int lane; asm volatile("v_mbcnt_lo_u32_b32 %0, -1, 0\n\tv_mbcnt_hi_u32_b32 %0, -1, %0" : "=v"(lane));
    const int tid = wave * 64 + lane;
    const int r = lane & 31, h2 = lane >> 5, pair = wave >> 1, role = wave & 1, q0 = qb * 128, qw0 = q0 + 32 * pair, nkt = (q0 + 128) / 64;
    const bf16* QKV = (const bf16*)(a.ws + WS_QKV); const bf16* VT1 = (const bf16*)(a.ws + WS_VT1);
    LAS float* btab = (LAS float*)(lds + dfa::BT_OFF);
    LAS float* xm = (LAS float*)(lds + dfa::XM_OFF);
    __syncthreads();
    if (tid < 224) { float v = -1e30f;
        if (tid >= 96) { const int n = tid - 96; int bk = n;
            if (n >= 16) { bk = 16 + (n >= 19) + (n >= 21) + (n >= 24) + (n >= 27) + (n >= 31) + (n >= 35) + (n >= 40) + (n >= 46) + (n >= 52) + (n >= 59) + (n >= 67) + (n >= 77) + (n >= 87) + (n >= 99) + (n >= 113); }
            v = (inp(a, I_RELB)[bk * AH + h] - inp(a, I_RELB)[31 * AH + h]) * LOG2E; }
        btab[tid] = v; }
    const int pr = (r & 0x13) | ((r & 4) << 1) | ((r & 8) >> 1);
    const unsigned A0 = (unsigned)(pr * 256) | (unsigned)((h2 ^ (pr & 15)) << 4);
    const unsigned B0 = (unsigned)(r * 128) | (unsigned)((h2 ^ ((r >> 1) & 7)) << 4);
    unsigned ko[2], vo[4];
#pragma unroll
    for (int i = 0; i < 2; ++i) { const int row = 4 * (2 * wave + i) + (lane >> 4), u = (lane & 15) ^ (row & 15); ko[i] = (unsigned)(row * QKVW + u * 8) * 2u; }
#pragma unroll
    for (int i = 0; i < 4; ++i) { const int row = 8 * (4 * wave + i) + (lane >> 3), u = (lane & 7) ^ ((row >> 1) & 7); vo[i] = (unsigned)(row * T + u * 8) * 2u; }
    const int chb = h * AVD + role * 128;
    const int oo = (r * D + 4 * h2) * 4, ao = (r * D + 4 * h2) * 2, so = (4 * h2) * 4;
    const __amdgpu_buffer_rsrc_t vrs = __builtin_amdgcn_make_buffer_rsrc((void*)(VT1 + (size_t)h * AVD * T), 0, 0x7fffffff, 0x00020000);
    const int qi = qw0 + r;
    for (int mp = 0; mp < 2; ++mp) {
        const __amdgpu_buffer_rsrc_t krs = __builtin_amdgcn_make_buffer_rsrc((void*)(QKV + D + (h * 2 + mp) * AHD), 0, 0x7fffffff, 0x00020000);
        bf16x8 qf[8];
        { const char* qg = (const char*)(QKV + (size_t)qw0 * QKVW + (h * 2 + mp) * AHD); const unsigned qoff = (unsigned)(r * QKVW + 8 * h2) * 2u;
#pragma unroll
          for (int s = 0; s < 8; ++s) qf[s] = *(const bf16x8*)(qg + qoff + 32 * s); }
        f32x16 O[4];
#pragma unroll
        for (int dt = 0; dt < 4; ++dt)
#pragma unroll
            for (int i = 0; i < 16; ++i) O[dt][i] = 0.f;
        float m_run = -1e30f, l_run = 0.f;
        asm volatile("s_waitcnt vmcnt(0)" ::: "memory");
        dfa::stage_k(lds, dfa::KB0, krs, 0u, ko, wave); dfa::stage_v(lds, dfa::VB0, vrs, 0u, vo, wave); dfa::stage_k(lds, dfa::KB1, krs, 64u * QKVW * 2u, ko, wave);
        asm volatile("s_waitcnt vmcnt(6)" ::: "memory");
        __builtin_amdgcn_s_barrier(); asm volatile("" ::: "memory");
        float mx; u32x4 pw0, pw1;
        dfa::first(lds, qf, m_run, l_run, mx, pw0, pw1, A0, qw0 - 32 * role + 96, 63 + 127 <= qw0, wave, lane);
#pragma unroll 1
        for (int kt = 0; kt < nkt; ++kt) {
            const int k0 = kt * 64, odd = kt & 1;
            asm volatile("s_waitcnt vmcnt(0)" ::: "memory");
            DFA_BAR();
            if (kt + 2 < nkt) dfa::stage_k(lds, odd ? dfa::KB1 : dfa::KB0, krs, (unsigned)(k0 + 128) * (QKVW * 2u), ko, wave);
            if (kt + 1 < nkt) dfa::stage_v(lds, odd ? dfa::VB0 : dfa::VB1, vrs, (unsigned)(k0 + 64) * 2u, vo, wave);
            dfa::iter(lds, odd ? dfa::KB0 : dfa::KB1, odd ? dfa::VB1 : dfa::VB0, odd, qf, O, m_run, l_run, mx, pw0, pw1, A0, B0, qw0 - (k0 + 64) - 32 * role + 96, k0 + 64 + 63 + 127 <= qw0,
                      k0 <= qw0 + 31, (kt + 1 < nkt) && (k0 + 64 <= qw0 + 31), wave, lane);
        }
        const __amdgpu_buffer_rsrc_t o1_rs = __builtin_amdgcn_make_buffer_rsrc((void*)((float*)(a.ws + WS_O1) + (size_t)qw0 * D + chb), 0, 32 * D * 4, 0x00020000);
        const __amdgpu_buffer_rsrc_t ao_rs = FP8_OWO ? __builtin_amdgcn_make_buffer_rsrc((void*)(a.ws + WS_AO + (size_t)qw0 * D + chb), 0, 32 * D, 0x00020000)
                                                       : __builtin_amdgcn_make_buffer_rsrc((void*)((bf16*)(a.ws + WS_AO) + (size_t)qw0 * D + chb), 0, 32 * D * 2, 0x00020000);
        const __amdgpu_buffer_rsrc_t sg_rs = __builtin_amdgcn_make_buffer_rsrc((void*)(inp(a, I_SUBG) + role * 128), 0, 128 * 4, 0x00020000);
        xm[wave * 32 + r] = l_run;
        DFA_BAR();
        const float inv = 1.f / (l_run + xm[(wave ^ 1) * 32 + r]);
        if (mp == 0) {
#pragma unroll
            for (int dt = 0; dt < 4; ++dt)
#pragma unroll
                for (int g4 = 0; g4 < 4; ++g4) { const int dvl = 32 * dt + 8 * g4;
                    f32x4 v; v[0] = O[dt][4 * g4] * inv; v[1] = O[dt][4 * g4 + 1] * inv; v[2] = O[dt][4 * g4 + 2] * inv; v[3] = O[dt][4 * g4 + 3] * inv;
                    __builtin_amdgcn_raw_buffer_store_b128(__builtin_bit_cast(u32x4, v), o1_rs, oo + dvl * 4, 0, 0); if (g4 == 3) __builtin_amdgcn_sched_barrier(0); }
            DFA_BAR();
        } else {
            float lam_s = lam; asm volatile("" : "+s"(lam_s));
            const float c2 = lam_s * inv; float ss = 0.f;
#pragma unroll
            for (int dt = 0; dt < 4; ++dt)
#pragma unroll
                for (int g4 = 0; g4 < 4; ++g4) { const int dvl = 32 * dt + 8 * g4; const f32x4 o1 = __builtin_bit_cast(f32x4, __builtin_amdgcn_raw_buffer_load_b128(o1_rs, oo + dvl * 4, 0, 0));
#pragma unroll
                    for (int e = 0; e < 4; ++e) { const float d = o1[e] - c2 * O[dt][4 * g4 + e]; ss += d * d; } __builtin_amdgcn_sched_barrier(0); }
            { float lo, hi; swap32(ss, lo, hi); ss = lo + hi; }
            DFA_BAR();
            xm[wave * 32 + r] = ss;
            DFA_BAR();
            ss += xm[(wave ^ 1) * 32 + r];
            const float rs = (1.f / sqrtf(ss * (1.f / AVD) + EPS)) * (1.f - LAMBDA_INIT);
#pragma unroll
            for (int dt = 0; dt < 4; ++dt)
#pragma unroll
                for (int g4 = 0; g4 < 4; ++g4) { const int dvl = 32 * dt + 8 * g4; const f32x4 sg = __builtin_bit_cast(f32x4, __builtin_amdgcn_raw_buffer_load_b128(sg_rs, so + dvl * 4, 0, 0));
                    const f32x4 o1 = __builtin_bit_cast(f32x4, __builtin_amdgcn_raw_buffer_load_b128(o1_rs, oo + dvl * 4, 0, 0));
                    const float y0 = (o1[0] - c2 * O[dt][4 * g4]) * rs * sg[0], y1 = (o1[1] - c2 * O[dt][4 * g4 + 1]) * rs * sg[1], y2 = (o1[2] - c2 * O[dt][4 * g4 + 2]) * rs * sg[2], y3 = (o1[3] - c2 * O[dt][4 * g4 + 3]) * rs * sg[3];
                    if (FP8_OWO) __builtin_amdgcn_raw_buffer_store_b32(pk4_fp8(y0, y1, y2, y3), ao_rs, (ao >> 1) + dvl, 0, 0);
                    else { u32x2 w; w.x = pk2(y0, y1); w.y = pk2(y2, y3); __builtin_amdgcn_raw_buffer_store_b64(w, ao_rs, ao + dvl * 2, 0, 0); }
                    __builtin_amdgcn_sched_barrier(0); }
        }
    }
    __syncthreads();
}

DI void peer_topk_process(float a0, float a1, float b0, float b1, int* EIDX, float* GATE, LAS float* scr, int item, int lane) {
    const int tok = item >> 3, hd = item & 7;
    LAS float* sc = scr; LAS float* sv = scr + 64; volatile LAS int* si = (volatile LAS int*)(scr + 96); LAS float* cv = scr + 128; LAS float* fv = scr + 192; volatile LAS int* fi = (volatile LAS int*)(scr + 208);
    typedef unsigned long long u64;
    LAS u64* ck = (LAS u64*)sc;
    const unsigned ua0 = __builtin_bit_cast(unsigned, a0), ua1 = __builtin_bit_cast(unsigned, a1), ub0 = __builtin_bit_cast(unsigned, b0), ub1 = __builtin_bit_cast(unsigned, b1);
    const unsigned ka0 = (ua0 & 0x80000000u) ? ~ua0 : (ua0 | 0x80000000u), ka1 = (ua1 & 0x80000000u) ? ~ua1 : (ua1 | 0x80000000u);
    const unsigned kb0 = (ub0 & 0x80000000u) ? ~ub0 : (ub0 | 0x80000000u), kb1 = (ub1 & 0x80000000u) ? ~ub1 : (ub1 | 0x80000000u);
    unsigned pa = 0u, pb = 0u; bool da = false, db = false;
#pragma unroll 1
    for (int bit = 31; bit >= 0; --bit) {
        const unsigned m = 1u << bit;
        if (!da) { const unsigned t = pa | m; const int c = __builtin_popcountll(__builtin_amdgcn_ballot_w64(ka0 >= t)) + __builtin_popcountll(__builtin_amdgcn_ballot_w64(ka1 >= t)); pa = c >= 16 ? t : pa; da = c == 16; }
        if (!db) { const unsigned t = pb | m; const int c = __builtin_popcountll(__builtin_amdgcn_ballot_w64(kb0 >= t)) + __builtin_popcountll(__builtin_amdgcn_ballot_w64(kb1 >= t)); pb = c >= 16 ? t : pb; db = c == 16; }
        if (da && db) break;
    }
#pragma unroll
    for (int hf = 0; hf < 2; ++hf) {
        const unsigned k0 = hf ? kb0 : ka0, k1 = hf ? kb1 : ka1, p = hf ? pb : pa;
        const bool g0 = k0 > p, g1 = k1 > p, e0 = k0 == p, e1 = k1 == p;
        const u64 E0 = __builtin_amdgcn_ballot_w64(e0), E1 = __builtin_amdgcn_ballot_w64(e1);
        const int need = 16 - __builtin_popcountll(__builtin_amdgcn_ballot_w64(g0)) - __builtin_popcountll(__builtin_amdgcn_ballot_w64(g1));
        const int ne0 = (int)__builtin_amdgcn_mbcnt_hi((unsigned)(E0 >> 32), __builtin_amdgcn_mbcnt_lo((unsigned)E0, 0u));
        const int ne1 = __builtin_popcountll(E0) + (int)__builtin_amdgcn_mbcnt_hi((unsigned)(E1 >> 32), __builtin_amdgcn_mbcnt_lo((unsigned)E1, 0u));
        const bool s0 = g0 || (e0 && ne0 < need), s1 = g1 || (e1 && ne1 < need);
        const u64 S0 = __builtin_amdgcn_ballot_w64(s0), S1 = __builtin_amdgcn_ballot_w64(s1);
        const int p0 = (int)__builtin_amdgcn_mbcnt_hi((unsigned)(S0 >> 32), __builtin_amdgcn_mbcnt_lo((unsigned)S0, 0u));
        const int p1 = __builtin_popcountll(S0) + (int)__builtin_amdgcn_mbcnt_hi((unsigned)(S1 >> 32), __builtin_amdgcn_mbcnt_lo((unsigned)S1, 0u));
        if (s0) ck[hf * 16 + (p0 & 15)] = ((u64)k0 << 32) | (unsigned)(127 - lane);
        if (s1) ck[hf * 16 + (p1 & 15)] = ((u64)k1 << 32) | (unsigned)(63 - lane);
    }
    if (lane < 32) { const int hf = lane >> 4; const u64 mine = ck[lane]; int rk = 0;
#pragma unroll
        for (int j = 0; j < 16; ++j) rk += ck[hf * 16 + j] > mine ? 1 : 0;
        const unsigned k = (unsigned)(mine >> 32), u = (k & 0x80000000u) ? (k & 0x7fffffffu) : ~k;
        sv[hf * 16 + rk] = __builtin_bit_cast(float, u); si[hf * 16 + rk] = 127 - (int)(unsigned)mine; }
    int ca = 0;
    ca = lane >= 16 ? 1 : ca; ca = lane >= 24 ? 2 : ca; ca = lane >= 29 ? 3 : ca; ca = lane >= 33 ? 4 : ca; ca = lane >= 36 ? 5 : ca; ca = lane >= 38 ? 6 : ca; ca = lane >= 40 ? 7 : ca;
    ca = lane >= 42 ? lane - 34 : ca; ca = ca > 15 ? 15 : ca;
    int base = 0;
    base = ca == 1 ? 16 : base; base = ca == 2 ? 24 : base; base = ca == 3 ? 29 : base; base = ca == 4 ? 33 : base; base = ca == 5 ? 36 : base; base = ca == 6 ? 38 : base; base = ca == 7 ? 40 : base;
    base = ca >= 8 ? 34 + ca : base;
    int cb = lane - base; cb = cb > 15 ? 15 : cb;
    const bool valid = lane < 50;
    const float myv = valid ? sv[ca] + sv[16 + cb] : -3.0e38f;
    cv[lane] = myv;
    int rk = 0;
#pragma unroll
    for (int j = 0; j < 52; j += 4) { const f32x4 v = *(const LAS f32x4*)(cv + j);
#pragma unroll
        for (int e = 0; e < 4; ++e) rk += v[e] > myv ? 1 : 0; }
    if (valid && rk < 16) { fv[rk] = myv; fi[rk] = lane; }
    const bool bad = valid && rk < 16 && fi[rk] != lane;
    if (__builtin_amdgcn_ballot_w64(bad) != 0ull) {
        rk = 0;
#pragma unroll 1
        for (int j = 0; j < 50; ++j) { const float v = cv[j]; rk += (v > myv || (v == myv && j < lane)) ? 1 : 0; }
        if (valid && rk < 16) { fv[rk] = myv; fi[rk] = lane; }
    }
    if (valid && rk < 16) fi[rk] = si[ca] * PNK + si[16 + cb];
    if (lane < 16) { const float mx = fv[0]; const float e = __expf(fv[lane] - mx); float s = e; s += __shfl_xor(s, 1); s += __shfl_xor(s, 2); s += __shfl_xor(s, 4); s += __shfl_xor(s, 8);
        EIDX[(size_t)tok * 128 + hd * 16 + lane] = fi[lane] & (NEXP - 1); GATE[(size_t)tok * 128 + hd * 16 + lane] = e / s; }
}
DI void peer_topk_phase(const float* PS, int* EIDX, float* GATE, LAS float* scr, int gw, int ngw, int lane) {
    constexpr int NIT = T * PH;
    int it = gw; if (it >= NIT) return;
    const float* src = PS + (size_t)it * 256 + lane;
    float n0 = src[0], n1 = src[64], n2 = src[128], n3 = src[192];
    for (; it < NIT; it += ngw) {
        const float a0 = n0, a1 = n1, b0 = n2, b1 = n3;
        if (it + ngw < NIT) { const float* nx = PS + (size_t)(it + ngw) * 256 + lane; n0 = nx[0]; n1 = nx[64]; n2 = nx[128]; n3 = nx[192]; }
        peer_topk_process(a0, a1, b0, b1, EIDX, GATE, scr, it, lane);
    }
}

DI void unpack8(const u32x4 v, float* o) { o[0] = bflo(v.x); o[1] = bfhi(v.x); o[2] = bflo(v.y); o[3] = bfhi(v.y); o[4] = bflo(v.z); o[5] = bfhi(v.z); o[6] = bflo(v.w); o[7] = bfhi(v.w); }
DI void unpack_fp8x16(const u32x4 q, float* o) {
#pragma unroll
    for (int d = 0; d < 4; ++d) { const f32x2 lo = __builtin_amdgcn_cvt_pk_f32_fp8((int)q[d], false), hi = __builtin_amdgcn_cvt_pk_f32_fp8((int)q[d], true);
        o[4 * d] = lo.x; o[4 * d + 1] = lo.y; o[4 * d + 2] = hi.x; o[4 * d + 3] = hi.y; }
}
DI void fp8_row(const float* src, unsigned char* tab, int e, float* scale_out, int lane) {
    f32x4 v[16]; float mx = 0.f;
#pragma unroll
    for (int j = 0; j < 4; ++j)
#pragma unroll
        for (int q = 0; q < 4; ++q) { v[4 * j + q] = *(const f32x4*)(src + j * 1024 + lane * 16 + q * 4);
            mx = fmaxf(mx, fmaxf(fmaxf(fabsf(v[4 * j + q].x), fabsf(v[4 * j + q].y)), fmaxf(fabsf(v[4 * j + q].z), fabsf(v[4 * j + q].w)))); }
#pragma unroll
    for (int o = 1; o < 64; o <<= 1) mx = fmaxf(mx, __shfl_xor(mx, o));
    const float inv = mx > 0.f ? 416.f / mx : 0.f;
    if (lane == 0) *scale_out = mx * (1.f / 416.f);
#pragma unroll
    for (int j = 0; j < 4; ++j) { u32x4 w;
#pragma unroll
        for (int q = 0; q < 4; ++q) { int p = 0; p = __builtin_amdgcn_cvt_pk_fp8_f32(v[4 * j + q].x * inv, v[4 * j + q].y * inv, p, false); p = __builtin_amdgcn_cvt_pk_fp8_f32(v[4 * j + q].z * inv, v[4 * j + q].w * inv, p, true); w[q] = (unsigned)p; }
        *(u32x4*)(tab + ((size_t)(8 * j + (lane >> 3)) * NEXP + e) * 128 + (lane & 7) * 16) = w; }
}
typedef int i32x4 __attribute__((ext_vector_type(4)));
constexpr int PGP = 132;
DI float red8(float v) {
    v += __builtin_bit_cast(float, __builtin_amdgcn_update_dpp(0, __builtin_bit_cast(int, v), 0xB1, 0xF, 0xF, false));
    v += __builtin_bit_cast(float, __builtin_amdgcn_update_dpp(0, __builtin_bit_cast(int, v), 0x4E, 0xF, 0xF, false));
    v += __builtin_bit_cast(float, __builtin_amdgcn_update_dpp(0, __builtin_bit_cast(int, v), 0x141, 0xF, 0xF, false));
    return v;
}
DI void ld_e8(const int* p, int (&e)[8]) {
#pragma unroll
    for (int m = 0; m < 2; ++m) { const i32x4 v = *(const i32x4*)(p + 4 * m); e[4 * m] = v[0]; e[4 * m + 1] = v[1]; e[4 * m + 2] = v[2]; e[4 * m + 3] = v[3]; }
}
DI void ld_q8(const __amdgpu_buffer_rsrc_t tab, const int lo, const int (&e)[8], u32x4 (&q)[8]) {
#pragma unroll
    for (int i = 0; i < 8; ++i) q[i] = __builtin_amdgcn_raw_buffer_load_b128(tab, lo + e[i] * 128, 0, 0);
}
DI void g1_chunk(const u32x4 (&q)[8], const float (&hv)[16], LAS float* prow, int j) {
    float r0 = 0.f;
    f32x2 h2[8];
#pragma unroll
    for (int k = 0; k < 8; ++k) { h2[k].x = hv[2 * k]; h2[k].y = hv[2 * k + 1]; }
    float sd[8];
#pragma unroll
    for (int ii = 0; ii < 8; ++ii) {
        f32x2 s2 = __builtin_amdgcn_cvt_pk_f32_fp8((int)q[ii][0], false) * h2[0];
        s2 = __builtin_elementwise_fma(__builtin_amdgcn_cvt_pk_f32_fp8((int)q[ii][0], true), h2[1], s2);
#pragma unroll
        for (int d = 1; d < 4; ++d) { s2 = __builtin_elementwise_fma(__builtin_amdgcn_cvt_pk_f32_fp8((int)q[ii][d], false), h2[2 * d], s2);
            s2 = __builtin_elementwise_fma(__builtin_amdgcn_cvt_pk_f32_fp8((int)q[ii][d], true), h2[2 * d + 1], s2); }
        sd[ii] = s2.x + s2.y; }
#pragma unroll
    for (int ii = 0; ii < 8; ++ii) sd[ii] += __builtin_bit_cast(float, __builtin_amdgcn_update_dpp(0, __builtin_bit_cast(int, sd[ii]), 0xB1, 0xF, 0xF, false));
#pragma unroll
    for (int ii = 0; ii < 8; ++ii) sd[ii] += __builtin_bit_cast(float, __builtin_amdgcn_update_dpp(0, __builtin_bit_cast(int, sd[ii]), 0x4E, 0xF, 0xF, false));
#pragma unroll
    for (int ii = 0; ii < 8; ++ii) sd[ii] += __builtin_bit_cast(float, __builtin_amdgcn_update_dpp(0, __builtin_bit_cast(int, sd[ii]), 0x141, 0xF, 0xF, false));
#pragma unroll
    for (int ii = 0; ii < 8; ++ii) r0 = (j == ii) ? sd[ii] : r0;
    prow[j] += r0;
}
DI void peer_g1_unit(const bf16* H, const unsigned char* TU, const int* EIDX, float* PART, LAS unsigned char* lds, int unit, int tid) {
    const int x = unit & 7, r = unit >> 3, lane = tid & 63, wave = __builtin_amdgcn_readfirstlane(tid >> 6), j = lane & 7, g = lane >> 3;
    LAS float* part = (LAS float*)lds;
    const __amdgpu_buffer_rsrc_t tab = __builtin_amdgcn_make_buffer_rsrc((void*)TU, 0, NEXP * D, 0x00020000);
    __syncthreads();
    for (int i = tid; i < 256 * PGP; i += 512) part[i] = 0.f;
    __syncthreads();
    for (int sl = 0; sl < 4; ++sl) { const int sidx = 4 * x + sl;
        const int lo = sidx * NEXP * 128 + j * 16;
        for (int tb = wave * 32; tb < wave * 32 + 32; tb += 8) { const int tl = tb + g, tok = 256 * r + tl;
            const bf16* hp = H + (size_t)tok * D + sidx * 128 + 16 * j; float hv[16]; unpack8(*(const u32x4*)hp, hv); unpack8(*(const u32x4*)(hp + 8), hv + 8);
            const int* ep = EIDX + (size_t)tok * 128; LAS float* prow = part + tl * PGP;
            int eA[8], eB[8]; u32x4 qA[8], qB[8];
            ld_e8(ep, eA); ld_e8(ep + 8, eB); ld_q8(tab, lo, eA, qA);
#pragma unroll 1
            for (int c = 0; c < 16; c += 2) {
                ld_q8(tab, lo, eB, qB);
                if (c + 2 < 16) ld_e8(ep + 8 * (c + 2), eA);
                g1_chunk(qA, hv, prow + 8 * c, j);
                if (c + 2 < 16) ld_q8(tab, lo, eA, qA);
                if (c + 3 < 16) ld_e8(ep + 8 * (c + 3), eB);
                g1_chunk(qB, hv, prow + 8 * (c + 1), j);
            }
        }
    }
    __syncthreads();
    float* dst = PART + ((size_t)x * T + 256 * r) * 128;
    for (int i = tid; i < 256 * 32; i += 512) *(f32x4*)(dst + i * 4) = *(const LAS f32x4*)(part + (i >> 5) * PGP + (i & 31) * 4);
}
DI void peer_g2(const float* PART, const int* EIDX, const float* GATE, const float* SU, const float* SV, float* W, int i4) {
    f32x4 s = {0.f, 0.f, 0.f, 0.f};
#pragma unroll
    for (int x = 0; x < 8; ++x) s += *(const f32x4*)(PART + (size_t)x * T * 128 + 4 * (size_t)i4);
    const i32x4 e = *(const i32x4*)(EIDX + 4 * (size_t)i4); const f32x4 g = *(const f32x4*)(GATE + 4 * (size_t)i4);
    float su[4], sv[4];
#pragma unroll
    for (int k = 0; k < 4; ++k) { su[k] = SU[e[k]]; sv[k] = SV[e[k]]; }
    f32x4 w;
#pragma unroll
    for (int k = 0; k < 4; ++k) w[k] = g[k] * gelu_tanh(s[k] * su[k]) * sv[k];
    *(f32x4*)(W + 4 * (size_t)i4) = w;
}
DI void g3_chunk(const u32x4 (&q)[8], const LAS float* wrow, float (&acc)[16]) {
#pragma unroll
    for (int m = 0; m < 2; ++m) { const f32x4 w4 = *(const LAS f32x4*)(wrow + 4 * m);
#pragma unroll
        for (int i2 = 0; i2 < 4; ++i2) { float f[16]; unpack_fp8x16(q[4 * m + i2], f);
#pragma unroll
            for (int k = 0; k < 16; ++k) acc[k] += w4[i2] * f[k]; } }
}
DI void ld_e8b(const __amdgpu_buffer_rsrc_t ers, const int voff, int (&e)[8]) {
#pragma unroll
    for (int m = 0; m < 2; ++m) { const u32x4 v = __builtin_amdgcn_raw_buffer_load_b128(ers, voff + 16 * m, 0, 0); e[4 * m] = (int)v[0]; e[4 * m + 1] = (int)v[1]; e[4 * m + 2] = (int)v[2]; e[4 * m + 3] = (int)v[3]; }
}
struct GChunk { int eoff, lo, tl, c, sidx; };
DI GChunk gchunk(int cc, int wave, int r, int x, int g, int j) {
    GChunk q; const int b = cc >> 4; q.c = cc & 15; q.sidx = 4 * x + (b >> 2); q.tl = wave * 32 + (b & 3) * 8 + g;
    q.eoff = ((256 * r + q.tl) * 128 + 8 * q.c) * 4; q.lo = q.sidx * NEXP * 128 + j * 16; return q;
}
DI void peer_g3_unit(const float* W, const unsigned char* TV, const int* EIDX, float* out, LAS unsigned char* lds, int unit, int tid) {
    const int x = unit & 7, r = unit >> 3, lane = tid & 63, wave = __builtin_amdgcn_readfirstlane(tid >> 6), j = lane & 7, g = lane >> 3;
    LAS float* wl = (LAS float*)lds;
    const __amdgpu_buffer_rsrc_t tab = __builtin_amdgcn_make_buffer_rsrc((void*)TV, 0, NEXP * D, 0x00020000);
    const __amdgpu_buffer_rsrc_t ers = __builtin_amdgcn_make_buffer_rsrc((void*)EIDX, 0, T * 128 * 4, 0x00020000);
    __syncthreads();
    { const float* src = W + (size_t)(256 * r) * 128;
      for (int i = tid; i < 256 * 32; i += 512) *(LAS f32x4*)(wl + (i >> 5) * PGP + (i & 31) * 4) = *(const f32x4*)(src + i * 4); }
    __syncthreads();
    int eA[8], eB[8]; u32x4 qA[8], qB[8]; f32x4 ov[4]; float acc[16];
    { const GChunk c0 = gchunk(0, wave, r, x, g, j), c1 = gchunk(1, wave, r, x, g, j); ld_e8b(ers, c0.eoff, eA); ld_e8b(ers, c1.eoff, eB); ld_q8(tab, c0.lo, eA, qA); }
#pragma unroll 1
    for (int cc = 0; cc < 256; cc += 2) {
        const GChunk ca = gchunk(cc, wave, r, x, g, j), cb = gchunk(cc + 1, wave, r, x, g, j);
        float* op = out + (size_t)(256 * r + ca.tl) * D + ca.sidx * 128 + 16 * j;
        ld_q8(tab, cb.lo, eB, qB);
        if (cc + 2 < 256) ld_e8b(ers, gchunk(cc + 2, wave, r, x, g, j).eoff, eA);
        if (ca.c == 0) {
#pragma unroll
            for (int k = 0; k < 4; ++k) ov[k] = *(const f32x4*)(op + 4 * k);
#pragma unroll
            for (int k = 0; k < 16; ++k) acc[k] = 0.f; }
        g3_chunk(qA, wl + ca.tl * PGP + 8 * ca.c, acc);
        if (cc + 2 < 256) ld_q8(tab, gchunk(cc + 2, wave, r, x, g, j).lo, eA, qA);
        if (cc + 3 < 256) ld_e8b(ers, gchunk(cc + 3, wave, r, x, g, j).eoff, eB);
        g3_chunk(qB, wl + cb.tl * PGP + 8 * cb.c, acc);
        if (cb.c == 15) {
#pragma unroll
            for (int k = 0; k < 4; ++k) { f32x4 o = ov[k]; o[0] += acc[4 * k]; o[1] += acc[4 * k + 1]; o[2] += acc[4 * k + 2]; o[3] += acc[4 * k + 3]; *(f32x4*)(op + 4 * k) = o; } }
    }
}

constexpr int NPH = 24;
__global__ void __launch_bounds__(512, 2) fwd_kernel(Args a_) {
    extern __shared__ __attribute__((aligned(16))) unsigned char lds_raw[];
    LAS unsigned char* lds = (LAS unsigned char*)lds_raw;
    const int wave = __builtin_amdgcn_readfirstlane(threadIdx.x >> 6);
    const int G = gridDim.x, bid = blockIdx.x, gw = bid * 8 + wave, ngw = G * 8;
    volatile LAS unsigned* MISC = (volatile LAS unsigned*)(lds + LDS_MISC);
    if (wave == 0) MISC[lane_id()] = 0u;
    __syncthreads();
    unsigned* ctl = (unsigned*)(a_.ws + WS_CTL);
    XcdBarrier bar = xcd_barrier_post(ctl + 4096, MISC + 8, wave);
    const int lo = a_.ph_lo, hi = a_.ph_hi;
#ifndef PHASE_MASK
#define PHASE_MASK 0xffffffffu
#endif
#define IN(k) ((((PHASE_MASK) >> (k)) & 1u) && lo <= (k) && (k) < hi)
#ifndef DUP
#define DUP -1
#endif
#define REP(k) for (int rep_ = 0; rep_ < ((DUP) == (k) ? 2 : 1); ++rep_)
#define SEAM(k) do { if (IN(k) && IN((k) + 1)) xcd_barrier(bar); } while (0)
#define PH_BASES unsigned char* ws = a_.ws; float* out_ = a_.out; asm volatile("" : "+s"(ws), "+s"(out_)); const PA a{a_, ws, out_}; bf16* Hb = (bf16*)(ws + WS_H); (void)Hb; const int lane = lane_id(), tid = wave * 64 + lane; (void)tid;

    if (IN(0)) REP(0) { PH_BASES
        if (bid < S5G) s5_build(a, lds, bid, tid);
        for (int g = bid + G; g < S5G; g += G) s5_build(a, lds, g, tid);
        __syncthreads();
        LAS float* scr = (LAS float*)(lds + wave * 16384);
        constexpr int I_WIN = 64 * 320, I_GLU = 32 * 64, I_EWO = 64 * 128, I_OWI = 64 * 384, I_OWO = 64 * 128;
        constexpr int NIT = I_WIN + I_GLU + I_EWO + I_OWI + I_OWO;
        for (int it = gw; it < NIT; it += ngw) { int r = it;
            if (r < I_WIN) { const int nb_ = r % 320;
                if (FP8_WPART && !FP8_WIN && (nb_ < 64 || nb_ >= 192)) { transpose_item8(inp(a, I_EWIN), D, 10240, ws + WS_WIN8, scr, r, lane, nb_ < 64 ? 0 : -4096); continue; }
                if (FP8_WIN) transpose_item8(inp(a, I_EWIN), D, 10240, ws + WS_WIN, scr, r, lane); else transpose_item(inp(a, I_EWIN), D, 10240, (bf16*)(ws + WS_WIN), nullptr, scr, r, lane); continue; } r -= I_WIN;
            if (r < I_GLU) { transpose_item(inp(a, I_GLUW), S5W, S5W, (bf16*)(ws + WS_GLU), nullptr, scr, r, lane); continue; } r -= I_GLU;
            if (r < I_EWO) { if (FP8_EWO) transpose_item8(inp(a, I_EWOUT), D, D, ws + WS_EWO, scr, r, lane); else transpose_item(inp(a, I_EWOUT), D, D, (bf16*)(ws + WS_EWO), nullptr, scr, r, lane); continue; } r -= I_EWO;
            if (r < I_OWI) { transpose_item8(inp(a, I_OWIN), D, QKVW, ws + WS_OWI, scr, r, lane); continue; } r -= I_OWI;
            if (FP8_OWO) transpose_item8(inp(a, I_OWOUT), D, D, ws + WS_OWO, scr, r, lane); else transpose_item(inp(a, I_OWOUT), D, D, (bf16*)(ws + WS_OWO), nullptr, scr, r, lane);
        }
        {
            const int gt = bid * 512 + tid, ngt = G * 512;
            for (int q = gt; q < 2 * 2048 * 256; q += ngt) { const int l = q >> 19, rem = q & 524287, n = rem >> 8, col0 = (rem & 255) * 8, blk = n >> 7;
                u32x4 w = {0u, 0u, 0u, 0u};
                if ((col0 >> 7) == blk) { const float* kp = inp(a, I_PKEYS) + (((size_t)(l * 16 + blk) * PNK + (n & 127)) * PKD + (col0 & 127));
                    const f32x4 k0 = *(const f32x4*)kp, k1 = *(const f32x4*)(kp + 4); w.x = pk2(k0[0], k0[1]); w.y = pk2(k0[2], k0[3]); w.z = pk2(k1[0], k1[1]); w.w = pk2(k1[2], k1[3]); }
                *(u32x4*)((bf16*)(ws + WS_PKEY) + (size_t)q * 8) = w; }
            for (int q = gt; q < 2 * D * PQW / 8; q += ngt) { const float* sp = inp(a, I_PWQ) + (size_t)q * 8; const f32x4 v0 = *(const f32x4*)sp, v1 = *(const f32x4*)(sp + 4);
                u32x4 w; w.x = pk2(v0[0], v0[1]); w.y = pk2(v0[2], v0[3]); w.z = pk2(v1[0], v1[1]); w.w = pk2(v1[2], v1[3]); *(u32x4*)((bf16*)(ws + WS_WQB) + (size_t)q * 8) = w; }
        }
        const bool bal = (G == 256);
        const int nrounds = bal ? (bid >= 128 ? 34 : 30) : (4 * NEXP - gw + ngw - 1) / ngw;
#pragma unroll 1
        for (int k = 0; k < nrounds; ++k) { const int rr = (bal && k >= 30) ? 30 * ngw + (gw - 1024) + (k - 30) * 1024 : gw + k * ngw;
            const int tb = rr >> 15, idx = rr & 32767, l = idx >> 14, e = idx & 16383;
            fp8_row(inp(a, tb ? I_PV : I_PU) + (size_t)idx * D, ws + (tb ? WS_TV : WS_TU) + (size_t)l * NEXP * D, e, (float*)(ws + (tb ? WS_SV : WS_SU)) + idx, lane); }
        if (FP8_WIN) { for (int m = gw; m < T; m += ngw) rms_row8(inp(a, I_X) + (size_t)m * D, inp(a, I_EVG), ws + WS_H + (size_t)m * D, lane); }
        else if (FP8_WPART) { for (int m = gw; m < T; m += ngw) rms_row_both(inp(a, I_X) + (size_t)m * D, inp(a, I_EVG), Hb + (size_t)m * D, ws + WS_H8L0 + (size_t)m * D, lane); }
        else rms_phase(inp(a, I_X), inp(a, I_EVG), Hb, gw, ngw, lane);
    }
    SEAM(0);
    if (IN(1)) { PH_BASES
        if (FP8_WPART && !FP8_WIN) {
            { pg8::Sched S{Hb, (const bf16*)(ws + WS_WIN) + (size_t)2048 * D, 0, 0, D, D, T / 256, 16, 1, G, bid};
              pg8::EpiZ E{(bf16*)(ws + WS_UC), (bf16*)(ws + WS_Z), 0, 0, 8}; pg8::gemm_phase<pg8::EpiZ, pg8::Sched, false>(lds, tid, D, D, D, S, E); }
            { pg8::Sched S{(const bf16*)(ws + WS_H8L0), (const bf16*)(ws + WS_WIN8), 0, 0, D / 2, D / 2, T / 256, 24, 1, G, bid};
              pg8::EpiZ E{(bf16*)(ws + WS_UC), (bf16*)(ws + WS_Z), 8, 0, 16}; pg8::gemm_phase<pg8::EpiZ, pg8::Sched, true>(lds, tid, D / 2, D / 2, D / 2, S, E); }
        } else { constexpr int KW = FP8_WIN ? D / 2 : D; pg8::Sched S{Hb, (const bf16*)(ws + WS_WIN), 0, 0, KW, KW, T / 256, 10240 / 256, 1, G, bid};
        pg8::EpiZ E{(bf16*)(ws + WS_UC), (bf16*)(ws + WS_Z), 0, 0, 0}; pg8::gemm_phase<pg8::EpiZ, pg8::Sched, FP8_WIN != 0>(lds, tid, KW, KW, KW, S, E); }
        pg8::SchedFold SF{(const bf16*)(ws + WS_PKEY), (const bf16*)(ws + WS_WQB), G, bid};
        pg8::EpiBf16 EF{(bf16*)(ws + WS_WST), D, (size_t)PQW * D}; pg8::gemm_phase(lds, tid, 256, PQW, PQW, SF, EF); }
    SEAM(1);
    if (IN(2)) { PH_BASES pg8::Sched S{(const bf16*)(ws + WS_UC), (const bf16*)(ws + WS_BTE), (size_t)S5NC * UCLD, (size_t)256 * 512, UCLD, 512, 1, 1, S5G, G, bid};
        pg8::EpiS5E E{(float*)(ws + WS_E)}; pg8::gemm_phase(lds, tid, 512, UCLD, 512, S, E);
        for (int it = bid; it < (T / 64) * RH; it += G) ret_prep_item(a, lds, it, tid);
    }
    SEAM(2);
    if (IN(3)) { PH_BASES
        { pg8::SchedRet S{(const bf16*)(ws + WS_QR), (const bf16*)(ws + WS_KR), 0, G, bid}; pg8::EpiRetS E{(bf16*)(ws + WS_SQ)}; pg8::gemm_phase(lds, tid, 256, RW, RW, S, E); }
        { pg8::SchedRet S{(const bf16*)(ws + WS_VS), (const bf16*)(ws + WS_KDT), 1, G, bid}; pg8::EpiRetKV E{(float*)(ws + WS_KVT)}; pg8::gemm_phase(lds, tid, 256, 512, T, S, E); }
        for (int g = bid; g < S5G; g += G) s5_scan(a, lds, g, tid); }
    SEAM(3);
    if (IN(4)) REP(4) { PH_BASES pg8::Sched S{(const bf16*)(ws + WS_UC), (const bf16*)(ws + WS_BT13), (size_t)S5NC * UCLD, (size_t)512 * UCLD, UCLD, UCLD, 1, 2, S5G, G, bid};
        pg8::EpiS5Y E{(const bf16*)(ws + WS_UC), inp(a, I_S5D), (bf16*)(ws + WS_YPRE)}; pg8::gemm_phase(lds, tid, UCLD, UCLD, UCLD, S, E);
        for (int e4 = bid * 512 + tid; e4 < RH * 256 * 64; e4 += G * 512) ret_prefix(a, e4);
    }
    SEAM(4);
    if (IN(5)) { PH_BASES
        { pg8::Sched S{(const bf16*)(ws + WS_YPRE), (const bf16*)(ws + WS_GLU), 0, 0, S5W, S5W, T / 256, S5W / 256, 1, G, bid};
          pg8::EpiGlu E{(const bf16*)(ws + WS_YPRE), inp(a, I_GLUB), (bf16*)(ws + WS_YCAT)}; pg8::gemm_phase(lds, tid, S5W, S5W, S5W, S, E); }
        { pg8::SchedRet S{(const bf16*)(ws + WS_SQ), (const bf16*)(ws + WS_VS), 2, G, bid};
          pg8::EpiRetOut E{(const bf16*)(ws + WS_Z), inp(a, I_GNG), inp(a, I_GNB), (bf16*)(ws + WS_YCAT), (LAS float*)(lds + 131072)}; pg8::gemm_phase(lds, tid, 512, 512, 512, S, E); } }
    SEAM(5);
    if (IN(6)) { PH_BASES constexpr int KW = FP8_EWO ? D / 2 : D; pg8::Sched S{(const bf16*)(ws + WS_YCAT), (const bf16*)(ws + WS_EWO), 0, 0, KW, KW, T / 256, D / 256, 1, G, bid};
        pg8::EpiF32 E{a.out, inp(a, I_X), D}; pg8::gemm_phase<pg8::EpiF32, pg8::Sched, FP8_EWO != 0>(lds, tid, KW, KW, KW, S, E); }
    SEAM(6);
#define PEER_BLOCK(P, LAYER) \
    if (IN(P)) { PH_BASES rms_phase(a.out, inp(a, I_FFNG) + (LAYER) * D, Hb, gw, ngw, lane); } \
    SEAM(P); \
    if (IN((P) + 1)) { PH_BASES pg8::Sched S{Hb, (const bf16*)(ws + WS_WST) + (size_t)(LAYER) * PQW * D, 0, 0, D, D, T / 256, PQW / 256, 1, G, bid}; \
        if (G == 256) { pg8::EpiTopk E{(int*)(ws + WS_EIDX), (float*)(ws + WS_GATE), lds}; pg8::gemm_phase(lds, tid, D, D, D, S, E); }        \
        else { pg8::EpiF32 E{(float*)(ws + WS_PS), nullptr, PQW}; pg8::gemm_phase(lds, tid, D, D, D, S, E); } } \
    if (G != 256) SEAM((P) + 1); \
    if (IN((P) + 2) && G != 256) REP((P) + 2) { PH_BASES peer_topk_phase((const float*)(ws + WS_PS), (int*)(ws + WS_EIDX), (float*)(ws + WS_GATE), (LAS float*)(lds + wave * 2048), gw, ngw, lane); } \
    SEAM((P) + 2); \
    if (IN((P) + 3)) REP((P) + 3) { PH_BASES for (int u = bid; u < 256; u += G) \
        peer_g1_unit(Hb, ws + WS_TU + (size_t)(LAYER) * NEXP * D, (const int*)(ws + WS_EIDX), (float*)(ws + WS_PART), lds, u, tid); } \
    SEAM((P) + 3); \
    if (IN((P) + 4)) { PH_BASES for (int i = bid * 512 + tid; i < T * 32; i += G * 512) \
        peer_g2((const float*)(ws + WS_PART), (const int*)(ws + WS_EIDX), (const float*)(ws + WS_GATE), (const float*)(ws + WS_SU) + (LAYER) * NEXP, (const float*)(ws + WS_SV) + (LAYER) * NEXP, (float*)(ws + WS_PW), i); } \
    SEAM((P) + 4); \
    if (IN((P) + 5)) { PH_BASES for (int u = bid; u < 256; u += G) \
        peer_g3_unit((const float*)(ws + WS_PW), ws + WS_TV + (size_t)(LAYER) * NEXP * D, (const int*)(ws + WS_EIDX), a.out, lds, u, tid); } \
    SEAM((P) + 5);
    PEER_BLOCK(7, 0)
    if (IN(13)) { PH_BASES for (int m = gw; m < T; m += ngw) rms_row8(a.out + (size_t)m * D, inp(a, I_ODG), ws + WS_H + (size_t)m * D, lane); }
    SEAM(13);
    if (IN(14)) REP(14) { PH_BASES
        { pg8::Sched S{Hb, (const bf16*)(ws + WS_OWI), 0, 0, D / 2, D / 2, T / 256, 2 * D / 256, 1, G, bid};
          pg8::EpiQK E{(bf16*)(ws + WS_QKV), inp(a, I_QNG), inp(a, I_KNG), (PG8_LAS float*)(lds + 131072)}; pg8::gemm_phase<pg8::EpiQK, pg8::Sched, true>(lds, tid, D / 2, D / 2, D / 2, S, E); }
        { pg8::Sched S{(const bf16*)(ws + WS_OWI) + (size_t)2 * D * (D / 2), Hb, 0, 0, D / 2, D / 2, AH * AVD / 256, T / 256, 1, G, bid};
          pg8::EpiBf16 E{(bf16*)(ws + WS_VT1), T, 0}; pg8::gemm_phase<pg8::EpiBf16, pg8::Sched, true>(lds, tid, D / 2, D / 2, D / 2, S, E); }
        if (bid == 0 && wave == 0) { const float s1 = wave_sum(inp(a, I_LQ1)[lane] * inp(a, I_LK1)[lane] + inp(a, I_LQ1)[lane + 64] * inp(a, I_LK1)[lane + 64]);
            const float s2 = wave_sum(inp(a, I_LQ2)[lane] * inp(a, I_LK2)[lane] + inp(a, I_LQ2)[lane + 64] * inp(a, I_LK2)[lane + 64]);
            if (lane == 0) *(float*)(ws + WS_MISC) = expf(s1) - expf(s2) + LAMBDA_INIT; }
    }
    SEAM(14);
    if (IN(16)) REP(16) { PH_BASES if (wave >= 4) __builtin_amdgcn_s_setprio(1);
        const float lam = __builtin_bit_cast(float, __builtin_amdgcn_readfirstlane(*(const int*)(ws + WS_MISC)));
        for (int c = bid; c < 256; c += G) { const int hA = 2 * (c & 7) + ((c >> 3) & 1), j = c >> 4;
#pragma unroll 1
            for (int u = 0; u < 4; ++u) { const int qb = (u == 0) ? 63 - j : (u == 1) ? 32 + j : (u == 2) ? 31 - j : j; diff_unit(a, lds, hA, qb, lam, wave); } }
        __builtin_amdgcn_s_setprio(0); }
    SEAM(16);
    if (IN(17)) { PH_BASES constexpr int KW = FP8_OWO ? D / 2 : D; pg8::Sched S{(const bf16*)(ws + WS_AO), (const bf16*)(ws + WS_OWO), 0, 0, KW, KW, T / 256, D / 256, 1, G, bid};
        pg8::EpiF32 E{a.out, a.out, D}; pg8::gemm_phase<pg8::EpiF32, pg8::Sched, FP8_OWO != 0>(lds, tid, KW, KW, KW, S, E); }
    SEAM(17);
    PEER_BLOCK(18, 1)
#undef IN
#undef SEAM
}

#ifndef N_LAUNCH_SPLIT
#define N_LAUNCH_SPLIT 0
#endif
extern "C" void kernel_launch(void* const* d_in, const int* in_sizes, int n_in, void* d_out, int out_size, void* d_ws, size_t ws_size, hipStream_t stream) {
    static int grid = 0;
    if (grid == 0) {
        if (n_in != 32 || out_size != T * D || ws_size < WS_END) { fprintf(stderr, "kernel_launch: unexpected shapes (n_in %d, out %d, ws %zu < %zu)\n", n_in, out_size, ws_size, (size_t)WS_END); grid = -1; return; }
        int dev = 0, cus = 0, per_cu = 0;
        if (hipGetDevice(&dev) != hipSuccess || hipDeviceGetAttribute(&cus, hipDeviceAttributeMultiprocessorCount, dev) != hipSuccess) { grid = -1; return; }
        if (hipFuncSetAttribute((const void*)fwd_kernel, hipFuncAttributeMaxDynamicSharedMemorySize, LDS_BYTES) != hipSuccess) { fprintf(stderr, "kernel_launch: hipFuncSetAttribute failed\n"); grid = -1; return; }
        if (hipOccupancyMaxActiveBlocksPerMultiprocessor(&per_cu, (const void*)fwd_kernel, 512, LDS_BYTES) != hipSuccess || per_cu < 1) fprintf(stderr, "kernel_launch: occupancy query reports %d\n", per_cu);
        (void)hipGetLastError();
        grid = cus;
    }
    if (grid < 0) return;
    (void)hipMemsetAsync((char*)d_ws + WS_CTL, 0, CTL_ZERO_BYTES, stream);
    Args a{};
    for (int i = 0; i < 32; ++i) a.in[i] = (const float*)d_in[i];
    a.out = (float*)d_out; a.ws = (unsigned char*)d_ws;
#if N_LAUNCH_SPLIT
    for (int p = 0; p < NPH; ++p) { a.ph_lo = p; a.ph_hi = p + 1; hipLaunchKernelGGL(fwd_kernel, dim3(grid), dim3(512), LDS_BYTES, stream, a); }
#else
    a.ph_lo = 0; a.ph_hi = NPH; hipLaunchKernelGGL(fwd_kernel, dim3(grid), dim3(512), LDS_BYTES, stream, a);
#endif
}
```
